# Optimizing an MI355X kernel written in HIP

```python
import jax, jax.numpy as jnp
from jax import lax
import numpy as np

D_MODEL = 2048
BATCH = 16
SEQ = 2048
DEPTH = 2

N_A_LAYERS = DEPTH // 2
N_B_LAYERS = DEPTH - N_A_LAYERS
POOL_WINDOWS = (2, 4, 8, 16)
N_POOL_GROUPS = len(POOL_WINDOWS)
POOL_GROUP_DIM = D_MODEL // N_POOL_GROUPS
HEAD_DIM = 128
N_HEADS = D_MODEL // HEAD_DIM
Q_BLOCK = 128
N_GROUPS = 4
EXPERTS_PER_GROUP = 4
N_EXPERTS = N_GROUPS * EXPERTS_PER_GROUP
TOP_K_IN_GROUP = 2
D_FF_EXPERT = D_MODEL // 4
EPS = 1e-6

kernel_name = "hybrid_pool_stickbreak_hmoe"


def rmsnorm(x, g):
    xf = x.astype(jnp.float32)
    y = xf * lax.rsqrt(jnp.mean(xf * xf, axis=-1, keepdims=True) + EPS)
    return (y * g.astype(jnp.float32)).astype(x.dtype)


def pool_mixer(x, pool_w, pool_scale):
    B, S, D = x.shape
    xf = x.reshape(B, S, N_POOL_GROUPS, POOL_GROUP_DIM).astype(jnp.float32)
    csum = jnp.cumsum(xf, axis=1)
    pos = jnp.arange(S)
    outs = []
    for gi, w in enumerate(POOL_WINDOWS):
        c = csum[:, :, gi]
        c_prev = jnp.pad(c, ((0, 0), (w, 0), (0, 0)))[:, :S]
        cnt = jnp.minimum(pos + 1, w).astype(jnp.float32)[None, :, None]
        outs.append((c - c_prev) / cnt - xf[:, :, gi])
    pooled = jnp.stack(outs, axis=2).astype(x.dtype)
    y = jnp.einsum("bsgc,gcd->bsgd", pooled, pool_w).reshape(B, S, D)
    return y * pool_scale


def head_rms(x, g):
    xf = x.astype(jnp.float32)
    y = xf * lax.rsqrt(jnp.mean(xf * xf, axis=-1, keepdims=True) + EPS)
    return (y * g.astype(jnp.float32)).astype(x.dtype)


def shared_kv(h, kv_norm, w_kv, k_norm):
    B, S, D = h.shape
    kv = rmsnorm(h, kv_norm) @ w_kv
    k, v = jnp.split(kv, 2, axis=-1)
    k = head_rms(k.reshape(B, S, N_HEADS, HEAD_DIM), k_norm)
    v = v.reshape(B, S, N_HEADS, HEAD_DIM)
    return k.transpose(0, 2, 1, 3), v.transpose(0, 2, 1, 3)


def stick_breaking(q, k, v):
    S = q.shape[2]
    scale = HEAD_DIM ** -0.5
    outs = []
    for b0 in range(0, S, Q_BLOCK):
        n_k = b0 + Q_BLOCK
        qb = q[:, :, b0:n_k]
        kb = k[:, :, :n_k]
        vb = v[:, :, :n_k]
        z = jnp.einsum("bhqd,bhkd->bhqk", qb, kb).astype(jnp.float32) * scale
        t_pos = b0 + jnp.arange(Q_BLOCK)
        s_pos = jnp.arange(n_k)
        causal = s_pos[None, :] < t_pos[:, None]
        log_keep = jnp.where(causal, jax.nn.log_sigmoid(-z), 0.0)
        after = lax.cumsum(log_keep, axis=3, reverse=True) - log_keep
        a = jnp.where(causal, jnp.exp(jax.nn.log_sigmoid(z) + after), 0.0)
        outs.append(jnp.einsum("bhqk,bhkd->bhqd", a.astype(vb.dtype), vb))
    return jnp.concatenate(outs, axis=2)


def stick_breaking_layer(x, k, v, w_q, q_norm, w_o):
    B, S, D = x.shape
    q = head_rms((x @ w_q).reshape(B, S, N_HEADS, HEAD_DIM), q_norm)
    o = stick_breaking(q.transpose(0, 2, 1, 3), k, v)
    return o.transpose(0, 2, 1, 3).reshape(B, S, D) @ w_o


def hier_moe(x, w_grp, b_grp, w_rt, b_rt, w_gate, w_up, w_down):
    B, S, D = x.shape
    T = B * S
    xt = x.reshape(T, D)
    grp_logits = (xt @ w_grp + b_grp).astype(jnp.float32)
    grp_prob = jax.nn.softmax(grp_logits, axis=-1)
    g_idx = jnp.argmax(grp_logits, axis=-1)
    g_w = jnp.take_along_axis(grp_prob, g_idx[:, None], axis=-1)
    exp_logits = (jnp.einsum("td,gde->tge", xt, w_rt) + b_rt).astype(jnp.float32)
    sel = jnp.take_along_axis(exp_logits, g_idx[:, None, None], axis=1)[:, 0]
    top_v, top_i = lax.top_k(sel, TOP_K_IN_GROUP)
    top_w = jax.nn.softmax(top_v, axis=-1) * g_w
    within = jnp.sum(jax.nn.one_hot(top_i, EXPERTS_PER_GROUP, dtype=jnp.float32)
                     * top_w[..., None], axis=1)
    gate = (jax.nn.one_hot(g_idx, N_GROUPS, dtype=jnp.float32)[:, :, None]
            * within[:, None, :]).reshape(T, N_EXPERTS).astype(x.dtype)
    h = jax.nn.silu(jnp.einsum("td,edf->tef", xt, w_gate)) * jnp.einsum("td,edf->tef", xt, w_up)
    y = jnp.einsum("tef,efd->td", h * gate[:, :, None], w_down)
    return y.reshape(B, S, D)


def setup_inputs(seed: int = 0) -> dict:
    key = jax.random.key(seed)
    ks = jax.random.split(key, 20)
    f32 = jnp.float32
    D, C, HD, F = D_MODEL, POOL_GROUP_DIM, HEAD_DIM, D_FF_EXPERT

    def nrm(k, shape, fan_in):
        return jax.random.normal(k, shape, f32) * fan_in ** -0.5

    def gain(k, shape):
        return 1.0 + 0.05 * jax.random.normal(k, shape, f32)

    return {
        "x": jax.random.normal(ks[0], (BATCH, SEQ, D), f32),
        "norm_mix": gain(ks[1], (DEPTH, D)),
        "norm_ffn": gain(ks[2], (DEPTH, D)),
        "pool_w": nrm(ks[3], (N_A_LAYERS, N_POOL_GROUPS, C, C), C),
        "pool_scale": gain(ks[4], (N_A_LAYERS, D)),
        "kv_norm": gain(ks[5], (D,)),
        "w_kv": nrm(ks[6], (D, 2 * D), D),
        "k_norm": gain(ks[7], (HD,)),
        "w_q": nrm(ks[8], (N_B_LAYERS, D, D), D),
        "q_norm": gain(ks[9], (N_B_LAYERS, HD)),
        "w_o": nrm(ks[10], (N_B_LAYERS, D, D), D),
        "moe_w_grp": nrm(ks[11], (DEPTH, D, N_GROUPS), D),
        "moe_b_grp": 0.01 * jax.random.normal(ks[12], (DEPTH, N_GROUPS), f32),
        "moe_w_rt": nrm(ks[13], (DEPTH, N_GROUPS, D, EXPERTS_PER_GROUP), D),
        "moe_b_rt": 0.01 * jax.random.normal(ks[14], (DEPTH, N_GROUPS, EXPERTS_PER_GROUP), f32),
        "moe_w_gate": nrm(ks[15], (DEPTH, N_EXPERTS, D, F), D),
        "moe_w_up": nrm(ks[16], (DEPTH, N_EXPERTS, D, F), D),
        "moe_w_down": nrm(ks[17], (DEPTH, N_EXPERTS, F, D), F),
    }


def reference(x, norm_mix, norm_ffn, pool_w, pool_scale, kv_norm, w_kv, k_norm,
              w_q, q_norm, w_o, moe_w_grp, moe_b_grp, moe_w_rt, moe_b_rt,
              moe_w_gate, moe_w_up, moe_w_down):
    h = x
    k = v = None
    for i in range(DEPTH):
        if i < N_A_LAYERS:
            h = h + pool_mixer(rmsnorm(h, norm_mix[i]), pool_w[i], pool_scale[i])
        else:
            j = i - N_A_LAYERS
            if j == 0:
                k, v = shared_kv(h, kv_norm, w_kv, k_norm)
            h = h + stick_breaking_layer(rmsnorm(h, norm_mix[i]), k, v,
                                         w_q[j], q_norm[j], w_o[j])
        h = h + hier_moe(rmsnorm(h, norm_ffn[i]), moe_w_grp[i], moe_b_grp[i],
                         moe_w_rt[i], moe_b_rt[i], moe_w_gate[i], moe_w_up[i],
                         moe_w_down[i])
    return h
```

```cpp
#include <hip/hip_runtime.h>
#include <cstdio>
#include <cstdint>

#ifndef STOP_AFTER
#define STOP_AFTER 4
#endif
#ifndef N_LAUNCH_MODE
#define N_LAUNCH_MODE 0
#endif

#define LAS __attribute__((address_space(3)))
#define GAS __attribute__((address_space(1)))
typedef unsigned short bf16_t;
typedef short bf16x8 __attribute__((ext_vector_type(8)));
typedef short s16x4 __attribute__((ext_vector_type(4)));
typedef float f32x2 __attribute__((ext_vector_type(2)));
typedef float f32x4 __attribute__((ext_vector_type(4)));
typedef float f32x16 __attribute__((ext_vector_type(16)));
typedef unsigned u32x2 __attribute__((ext_vector_type(2)));
typedef unsigned u32x4 __attribute__((ext_vector_type(4)));

constexpr int BATCH = 16, SEQ = 2048, DM = 2048, T = BATCH * SEQ, NH = 16, HD = 128;
constexpr int NGRP = 4, EPG = 4, NE = 16, FF = 512, NBKT = 24;
constexpr int PGC = 512;
constexpr float EPS = 1e-6f;
constexpr int MAXRT = 152;
constexpr int NWAVES = 8, NTHR = 512;

constexpr size_t MiB = 1u << 20;
constexpr size_t WS_CTL = 0, CTL_BYTES = 1 * MiB;
constexpr size_t WS_WPOOL = 1 * MiB;
constexpr size_t WS_WQKV = 3 * MiB;
constexpr size_t WS_WO = 27 * MiB;
constexpr size_t WS_WGU = 35 * MiB;
constexpr size_t WS_WD = 163 * MiB;
constexpr size_t WS_WR = 227 * MiB;
constexpr size_t WS_RSTD = 228 * MiB;
constexpr size_t WS_LIST = 229 * MiB;
constexpr size_t WS_META = 232 * MiB;
constexpr size_t WS_HMOE = 244 * MiB;
constexpr size_t WS_HB = 320 * MiB;
constexpr size_t WS_HC = 448 * MiB;
constexpr size_t WS_Q = 576 * MiB;
constexpr size_t WS_K = 704 * MiB;
constexpr size_t WS_V = 832 * MiB;
constexpr size_t WS_END = 960 * MiB;
constexpr int CW_BAR = 4096;
constexpr int CW_CNT = 16384;

constexpr int RING_BYTES = 131072;
constexpr int EX_OFF = RING_BYTES;
constexpr int ROWTAB_OFF = EX_OFF + 8192;
constexpr int UDESC_OFF = ROWTAB_OFF + 8192;
constexpr int MISC_OFF = UDESC_OFF + 1024;
constexpr int LDS_BYTES = 151552;
static_assert(MISC_OFF + 256 <= LDS_BYTES, "lds map");
static_assert(WS_V - WS_K == WS_K - WS_Q, "q|k|v spacing");

__device__ __forceinline__ unsigned f2bf(float f) { unsigned u = __builtin_bit_cast(unsigned, f); return (u + 0x7fffu + ((u >> 16) & 1u)) >> 16; }
__device__ __forceinline__ unsigned pk2(float lo, float hi) { return f2bf(lo) | (f2bf(hi) << 16); }
__device__ __forceinline__ float bf2f(unsigned short b) { return __builtin_bit_cast(float, ((unsigned)b) << 16); }
__device__ __forceinline__ float bflo(unsigned w) { return __builtin_bit_cast(float, w << 16); }
__device__ __forceinline__ float bfhi(unsigned w) { return __builtin_bit_cast(float, w & 0xffff0000u); }
__device__ __forceinline__ unsigned cvt_pk_bf16(float lo, float hi) { unsigned r; asm volatile("v_cvt_pk_bf16_f32 %0, %1, %2" : "=v"(r) : "v"(lo), "v"(hi)); return r; }
__device__ __forceinline__ float wave_sum(float v) {
#pragma unroll
    for (int o = 1; o < 64; o <<= 1) v += __shfl_xor(v, o);
    return v;
}
#define LDS_WAIT() asm volatile("s_waitcnt lgkmcnt(0)" ::: "memory")
#define VM_WAIT() asm volatile("s_waitcnt vmcnt(0)" ::: "memory")

#define XB_TMO      128
#define XB_XCNT(j)  (256  + 64 * (j))
#define XB_XSUB(j)  (1280 + 64 * (j))
#define XB_XGEN(j)  (2304 + 64 * (j))
#define XB_TOP      3328
#define XB_TOPGEN   3392
#define XCD_BAR_WORDS 3456
#define XB_SPIN_CAP (1u << 18)
__device__ __forceinline__ unsigned xb_ld(unsigned* p)              { return __hip_atomic_load(p, __ATOMIC_RELAXED, __HIP_MEMORY_SCOPE_AGENT); }
__device__ __forceinline__ unsigned xb_add(unsigned* p, unsigned v) { return __hip_atomic_fetch_add(p, v, __ATOMIC_RELAXED, __HIP_MEMORY_SCOPE_AGENT); }
__device__ __forceinline__ unsigned xb_xcc_id() { return (unsigned)__builtin_amdgcn_s_getreg((3 << 11) | 20) & 0xFu; }
#define XB_SPIN(cond, bar) do { unsigned _sp = 0; while (cond) { __builtin_amdgcn_s_sleep(1); \
    if ((++_sp & 255u) == 0u) { if (xb_ld(&(bar)[XB_TMO])) break; if (_sp > XB_SPIN_CAP) { atomicAdd(&(bar)[XB_TMO], 1u); break; } } } } while (0)
struct XcdBarrier { unsigned* bar; unsigned x; volatile LAS unsigned* st; };
__device__ __forceinline__ XcdBarrier xcd_barrier_post(unsigned* bar, volatile LAS unsigned* st) {
    XcdBarrier b; b.bar = bar; b.x = xb_xcc_id(); b.st = st;
    if (threadIdx.x == 0) (void)xb_add(&bar[XB_XCNT(b.x)], 1u);
    return b;
}
__device__ __forceinline__ void xcd_barrier_complete(unsigned* bar, unsigned x, unsigned& nloc, unsigned& nx) {
    const unsigned G = gridDim.x * gridDim.y * gridDim.z;
    unsigned sum, cnt, mine, sp = 0u;
    for (;;) {
        sum = 0u; cnt = 0u; mine = 0u;
#pragma unroll
        for (unsigned j = 0; j < 16; ++j) { const unsigned c = xb_ld(&bar[XB_XCNT(j)]); sum += c; cnt += (c > 0u) ? 1u : 0u; mine = (j == x) ? c : mine; }
        if (sum == G) break;
        __builtin_amdgcn_s_sleep(1);
        if ((++sp & 255u) == 0u) { if (xb_ld(&bar[XB_TMO])) break; if (sp > XB_SPIN_CAP) { atomicAdd(&bar[XB_TMO], 1u); break; } }
    }
    nloc = mine > 0u ? mine : 1u; nx = cnt > 0u ? cnt : 1u;
}
__device__ __forceinline__ void xcd_barrier(const XcdBarrier& b) {
    asm volatile("s_waitcnt vmcnt(0)" ::: "memory");
    __syncthreads();
    if (threadIdx.x == 0) {
        unsigned* bar = b.bar;
        __builtin_amdgcn_s_waitcnt(0);
        unsigned nloc = b.st[0], nx = b.st[1];
        if (nloc == 0u) { xcd_barrier_complete(bar, b.x, nloc, nx); b.st[0] = nloc; b.st[1] = nx; }
        const unsigned old = xb_add(&bar[XB_XSUB(b.x)], 1u);
        const unsigned gen = old / nloc;
        if (old + 1u == (gen + 1u) * nloc) {
            __builtin_amdgcn_fence(__ATOMIC_RELEASE, "agent");
            asm volatile("s_waitcnt vmcnt(0)" ::: "memory");
            const unsigned og = xb_add(&bar[XB_TOP], 1u);
            const unsigned tg = og / nx;
            if (og + 1u == (tg + 1u) * nx) xb_add(&bar[XB_TOPGEN], 1u);
            else XB_SPIN(xb_ld(&bar[XB_TOPGEN]) == tg, bar);
            __builtin_amdgcn_fence(__ATOMIC_ACQUIRE, "agent");
            xb_add(&bar[XB_XGEN(b.x)], 1u);
            asm volatile("s_waitcnt vmcnt(0)" ::: "memory");
        } else {
            XB_SPIN(xb_ld(&bar[XB_XGEN(b.x)]) == gen, bar);
            __builtin_amdgcn_fence(__ATOMIC_ACQUIRE, "agent");
            asm volatile("s_waitcnt vmcnt(0)" ::: "memory");
        }
    }
    __syncthreads();
}

namespace pg8 {
constexpr int BM = 256, BK = 64, HALF = 128, HTB = HALF * BK * 2, STAGE_BYTES = 8 * HTB;
__host__ __device__ __forceinline__ int lds_byte(int r, int c) { const int st = (r >> 4) * 2 + (c >> 5), rr = r & 15, cc = c & 31, ob = rr * 64 + cc * 2; return st * 1024 + (ob ^ (((ob >> 9) & 1) << 5)); }
__host__ __device__ __forceinline__ void stage_rc(int b, int& R, int& C) { const int st = b / 1024, sb = b % 1024, swz = sb ^ (((sb >> 9) & 1) << 5); R = (st >> 1) * 16 + swz / 64; C = (st & 1) * 32 + (swz % 64) / 2; }
__host__ __device__ __forceinline__ int perm32(int rho) { const int n = rho >> 4, i = rho & 15; return 8 * (i >> 2) + 4 * n + (i & 3); }

struct Unit { int j, pm, pn, aux; };

template <class Epi, class Sched>
__device__ __forceinline__ void gemm_phase(LAS unsigned char* lds, const int K, const Sched& S, const Epi& E) {
    const int tid = threadIdx.x, wid = __builtin_amdgcn_readfirstlane(tid >> 6), lane = tid & 63, wr = wid >> 2, wc = wid & 3, fr = lane & 15, fq = lane >> 4;
    const int nt = K / BK;
    int Rl[2], Cl2[2]; unsigned voffB[2];
#pragma unroll
    for (int i = 0; i < 2; ++i) { int R, C; stage_rc(tid * 16 + i * 8192, R, C); Rl[i] = R; Cl2[i] = C * 2; const int Rb = (R & ~31) + perm32(R & 31); voffB[i] = (unsigned)Rb * S.ldb_bytes + (unsigned)C * 2u; }
    const size_t kstep = (size_t)(BK * 2);
    const size_t hstepB = (size_t)HALF * S.ldb_bytes;
    const unsigned ldsw = (unsigned)wid * 1024u;
    const int aoff = lds_byte(wr * 64 + fr, fq * 8), boff = lds_byte(wc * 32 + fr, fq * 8);
#define PG8_SA(b, h) (((b) * 2 + (h)) * HTB)
#define PG8_SB(b, h) ((4 + (b) * 2 + (h)) * HTB)
#define PG8_STAGEB(bufoff, gbase) do { _Pragma("unroll") for (int _i = 0; _i < 2; ++_i) \
        __builtin_amdgcn_global_load_lds((const unsigned*)((const char*)(gbase) + voffB[_i]), (LAS unsigned*)(lds + (bufoff) + ldsw + _i * 8192), 16, 0, 0); } while (0)
#define PG8_STAGEA(bufoff, offs, h, kb) do { _Pragma("unroll") for (int _i = 0; _i < 2; ++_i) \
        __builtin_amdgcn_global_load_lds((const unsigned*)(S.A + (kb) + (offs)[(h) * 2 + _i]), (LAS unsigned*)(lds + (bufoff) + ldsw + _i * 8192), 16, 0, 0); } while (0)
#define PG8_LDA(dst, b, h) do { _Pragma("unroll") for (int m = 0; m < 4; ++m) _Pragma("unroll") for (int k = 0; k < 2; ++k) dst[m][k] = *(const LAS bf16x8*)(lds + PG8_SA(b, h) + aoff + m * 2048 + k * 1024); } while (0)
#define PG8_LDB(dst, b, h) do { _Pragma("unroll") for (int n = 0; n < 2; ++n) _Pragma("unroll") for (int k = 0; k < 2; ++k) dst[n][k] = *(const LAS bf16x8*)(lds + PG8_SB(b, h) + boff + n * 2048 + k * 1024); } while (0)
#define PG8_MMA(ai, bj, At, Bt) do { __builtin_amdgcn_s_setprio(1); _Pragma("unroll") for (int m = 0; m < 4; ++m) _Pragma("unroll") for (int n = 0; n < 2; ++n) _Pragma("unroll") for (int k = 0; k < 2; ++k) \
        acc[ai][bj][m][n] = __builtin_amdgcn_mfma_f32_16x16x32_bf16(Bt[n][k], At[m][k], acc[ai][bj][m][n], 0, 0, 0); __builtin_amdgcn_s_setprio(0); } while (0)
#define PG8_WAIT_V(n) asm volatile("s_waitcnt vmcnt(" #n ")" ::: "memory")
#define PG8_WAIT_L(n) asm volatile("s_waitcnt lgkmcnt(" #n ")" ::: "memory")
#define PG8_BAR __builtin_amdgcn_s_barrier()
#define PG8_SCHED __builtin_amdgcn_sched_barrier(0)
#define PG8_OFFS(dst, u) do { _Pragma("unroll") for (int _h = 0; _h < 2; ++_h) _Pragma("unroll") for (int _i = 0; _i < 2; ++_i) dst[_h * 2 + _i] = S.row_off(u, _h * HALF + Rl[_i]) + (unsigned)Cl2[_i]; } while (0)
    Unit cur, nxt; int ui = 0;
    if (!S.next(0, cur)) return;
    f32x4 acc[2][2][4][2];
#pragma unroll
    for (int a = 0; a < 2; ++a)
#pragma unroll
        for (int b = 0; b < 2; ++b)
#pragma unroll
            for (int m = 0; m < 4; ++m)
#pragma unroll
                for (int n = 0; n < 2; ++n) acc[a][b][m][n] = (f32x4){0.f, 0.f, 0.f, 0.f};
    bf16x8 At[4][2], B0[2][2], B1[2][2];
    unsigned offC[4], offN[4];
    PG8_OFFS(offC, cur);
#pragma unroll
    for (int q = 0; q < 4; ++q) offN[q] = offC[q];
    const char* cB0 = S.b_ptr(cur, 0); const char* cB1 = S.b_ptr(cur, 1);
    PG8_STAGEB(PG8_SB(0, 0), cB0); PG8_STAGEB(PG8_SB(0, 1), cB0 + hstepB); PG8_STAGEA(PG8_SA(0, 0), offC, 0, 0); PG8_STAGEA(PG8_SA(0, 1), offC, 1, 0);
    if (wr == 1) PG8_BAR;
    PG8_WAIT_V(2); PG8_BAR;
    PG8_STAGEB(PG8_SB(1, 0), cB1); PG8_STAGEA(PG8_SA(1, 0), offC, 0, kstep); PG8_STAGEB(PG8_SB(1, 1), cB1 + hstepB);
    PG8_WAIT_V(6); PG8_BAR;
    for (;;) {
        const bool has_next = S.next(ui + 1, nxt);
        if (!has_next) nxt = cur;
        for (int t = 0; t < nt; t += 2) {
            const bool last = (t == nt - 2);
            const size_t a1 = (size_t)(t + 1) * kstep;
            const size_t a2 = last ? (size_t)0 : (size_t)(t + 2) * kstep; const size_t a3 = a2 + kstep;
            const char* b2 = last ? S.b_ptr(nxt, 0) : S.b_ptr(cur, t + 2);
            const char* b3 = last ? S.b_ptr(nxt, 1) : S.b_ptr(cur, t + 3);
            if (last && has_next) { PG8_OFFS(offN, nxt); }
            PG8_LDB(B0, 0, 0); PG8_LDB(B1, 0, 1); PG8_SCHED; PG8_LDA(At, 0, 0); PG8_STAGEA(PG8_SA(1, 1), offC, 1, a1);
            PG8_WAIT_V(8); PG8_WAIT_L(0); PG8_BAR; PG8_MMA(0, 0, At, B0); PG8_MMA(0, 1, At, B1); PG8_BAR; PG8_SCHED;
            PG8_LDA(At, 0, 1); PG8_STAGEB(PG8_SB(0, 0), b2); PG8_STAGEB(PG8_SB(0, 1), b2 + hstepB); PG8_STAGEA(PG8_SA(0, 0), offN, 0, a2);
            PG8_WAIT_V(8); PG8_WAIT_L(0); PG8_BAR; PG8_MMA(1, 0, At, B0); PG8_MMA(1, 1, At, B1); PG8_BAR; PG8_SCHED;
            PG8_LDB(B0, 1, 0); PG8_LDB(B1, 1, 1); PG8_SCHED; PG8_LDA(At, 1, 0); PG8_STAGEA(PG8_SA(0, 1), offN, 1, a2);
            PG8_WAIT_V(8); PG8_WAIT_L(0); PG8_BAR; PG8_MMA(0, 0, At, B0); PG8_MMA(0, 1, At, B1); PG8_BAR; PG8_SCHED;
            PG8_LDA(At, 1, 1); PG8_STAGEB(PG8_SB(1, 0), b3); PG8_STAGEB(PG8_SB(1, 1), b3 + hstepB); PG8_STAGEA(PG8_SA(1, 0), offN, 0, a3);
            PG8_WAIT_V(8); PG8_WAIT_L(0); PG8_BAR; PG8_MMA(1, 0, At, B0); PG8_MMA(1, 1, At, B1); PG8_BAR; PG8_SCHED;
        }
        if (wr == 0) PG8_BAR;
        E(acc, cur, wr, wc, fr, fq, lds);
        if (!has_next) break;
#pragma unroll
        for (int a = 0; a < 2; ++a)
#pragma unroll
            for (int b = 0; b < 2; ++b)
#pragma unroll
                for (int m = 0; m < 4; ++m)
#pragma unroll
                    for (int n = 0; n < 2; ++n) acc[a][b][m][n] = (f32x4){0.f, 0.f, 0.f, 0.f};
        cur = nxt; ++ui;
#pragma unroll
        for (int q = 0; q < 4; ++q) offC[q] = offN[q];
        if (wr == 1) PG8_BAR;
    }
    PG8_WAIT_V(0);
    PG8_BAR;
#undef PG8_SA
#undef PG8_SB
#undef PG8_STAGEA
#undef PG8_STAGEB
#undef PG8_LDA
#undef PG8_LDB
#undef PG8_MMA
#undef PG8_WAIT_V
#undef PG8_WAIT_L
#undef PG8_BAR
#undef PG8_SCHED
#undef PG8_OFFS
}
}

struct Args {
    const float* x; const float* norm_mix; const float* norm_ffn; const float* pool_w; const float* pool_scale; const float* kv_norm; const float* w_kv; const float* k_norm;
    const float* w_q; const float* q_norm; const float* w_o; const float* w_grp; const float* b_grp; const float* w_rt; const float* b_rt; const float* w_gate; const float* w_up; const float* w_down;
    float* out; unsigned char* ws; int ph_lo, ph_hi;
};
struct Frame {
    LAS unsigned char* lds; int tid, lane, wave, vcu, G;
};

__device__ __forceinline__ void transpose_item(const float* W, int ldw, const float* gk, const float* gn, bf16_t* WT, int ldk, int k0, int n0, int drow0, LAS float* scr, int lane) {
    const float gnv = gn ? gn[n0 + (lane & 31)] : 1.f;
#pragma unroll 8
    for (int i = 0; i < 32; ++i) { const int kk = 2 * i + (lane >> 5); const float g = (gk ? gk[k0 + kk] : 1.f) * gnv; scr[kk * 33 + (lane & 31)] = W[(size_t)(k0 + kk) * ldw + n0 + (lane & 31)] * g; }
    LDS_WAIT(); asm volatile("" ::: "memory");
    const int c = lane & 7;
#pragma unroll
    for (int j = 0; j < 4; ++j) { const int n = (lane >> 3) + 8 * j; const LAS float* s = scr + (8 * c) * 33 + n;
        u32x4 o; o.x = pk2(s[0 * 33], s[1 * 33]); o.y = pk2(s[2 * 33], s[3 * 33]); o.z = pk2(s[4 * 33], s[5 * 33]); o.w = pk2(s[6 * 33], s[7 * 33]);
        *(u32x4*)(WT + (size_t)(drow0 + n) * ldk + k0 + 8 * c) = o; }
    LDS_WAIT(); asm volatile("" ::: "memory");
}

__device__ __forceinline__ void p0_weights(const Args& a, Frame& F) {
    LAS float* scr = (LAS float*)(F.lds + F.wave * 16384);
    const int gw = F.vcu * NWAVES + F.wave, NGW = F.G * NWAVES;
    bf16_t* Wpool = (bf16_t*)(a.ws + WS_WPOOL); bf16_t* Wqkv = (bf16_t*)(a.ws + WS_WQKV); bf16_t* Wo = (bf16_t*)(a.ws + WS_WO);
    bf16_t* Wgu = (bf16_t*)(a.ws + WS_WGU); bf16_t* Wd = (bf16_t*)(a.ws + WS_WD);
    constexpr int I_POOL = 4 * 8 * 16, I_Q = 32 * 64, I_KV = 32 * 128, I_O = 32 * 64, I_G = 32 * 32 * 16  , I_D = 32 * 8 * 64;
    constexpr int NITEMS = I_POOL + I_Q + I_KV + I_O + 2 * I_G + I_D;
    for (int it = gw; it < NITEMS; it += NGW) {
        int r = it;
        if (r < I_POOL) { const int g = r / 128, rr = r % 128, kb = rr / 16, nb = rr % 16;
            transpose_item(a.pool_w + (size_t)g * PGC * PGC, PGC, a.norm_mix + g * PGC, a.pool_scale + g * PGC, Wpool + (size_t)g * PGC * PGC, PGC, 64 * kb, 32 * nb, 32 * nb, scr, F.lane); continue; } r -= I_POOL;
        if (r < I_Q) { const int kb = r / 64, nb = r % 64; transpose_item(a.w_q, DM, a.norm_mix + DM, nullptr, Wqkv, DM, 64 * kb, 32 * nb, 32 * nb, scr, F.lane); continue; } r -= I_Q;
        if (r < I_KV) { const int kb = r / 128, nb = r % 128; transpose_item(a.w_kv, 2 * DM, a.kv_norm, nullptr, Wqkv + (size_t)DM * DM, DM, 64 * kb, 32 * nb, 32 * nb, scr, F.lane); continue; } r -= I_KV;
        if (r < I_O) { const int kb = r / 64, nb = r % 64; transpose_item(a.w_o, DM, nullptr, nullptr, Wo, DM, 64 * kb, 32 * nb, 32 * nb, scr, F.lane); continue; } r -= I_O;
        if (r < 2 * I_G) { const int which = r / I_G; r %= I_G; const int le = r / 512, rr = r % 512, kb = rr / 16, nb = rr % 16;
            const int f0 = 32 * nb, drow0 = (f0 >> 7) * 256 + which * 128 + (f0 & 127);
            transpose_item((which ? a.w_up : a.w_gate) + (size_t)le * DM * FF, FF, a.norm_ffn + (le >> 4) * DM, nullptr, Wgu + (size_t)le * 1024 * DM, DM, 64 * kb, f0, drow0, scr, F.lane); continue; } r -= 2 * I_G;
        { const int le = r / 512, rr = r % 512, kb = rr / 64, nb = rr % 64;
            transpose_item(a.w_down + (size_t)le * FF * DM, DM, nullptr, nullptr, Wd + (size_t)le * DM * FF, FF, 64 * kb, 32 * nb, 32 * nb, scr, F.lane); }
    }
    bf16_t* Wr = (bf16_t*)(a.ws + WS_WR);
    for (int idx = (F.vcu * NTHR + F.tid); idx < 2 * 32 * DM; idx += F.G * NTHR) {
        const int l = idx / (32 * DM), rr = (idx / DM) % 32, k = idx % DM; float v = 0.f;
        if (rr < 16) v = a.w_rt[(((size_t)l * NGRP + (rr >> 2)) * DM + k) * EPG + (rr & 3)];
        else if (rr < 20) v = a.w_grp[((size_t)l * DM + k) * NGRP + (rr - 16)];
        v *= a.norm_ffn[l * DM + k];
        const unsigned hi = f2bf(v); const float rem = v - __builtin_bit_cast(float, hi << 16);
        Wr[idx] = (bf16_t)hi; Wr[2 * 32 * DM + idx] = (bf16_t)f2bf(rem);
    }
}

__device__ __forceinline__ void p0_pool(const Args& a, Frame& F, bf16_t* pooled) {
    constexpr int TC = 64;
    LAS float* rs = (LAS float*)(F.lds);
    const int c0 = F.tid * 4, gi = c0 / PGC, w = 2 << gi;
    for (int u = F.vcu; u < T / TC; u += F.G) {
        const int b = u / (SEQ / TC), t0 = (u % (SEQ / TC)) * TC;
        const float* xb = a.x + (size_t)b * SEQ * DM;
        __syncthreads();
        for (int r = F.wave - 16 + 0; r < TC; r += NWAVES) {
            const int t = t0 + r; float ss = 0.f;
            if (t >= 0) { const f32x4* xr = (const f32x4*)(xb + (size_t)t * DM) + F.lane;
#pragma unroll
                for (int j = 0; j < 8; ++j) { const f32x4 v = xr[64 * j]; ss += (v.x * v.x + v.y * v.y) + (v.z * v.z + v.w * v.w); }
                ss = wave_sum(ss); }
            if (F.lane == 0) rs[r + 16] = (t >= 0) ? 1.0f / sqrtf(ss * (1.0f / DM) + EPS) : 0.f;
        }
        __syncthreads();
        f32x4 S = (f32x4){0.f, 0.f, 0.f, 0.f};
        for (int r = -(w - 1); r < 0; ++r) { const int t = t0 + r; if (t >= 0) { const f32x4 v = *(const f32x4*)(xb + (size_t)t * DM + c0); S += v * rs[r + 16]; } }
        for (int r = 0; r < TC; ++r) {
            const int t = t0 + r;
            const f32x4 cur = *(const f32x4*)(xb + (size_t)t * DM + c0) * rs[r + 16];
            S += cur;
            const float inv = 1.0f / (float)((t + 1 < w) ? (t + 1) : w);
            const f32x4 p = S * inv - cur;
            u32x2 o; o.x = pk2(p.x, p.y); o.y = pk2(p.z, p.w);
            *(u32x2*)(pooled + ((size_t)b * SEQ + t) * DM + c0) = o;
            const int tw = t - w + 1;
            if (tw >= 0) { const f32x4 v = *(const f32x4*)(xb + (size_t)tw * DM + c0); S -= v * rs[r - w + 1 + 16]; }
        }
    }
    __syncthreads();
}

struct SchedPlain {
    const char* A; const char* B; unsigned lda_bytes, ldb_bytes; int nM, nN, G, vcu; int pool;
    __device__ __forceinline__ bool next(int i, pg8::Unit& u) const { const int L = i * G + vcu; if (L >= nM * nN) return false; u.j = i; u.pm = L / nN; u.pn = L % nN; u.aux = 0; return true; }
    __device__ __forceinline__ unsigned row_off(const pg8::Unit& u, int r) const { return (unsigned)(u.pm * 256 + r) * lda_bytes + (pool ? (unsigned)(u.pn >> 1) * (PGC * 2) : 0u); }
    __device__ __forceinline__ const char* b_ptr(const pg8::Unit& u, int kt) const { return B + (size_t)u.pn * 256 * ldb_bytes + (size_t)kt * 128; }
};

struct EpiPool {
    const float* x; bf16_t* out;
    __device__ __forceinline__ void operator()(const f32x4 (&acc)[2][2][4][2], const pg8::Unit& u, int wr, int wc, int fr, int fq, LAS unsigned char*) const {
        const int row0 = u.pm * 256 + wr * 64 + fr, col0 = u.pn * 256 + wc * 32 + 8 * fq;
#pragma unroll
        for (int ai = 0; ai < 2; ++ai)
#pragma unroll
            for (int m = 0; m < 4; ++m) { const size_t ro = (size_t)(row0 + ai * 128 + m * 16) * DM + col0;
#pragma unroll
                for (int bj = 0; bj < 2; ++bj) { const f32x4 x0 = *(const f32x4*)(x + ro + bj * 128), x1 = *(const f32x4*)(x + ro + bj * 128 + 4);
                    const f32x4 v0 = acc[ai][bj][m][0] + x0, v1 = acc[ai][bj][m][1] + x1;
                    u32x4 w; w.x = cvt_pk_bf16(v0[0], v0[1]); w.y = cvt_pk_bf16(v0[2], v0[3]); w.z = cvt_pk_bf16(v1[0], v1[1]); w.w = cvt_pk_bf16(v1[2], v1[3]);
                    *(u32x4*)(out + ro + bj * 128) = w; } }
    }
};


__device__ __forceinline__ void bucket_experts(int b, int& ge_lo, int& ge_hi) { const int g = b / 6, p = b % 6; const int el = p < 3 ? 0 : (p < 5 ? 1 : 2), eh = p < 3 ? p + 1 : (p < 5 ? p - 1 : 3); ge_lo = g * 4 + el; ge_hi = g * 4 + eh; }
__device__ __forceinline__ void router_phase(const Args& a, Frame& F, const bf16_t* h, int layer) {
    const bf16_t* Wh = (const bf16_t*)(a.ws + WS_WR) + (size_t)layer * 32 * DM; const bf16_t* Wl = Wh + (size_t)2 * 32 * DM;
    unsigned* cnt = (unsigned*)(a.ws + WS_CTL) + CW_CNT + layer * NBKT * 64;
    int* list = (int*)(a.ws + WS_LIST); f32x4* meta = (f32x4*)(a.ws + WS_META);
    LAS float* lg = (LAS float*)(F.lds + F.wave * 2048);
    const int gw = F.vcu * NWAVES + F.wave, NGW = F.G * NWAVES, tk = F.lane & 15, q = F.lane >> 4;
    for (int tile = gw; tile < T / 16; tile += NGW) {
        const int tok0 = tile * 16;
        f32x4 c0 = {0.f, 0.f, 0.f, 0.f}, c1 = c0, css = c0;
        const bf16_t* hp = h + (size_t)(tok0 + tk) * DM + 8 * q; const bf16_t* w0 = Wh + (size_t)tk * DM + 8 * q; const bf16_t* w0l = Wl + (size_t)tk * DM + 8 * q;
#pragma unroll 4
        for (int s = 0; s < DM / 32; ++s) {
            const bf16x8 hf = *(const bf16x8*)(hp + 32 * s);
            const bf16x8 a0 = *(const bf16x8*)(w0 + 32 * s), a0l = *(const bf16x8*)(w0l + 32 * s), a1 = *(const bf16x8*)(w0 + 16 * DM + 32 * s), a1l = *(const bf16x8*)(w0l + 16 * DM + 32 * s);
            c0 = __builtin_amdgcn_mfma_f32_16x16x32_bf16(a0, hf, c0, 0, 0, 0); c0 = __builtin_amdgcn_mfma_f32_16x16x32_bf16(a0l, hf, c0, 0, 0, 0);
            c1 = __builtin_amdgcn_mfma_f32_16x16x32_bf16(a1, hf, c1, 0, 0, 0); c1 = __builtin_amdgcn_mfma_f32_16x16x32_bf16(a1l, hf, c1, 0, 0, 0);
            css = __builtin_amdgcn_mfma_f32_16x16x32_bf16(hf, hf, css, 0, 0, 0);
        }
#pragma unroll
        for (int r = 0; r < 4; ++r) lg[tk * 24 + 4 * q + r] = c0[r];
        if (q == 0) {
#pragma unroll
            for (int r = 0; r < 4; ++r) lg[tk * 24 + 16 + r] = c1[r]; }
        if (q == (tk >> 2)) { const int rr = tk & 3; lg[384 + tk] = rr == 0 ? css[0] : (rr == 1 ? css[1] : (rr == 2 ? css[2] : css[3])); }
        LDS_WAIT(); asm volatile("" ::: "memory");
        if (F.lane < 16) {
            const float rstd = 1.0f / sqrtf(lg[384 + tk] * (1.0f / DM) + EPS);
            float gl[4], el[4];
#pragma unroll
            for (int g = 0; g < 4; ++g) gl[g] = lg[tk * 24 + 16 + g] * rstd + a.b_grp[layer * NGRP + g];
            int gs = 0; float gm = gl[0];
#pragma unroll
            for (int g = 1; g < 4; ++g) if (gl[g] > gm) { gm = gl[g]; gs = g; }
            float den = 0.f;
#pragma unroll
            for (int g = 0; g < 4; ++g) den += __expf(gl[g] - gm);
            const float gwt = 1.0f / den;
#pragma unroll
            for (int e = 0; e < 4; ++e) el[e] = lg[tk * 24 + gs * 4 + e] * rstd + a.b_rt[(layer * NGRP + gs) * EPG + e];
            int i1 = 0; float v1 = el[0];
#pragma unroll
            for (int e = 1; e < 4; ++e) if (el[e] > v1) { v1 = el[e]; i1 = e; }
            int i2 = -1; float v2 = -3.0e38f;
#pragma unroll
            for (int e = 0; e < 4; ++e) if (e != i1 && el[e] > v2) { v2 = el[e]; i2 = e; }
            const float w1 = gwt / (1.0f + __expf(v2 - v1)), w2 = gwt - w1;
            const int elo = i1 < i2 ? i1 : i2, ehi = i1 < i2 ? i2 : i1; const float wlo = i1 < i2 ? w1 : w2, whi = i1 < i2 ? w2 : w1;
            const int pidx = elo == 0 ? ehi - 1 : (elo == 1 ? ehi + 1 : 5);
            const int b = gs * 6 + pidx;
            const unsigned pos = __hip_atomic_fetch_add(cnt + b * 64, 1u, __ATOMIC_RELAXED, __HIP_MEMORY_SCOPE_AGENT);
            list[(size_t)b * T + pos] = tok0 + tk;
            meta[(size_t)b * T + pos] = (f32x4){rstd, wlo, whi, 0.f};
        }
        LDS_WAIT(); asm volatile("" ::: "memory");
    }
}

constexpr int MAXU = 8;
struct MoeTab { LAS int* ud; LAS unsigned* rowtab; };
__device__ __forceinline__ void moe_build(const Args& a, Frame& F, int layer, bool gather) {
    LAS int* ud = (LAS int*)(F.lds + UDESC_OFF); LAS int* tb = ud + MAXU * 8;
    LAS unsigned* rowtab = (LAS unsigned*)(F.lds + ROWTAB_OFF);
    const unsigned* cnt = (const unsigned*)(a.ws + WS_CTL) + CW_CNT + layer * NBKT * 64;
    const int* list = (const int*)(a.ws + WS_LIST);
    __syncthreads();
    if (F.tid == 0) { int base = 0; for (int b = 0; b < NBKT; ++b) { const int c = (int)__hip_atomic_load(cnt + b * 64, __ATOMIC_RELAXED, __HIP_MEMORY_SCOPE_AGENT); tb[b] = base; tb[32 + b] = c; base += (c + 255) >> 8; } tb[NBKT] = base; }
    __syncthreads();
    if (F.tid < MAXU) { const int i = F.tid, L = i * F.G + F.vcu, R = tb[NBKT]; int v = 0, rt = 0, pn = 0, b = 0, ti = 0, nv = 0;
        if (L < 8 * R) { v = 1; rt = L >> 3; pn = L & 7; while (tb[b + 1] <= rt) ++b; ti = rt - tb[b]; nv = tb[32 + b] - 256 * ti; if (nv > 256) nv = 256; }
        ud[i * 8 + 0] = rt; ud[i * 8 + 1] = pn; ud[i * 8 + 2] = b; ud[i * 8 + 3] = ti; ud[i * 8 + 4] = nv; ud[i * 8 + 5] = v; }
    __syncthreads();
    if (gather) for (int e = F.tid; e < MAXU * 256; e += NTHR) { const int i = e >> 8, r = e & 255; unsigned off = 0;
        if (ud[i * 8 + 5]) { const int b = ud[i * 8 + 2], ti = ud[i * 8 + 3], nv = ud[i * 8 + 4]; const int rr = r < nv ? r : nv - 1; off = (unsigned)list[(size_t)b * T + 256 * ti + rr] * (unsigned)(DM * 2); }
        rowtab[e] = off; }
    VM_WAIT(); __syncthreads();
}
__device__ __forceinline__ int rfl(int v) { return __builtin_amdgcn_readfirstlane(v); }
struct SchedMoe {
    const char* A; const char* W; unsigned ldb_bytes; LAS int* ud; LAS unsigned* rowtab; int layer; int down;
    __device__ __forceinline__ bool next(int i, pg8::Unit& u) const { if (i >= MAXU) return false; if (!rfl(ud[i * 8 + 5])) return false; u.j = i; u.pm = rfl(ud[i * 8 + 0]); u.pn = rfl(ud[i * 8 + 1]); u.aux = rfl(ud[i * 8 + 2]); return true; }
    __device__ __forceinline__ unsigned row_off(const pg8::Unit& u, int r) const { return down ? (unsigned)(u.pm * 256 + r) * (unsigned)(2 * FF * 2) : rowtab[u.j * 256 + r]; }
    __device__ __forceinline__ const char* b_ptr(const pg8::Unit& u, int kt) const {
        int gl, gh; bucket_experts(u.aux, gl, gh);
        if (!down) { const int ge = u.pn < 4 ? gl : gh; return W + ((size_t)(layer * NE + ge) * 1024 + (size_t)(u.pn & 3) * 256) * (size_t)(DM * 2) + (size_t)kt * 128; }
        const int ge = kt < 8 ? gl : gh; return W + ((size_t)(layer * NE + ge) * DM + (size_t)u.pn * 256) * (size_t)(FF * 2) + (size_t)(kt & 7) * 128;
    }
};
struct EpiSwiGLU {
    const f32x4* meta; bf16_t* H; LAS int* ud;
    __device__ __forceinline__ void operator()(const f32x4 (&acc)[2][2][4][2], const pg8::Unit& u, int wr, int wc, int fr, int fq, LAS unsigned char*) const {
        const int b = u.aux, ti = rfl(ud[u.j * 8 + 3]);
        const size_t mrow0 = (size_t)b * T + 256 * ti; const int hi = u.pn >> 2;
        const int hcol = hi * 512 + (u.pn & 3) * 128 + wc * 32 + 8 * fq;
#pragma unroll
        for (int ai = 0; ai < 2; ++ai)
#pragma unroll
            for (int m = 0; m < 4; ++m) { const int r = ai * 128 + wr * 64 + m * 16 + fr; const f32x4 mt = meta[mrow0 + r]; const float rstd = mt.x, w = hi ? mt.z : mt.y;
                float o[8];
#pragma unroll
                for (int n = 0; n < 2; ++n)
#pragma unroll
                    for (int j = 0; j < 4; ++j) { const float g = acc[ai][0][m][n][j] * rstd, up = acc[ai][1][m][n][j] * rstd; o[n * 4 + j] = g * __builtin_amdgcn_rcpf(1.0f + __expf(-g)) * up * w; }
                u32x4 pk; pk.x = cvt_pk_bf16(o[0], o[1]); pk.y = cvt_pk_bf16(o[2], o[3]); pk.z = cvt_pk_bf16(o[4], o[5]); pk.w = cvt_pk_bf16(o[6], o[7]);
                *(u32x4*)(H + (size_t)(u.pm * 256 + r) * (2 * FF) + hcol) = pk; }
    }
};
template <bool OUT_F32> struct EpiDown {
    const int* list; const bf16_t* hin; void* out; LAS int* ud;
    __device__ __forceinline__ void operator()(const f32x4 (&acc)[2][2][4][2], const pg8::Unit& u, int wr, int wc, int fr, int fq, LAS unsigned char*) const {
        const int b = u.aux, ti = rfl(ud[u.j * 8 + 3]), nv = rfl(ud[u.j * 8 + 4]);
        const int col0 = u.pn * 256 + wc * 32 + 8 * fq;
#pragma unroll
        for (int ai = 0; ai < 2; ++ai)
#pragma unroll
            for (int m = 0; m < 4; ++m) { const int r = ai * 128 + wr * 64 + m * 16 + fr;
                if (r < nv) { const int tok = list[(size_t)b * T + 256 * ti + r]; const size_t ro = (size_t)tok * DM + col0;
#pragma unroll
                    for (int bj = 0; bj < 2; ++bj) { const u32x4 hv = *(const u32x4*)(hin + ro + bj * 128);
                        const f32x4 v0 = acc[ai][bj][m][0] + (f32x4){bflo(hv.x), bfhi(hv.x), bflo(hv.y), bfhi(hv.y)}, v1 = acc[ai][bj][m][1] + (f32x4){bflo(hv.z), bfhi(hv.z), bflo(hv.w), bfhi(hv.w)};
                        if (OUT_F32) { float* o = (float*)out + ro + bj * 128; *(f32x4*)o = v0; *(f32x4*)(o + 4) = v1; }
                        else { u32x4 w; w.x = cvt_pk_bf16(v0[0], v0[1]); w.y = cvt_pk_bf16(v0[2], v0[3]); w.z = cvt_pk_bf16(v1[0], v1[1]); w.w = cvt_pk_bf16(v1[2], v1[3]); *(u32x4*)((bf16_t*)out + ro + bj * 128) = w; } } } }
    }
};


__device__ __forceinline__ void rstd_phase(Frame& F, const bf16_t* h, float* rstd) {
    const int gw = F.vcu * NWAVES + F.wave, NGW = F.G * NWAVES;
    for (int row = gw; row < T; row += NGW) {
        const u32x4* p = (const u32x4*)(h + (size_t)row * DM) + F.lane; float ss = 0.f;
#pragma unroll
        for (int j = 0; j < 4; ++j) { const u32x4 v = p[64 * j];
            const float a0 = bflo(v.x), a1 = bfhi(v.x), a2 = bflo(v.y), a3 = bfhi(v.y), a4 = bflo(v.z), a5 = bfhi(v.z), a6 = bflo(v.w), a7 = bfhi(v.w);
            ss += (a0 * a0 + a1 * a1) + (a2 * a2 + a3 * a3) + (a4 * a4 + a5 * a5) + (a6 * a6 + a7 * a7); }
        ss = wave_sum(ss);
        if (F.lane == 0) rstd[row] = 1.0f / sqrtf(ss * (1.0f / DM) + EPS);
    }
}

struct EpiRes {
    const bf16_t* hin; bf16_t* out;
    __device__ __forceinline__ void operator()(const f32x4 (&acc)[2][2][4][2], const pg8::Unit& u, int wr, int wc, int fr, int fq, LAS unsigned char*) const {
        const int row0 = u.pm * 256 + wr * 64 + fr, col0 = u.pn * 256 + wc * 32 + 8 * fq;
#pragma unroll
        for (int ai = 0; ai < 2; ++ai)
#pragma unroll
            for (int m = 0; m < 4; ++m) { const size_t ro = (size_t)(row0 + ai * 128 + m * 16) * DM + col0;
#pragma unroll
                for (int bj = 0; bj < 2; ++bj) { const u32x4 hv = *(const u32x4*)(hin + ro + bj * 128);
                    const f32x4 v0 = acc[ai][bj][m][0] + (f32x4){bflo(hv.x), bfhi(hv.x), bflo(hv.y), bfhi(hv.y)}, v1 = acc[ai][bj][m][1] + (f32x4){bflo(hv.z), bfhi(hv.z), bflo(hv.w), bfhi(hv.w)};
                    u32x4 w; w.x = cvt_pk_bf16(v0[0], v0[1]); w.y = cvt_pk_bf16(v0[2], v0[3]); w.z = cvt_pk_bf16(v1[0], v1[1]); w.w = cvt_pk_bf16(v1[2], v1[3]);
                    *(u32x4*)(out + ro + bj * 128) = w; } }
    }
};

constexpr float QSCALE = 0.08838834764831845f * 1.4426950408889634f;
struct EpiQKV {
    const float* rstd; const float* qn; const float* kn; bf16_t* q; bf16_t* k; bf16_t* v;
    __device__ __forceinline__ void operator()(const f32x4 (&acc)[2][2][4][2], const pg8::Unit& u, int wr, int wc, int fr, int fq, LAS unsigned char* lds) const {
        const int which = u.pn >> 3, colt = (u.pn & 7) * 256;
        bf16_t* dst = q + (size_t)which * ((WS_K - WS_Q) / 2);
        const int col0 = colt + wc * 32 + 8 * fq;
        LAS float* EX = (LAS float*)(lds + EX_OFF);
        const bool normed = which != 2;
        if (normed) {
#pragma unroll
            for (int ai = 0; ai < 2; ++ai)
#pragma unroll
                for (int m = 0; m < 4; ++m)
#pragma unroll
                    for (int bj = 0; bj < 2; ++bj) { const f32x4 v0 = acc[ai][bj][m][0], v1 = acc[ai][bj][m][1];
                        float s = (v0[0] * v0[0] + v0[1] * v0[1]) + (v0[2] * v0[2] + v0[3] * v0[3]) + (v1[0] * v1[0] + v1[1] * v1[1]) + (v1[2] * v1[2] + v1[3] * v1[3]);
                        s += __shfl_xor(s, 16); s += __shfl_xor(s, 32);
                        if (fq == 0) EX[((ai * 128 + wr * 64 + m * 16 + fr) * 2 + bj) * 4 + wc] = s; }
            asm volatile("s_waitcnt lgkmcnt(0)" ::: "memory"); __builtin_amdgcn_s_barrier(); asm volatile("" ::: "memory");
        }
        f32x4 g0 = (f32x4){1.f, 1.f, 1.f, 1.f}, g1 = g0;
        if (which == 0) { g0 = *(const f32x4*)(qn + wc * 32 + 8 * fq) * QSCALE; g1 = *(const f32x4*)(qn + wc * 32 + 8 * fq + 4) * QSCALE; }
        if (which == 1) { g0 = *(const f32x4*)(kn + wc * 32 + 8 * fq); g1 = *(const f32x4*)(kn + wc * 32 + 8 * fq + 4); }
#pragma unroll
        for (int ai = 0; ai < 2; ++ai)
#pragma unroll
            for (int m = 0; m < 4; ++m) { const int r = ai * 128 + wr * 64 + m * 16 + fr; const size_t ro = (size_t)(u.pm * 256 + r) * DM + col0;
                const float rs = rstd[u.pm * 256 + r];
#pragma unroll
                for (int bj = 0; bj < 2; ++bj) { float f = rs;
                    if (normed) { const f32x4 pp = *(const LAS f32x4*)(EX + (r * 2 + bj) * 4); const float tot = ((pp[0] + pp[1]) + (pp[2] + pp[3])) * rs * rs; f = rs / sqrtf(tot * (1.0f / HD) + EPS); }
                    const f32x4 v0 = acc[ai][bj][m][0] * f * g0, v1 = acc[ai][bj][m][1] * f * g1;
                    u32x4 w; w.x = cvt_pk_bf16(v0[0], v0[1]); w.y = cvt_pk_bf16(v0[2], v0[3]); w.z = cvt_pk_bf16(v1[0], v1[1]); w.w = cvt_pk_bf16(v1[2], v1[3]);
                    *(u32x4*)(dst + ro + bj * 128) = w; }
                asm volatile("" ::: "memory"); }
    }
};

typedef short v4i16_t __attribute__((ext_vector_type(4)));
__device__ __forceinline__ s16x4 vtr(const LAS char* p) { return __builtin_bit_cast(s16x4, __builtin_amdgcn_ds_read_tr16_b64_v4i16((LAS v4i16_t*)p)); }
__device__ __forceinline__ void attn_phase(Frame& F, const bf16_t* Q, const bf16_t* K, const bf16_t* V, bf16_t* O) {
    const int lane = F.lane, wid = F.wave, tid = F.tid, r32 = lane & 31, hi = lane >> 5;
    LAS char* lds = (LAS char*)F.lds;
    unsigned ksrc[2], vsrc[2];
#pragma unroll
    for (int i = 0; i < 2; ++i) { const int p = i * 512 + tid, row = p >> 4, cp = p & 15; const int X = ((row & 3) << 2) | ((row >> 2) & 3);
        ksrc[i] = (unsigned)(row * (DM * 2) + ((cp ^ X) * 16)); vsrc[i] = (unsigned)(row * (DM * 2) + ((cp ^ ((row & 3) << 2)) * 16)); }
    const int Xr = ((r32 & 3) << 2) | ((r32 >> 2) & 3);
    const int kbase = 256 * r32 + 16 * (hi ^ Xr);
    const int g4 = lane >> 4, qq = (lane & 15) >> 2, pp = lane & 3;
    int vb[4];
#pragma unroll
    for (int db = 0; db < 4; ++db) vb[db] = 256 * (4 * (g4 >> 1) + qq) + 64 * (db ^ qq) + 32 * (g4 & 1) + 16 * (pp >> 1) + 8 * (pp & 1);
#define AT_STAGE(jt, buf) do { const char* _kt = kg + (size_t)(jt) * 64 * (DM * 2); const char* _vt = vg + (size_t)(jt) * 64 * (DM * 2); \
        _Pragma("unroll") for (int _i = 0; _i < 2; ++_i) __builtin_amdgcn_global_load_lds((const unsigned*)(_kt + ksrc[_i]), (LAS unsigned*)(lds + (buf) * 16384 + _i * 8192 + wid * 1024), 16, 0, 0); \
        _Pragma("unroll") for (int _i = 0; _i < 2; ++_i) __builtin_amdgcn_global_load_lds((const unsigned*)(_vt + vsrc[_i]), (LAS unsigned*)(lds + 32768 + (buf) * 16384 + _i * 8192 + wid * 1024), 16, 0, 0); } while (0)
    for (int it = 0;; ++it) {
        const int idx = it * F.G + F.vcu; if (idx >= BATCH * NH * (SEQ / 256)) break;
        const int bh = idx & 255, qb = idx >> 8, b = bh >> 4, h = bh & 15;
        const size_t rowbase = (size_t)b * SEQ;
        const int t0w = qb * 256 + wid * 32, t = t0w + r32;
        bf16x8 qf[8];
        { const bf16_t* qp = Q + (rowbase + t) * DM + h * HD + 8 * hi;
#pragma unroll
          for (int s = 0; s < 8; ++s) qf[s] = *(const bf16x8*)(qp + 16 * s); }
        f32x16 o[4];
#pragma unroll
        for (int db = 0; db < 4; ++db)
#pragma unroll
            for (int r = 0; r < 16; ++r) o[db][r] = 0.f;
        float C = 1.0f;
        const char* kg = (const char*)(K + rowbase * DM + h * HD); const char* vg = (const char*)(V + rowbase * DM + h * HD);
        const int jmax = 4 * qb + 3;
        __builtin_amdgcn_s_barrier();
        AT_STAGE(jmax, 0);
        for (int jt = jmax, n = 0; jt >= 0; --jt, ++n) {
            const int buf = n & 1;
            if (jt > 0) { AT_STAGE(jt - 1, buf ^ 1); asm volatile("s_waitcnt vmcnt(4)" ::: "memory"); }
            else asm volatile("s_waitcnt vmcnt(0)" ::: "memory");
            __builtin_amdgcn_s_barrier(); asm volatile("" ::: "memory");
            if (64 * jt <= t0w + 30) {
                const LAS char* kb = lds + buf * 16384; const LAS char* vbuf = lds + 32768 + buf * 16384;
                f32x16 p[2];
#pragma unroll
                for (int sub = 0; sub < 2; ++sub) {
#pragma unroll
                    for (int r = 0; r < 16; ++r) p[sub][r] = 0.f;
#pragma unroll
                    for (int s = 0; s < 8; ++s) { const bf16x8 kf = *(const LAS bf16x8*)(kb + sub * 8192 + (kbase ^ (32 * s))); p[sub] = __builtin_amdgcn_mfma_f32_32x32x16_bf16(kf, qf[s], p[sub], 0, 0, 0); } }
                const bool needmask = (64 * jt + 63 >= t0w);
                bf16x8 pf[4];
#pragma unroll
                for (int sub = 1; sub >= 0; --sub) {
                    float E[16], sfx[16], gt[4], pr[4], om[4];
#pragma unroll
                    for (int r = 0; r < 16; ++r) { float e = __builtin_amdgcn_exp2f(p[sub][r]);
                        if (needmask) { const int key = 64 * jt + 32 * sub + (r & 3) + 8 * (r >> 2) + 4 * hi; e = key < t ? e : 0.f; }
                        E[r] = e; }
#pragma unroll
                    for (int a = 0; a < 4; ++a) { const float s3 = 1.0f + E[4 * a + 3], s2 = (1.0f + E[4 * a + 2]) * s3, s1 = (1.0f + E[4 * a + 1]) * s2, s0 = (1.0f + E[4 * a]) * s1;
                        sfx[4 * a + 3] = s3; sfx[4 * a + 2] = s2; sfx[4 * a + 1] = s1; sfx[4 * a] = s0; gt[a] = s0; }
#pragma unroll
                    for (int a = 0; a < 4; ++a) { auto rr = __builtin_amdgcn_permlane32_swap(__float_as_uint(gt[a]), __float_as_uint(gt[a]), false, false);
                        const float x0 = __uint_as_float(rr[0]), x1 = __uint_as_float(rr[1]); pr[a] = x0 * x1; om[a] = hi ? 1.0f : x1; }
                    float R[4]; R[3] = C; R[2] = R[3] * pr[3]; R[1] = R[2] * pr[2]; R[0] = R[1] * pr[1]; C = R[0] * pr[0];
                    float A[16];
#pragma unroll
                    for (int a = 0; a < 4; ++a) { const float ap = R[a] * om[a];
#pragma unroll
                        for (int bb = 0; bb < 4; ++bb) A[4 * a + bb] = E[4 * a + bb] * __builtin_amdgcn_rcpf(sfx[4 * a + bb] * ap); }
#pragma unroll
                    for (int s2 = 0; s2 < 2; ++s2) { u32x4 w; w.x = cvt_pk_bf16(A[8 * s2 + 0], A[8 * s2 + 1]); w.y = cvt_pk_bf16(A[8 * s2 + 2], A[8 * s2 + 3]); w.z = cvt_pk_bf16(A[8 * s2 + 4], A[8 * s2 + 5]); w.w = cvt_pk_bf16(A[8 * s2 + 6], A[8 * s2 + 7]);
                        pf[sub * 2 + s2] = __builtin_bit_cast(bf16x8, w); }
                }
#pragma unroll
                for (int ks = 0; ks < 4; ++ks) { const int kb0 = 16 * ks;
#pragma unroll
                    for (int db = 0; db < 4; ++db) { const s16x4 v0 = vtr(vbuf + vb[db] + 256 * kb0), v1 = vtr(vbuf + vb[db] + 256 * (kb0 + 8));
                        const bf16x8 vf = __builtin_shufflevector(v0, v1, 0, 1, 2, 3, 4, 5, 6, 7);
                        o[db] = __builtin_amdgcn_mfma_f32_32x32x16_bf16(vf, pf[ks], o[db], 0, 0, 0); } }
            }
            asm volatile("s_waitcnt lgkmcnt(0)" ::: "memory"); __builtin_amdgcn_s_barrier(); asm volatile("" ::: "memory");
        }
        bf16_t* op = O + (rowbase + t) * DM + h * HD + 4 * hi;
#pragma unroll
        for (int db = 0; db < 4; ++db)
#pragma unroll
            for (int a = 0; a < 4; ++a) { u32x2 w; w.x = cvt_pk_bf16(o[db][4 * a], o[db][4 * a + 1]); w.y = cvt_pk_bf16(o[db][4 * a + 2], o[db][4 * a + 3]); *(u32x2*)(op + 32 * db + 8 * a) = w; }
    }
#undef AT_STAGE
    asm volatile("s_waitcnt vmcnt(0)" ::: "memory"); __builtin_amdgcn_s_barrier();
}

__device__ __forceinline__ void dump_bf16(Frame& F, const bf16_t* src, float* out) {
    const size_t n8 = (size_t)T * DM / 8;
    for (size_t i = (size_t)F.vcu * NTHR + F.tid; i < n8; i += (size_t)F.G * NTHR) {
        const u32x4 v = *(const u32x4*)(src + i * 8);
        f32x4 a = (f32x4){bflo(v.x), bfhi(v.x), bflo(v.y), bfhi(v.y)}, b = (f32x4){bflo(v.z), bfhi(v.z), bflo(v.w), bfhi(v.w)};
        *(f32x4*)(out + i * 8) = a; *(f32x4*)(out + i * 8 + 4) = b;
    }
}

constexpr int N_PHASES = 13;
__global__ void __launch_bounds__(NTHR, 2) fwd(Args args) {
    extern __shared__ __attribute__((aligned(16))) unsigned char lds_raw[];
    Frame F;
    F.lds = (LAS unsigned char*)lds_raw;
    F.tid = threadIdx.x; F.lane = F.tid & 63; F.wave = __builtin_amdgcn_readfirstlane(F.tid >> 6);
    F.G = gridDim.x; { const int bx = blockIdx.x; F.vcu = (F.G % 8 == 0) ? (bx % 8) * (F.G / 8) + bx / 8 : bx; }
    volatile LAS unsigned* MISC = (volatile LAS unsigned*)(F.lds + MISC_OFF);
    if (F.tid < 64) MISC[F.tid] = 0u;
    __syncthreads();
    unsigned* ctl = (unsigned*)(args.ws + WS_CTL);
    XcdBarrier bar; bar.bar = ctl + CW_BAR; bar.x = 0; bar.st = nullptr;
    if (N_LAUNCH_MODE == 1) bar = xcd_barrier_post(ctl + CW_BAR, MISC + 8);
    const int lo = args.ph_lo, hi = args.ph_hi;
#define IN(k) (lo <= (k) && (k) < hi)
#define SEAM(k) do { if (N_LAUNCH_MODE == 1 && IN(k) && IN((k) + 1)) xcd_barrier(bar); } while (0)
    bf16_t* pooled = (bf16_t*)(args.ws + WS_Q);
    bf16_t* h1 = (bf16_t*)(args.ws + WS_K);
    bf16_t* h2 = (bf16_t*)(args.ws + WS_HB);
    bf16_t* h3 = (bf16_t*)(args.ws + WS_HC);

    if (IN(0)) { p0_weights(args, F); p0_pool(args, F, pooled); }
    SEAM(0);
    if (IN(1)) {
        SchedPlain S{(const char*)pooled, (const char*)(args.ws + WS_WPOOL), DM * 2, PGC * 2, T / 256, 8, F.G, F.vcu, 1};
        EpiPool E{args.x, h1};
        pg8::gemm_phase<EpiPool, SchedPlain>(F.lds, PGC, S, E);
    }
    SEAM(1);
    if (IN(2)) router_phase(args, F, h1, 0);
    SEAM(2);
    if (IN(3)) {
        moe_build(args, F, 0, true);
        SchedMoe S{(const char*)h1, (const char*)(args.ws + WS_WGU), DM * 2, (LAS int*)(F.lds + UDESC_OFF), (LAS unsigned*)(F.lds + ROWTAB_OFF), 0, 0};
        EpiSwiGLU E{(const f32x4*)(args.ws + WS_META), (bf16_t*)(args.ws + WS_HMOE), (LAS int*)(F.lds + UDESC_OFF)};
        pg8::gemm_phase<EpiSwiGLU, SchedMoe>(F.lds, DM, S, E);
    }
    SEAM(3);
    if (IN(4)) {
        moe_build(args, F, 0, false);
        SchedMoe S{(const char*)(args.ws + WS_HMOE), (const char*)(args.ws + WS_WD), FF * 2, (LAS int*)(F.lds + UDESC_OFF), (LAS unsigned*)(F.lds + ROWTAB_OFF), 0, 1};
        EpiDown<false> E{(const int*)(args.ws + WS_LIST), h1, (void*)h2, (LAS int*)(F.lds + UDESC_OFF)};
        pg8::gemm_phase<EpiDown<false>, SchedMoe>(F.lds, 2 * FF, S, E);
    }
    SEAM(4);
#if STOP_AFTER == 1
    if (IN(12)) dump_bf16(F, h1, args.out);
#endif
#if STOP_AFTER == 2
    if (IN(12)) dump_bf16(F, h2, args.out);
#endif
#if STOP_AFTER >= 3
    bf16_t* qb_ = (bf16_t*)(args.ws + WS_Q); bf16_t* kb_ = (bf16_t*)(args.ws + WS_K); bf16_t* vb_ = (bf16_t*)(args.ws + WS_V);
    bf16_t* ob_ = (bf16_t*)args.out;
    float* rstd2 = (float*)(args.ws + WS_RSTD);
    if (IN(5)) rstd_phase(F, h2, rstd2);
    SEAM(5);
#ifndef SKIP_QKV
    if (IN(6)) {
        SchedPlain S{(const char*)h2, (const char*)(args.ws + WS_WQKV), DM * 2, DM * 2, T / 256, 24, F.G, F.vcu, 0};
        EpiQKV E{rstd2, args.q_norm, args.k_norm, qb_, kb_, vb_};
        pg8::gemm_phase<EpiQKV, SchedPlain>(F.lds, DM, S, E);
    }
#endif
    SEAM(6);
#ifndef SKIP_ATTN
    if (IN(7)) attn_phase(F, qb_, kb_, vb_, ob_);
#endif
    SEAM(7);
    if (IN(8)) {
        SchedPlain S{(const char*)ob_, (const char*)(args.ws + WS_WO), DM * 2, DM * 2, T / 256, 8, F.G, F.vcu, 0};
        EpiRes E{h2, h3};
        pg8::gemm_phase<EpiRes, SchedPlain>(F.lds, DM, S, E);
    }
    SEAM(8);
#endif
#if STOP_AFTER == 3
    if (IN(12)) dump_bf16(F, h3, args.out);
#endif
#if STOP_AFTER >= 4
    if (IN(9)) router_phase(args, F, h3, 1);
    SEAM(9);
    if (IN(10)) {
        moe_build(args, F, 1, true);
        SchedMoe S{(const char*)h3, (const char*)(args.ws + WS_WGU), DM * 2, (LAS int*)(F.lds + UDESC_OFF), (LAS unsigned*)(F.lds + ROWTAB_OFF), 1, 0};
        EpiSwiGLU E{(const f32x4*)(args.ws + WS_META), (bf16_t*)(args.ws + WS_HMOE), (LAS int*)(F.lds + UDESC_OFF)};
        pg8::gemm_phase<EpiSwiGLU, SchedMoe>(F.lds, DM, S, E);
    }
    SEAM(10);
    if (IN(11)) {
        moe_build(args, F, 1, false);
        SchedMoe S{(const char*)(args.ws + WS_HMOE), (const char*)(args.ws + WS_WD), FF * 2, (LAS int*)(F.lds + UDESC_OFF), (LAS unsigned*)(F.lds + ROWTAB_OFF), 1, 1};
        EpiDown<true> E{(const int*)(args.ws + WS_LIST), h3, (void*)args.out, (LAS int*)(F.lds + UDESC_OFF)};
        pg8::gemm_phase<EpiDown<true>, SchedMoe>(F.lds, 2 * FF, S, E);
    }
#endif
#undef IN
#undef SEAM
}

extern "C" void kernel_launch(void* const* d_in, const int* in_sizes, int n_in, void* d_out, int out_size, void* d_ws, size_t ws_size, hipStream_t stream) {
    static int grid = 0;
    if (grid == 0) {
        if (n_in != 18 || out_size != T * DM || ws_size < WS_END) { fprintf(stderr, "kernel_launch: unexpected sizes (n_in %d out %d ws %zu)\n", n_in, out_size, ws_size); grid = -1; return; }
        int dev = 0, cus = 0, per_cu = 0;
        if (hipGetDevice(&dev) != hipSuccess || hipDeviceGetAttribute(&cus, hipDeviceAttributeMultiprocessorCount, dev) != hipSuccess) { grid = -1; return; }
        if (hipFuncSetAttribute((const void*)fwd, hipFuncAttributeMaxDynamicSharedMemorySize, LDS_BYTES) != hipSuccess) { fprintf(stderr, "kernel_launch: hipFuncSetAttribute failed\n"); grid = -1; return; }
        if (hipOccupancyMaxActiveBlocksPerMultiprocessor(&per_cu, (const void*)fwd, NTHR, LDS_BYTES) != hipSuccess || per_cu < 1) fprintf(stderr, "kernel_launch: occupancy query says %d\n", per_cu);
        (void)hipGetLastError();
        grid = cus;
    }
    if (grid < 0) return;
    hipMemsetAsync((char*)d_ws + WS_CTL, 0, CTL_BYTES, stream);
    Args a{};
    a.x = (const float*)d_in[0]; a.norm_mix = (const float*)d_in[1]; a.norm_ffn = (const float*)d_in[2]; a.pool_w = (const float*)d_in[3]; a.pool_scale = (const float*)d_in[4];
    a.kv_norm = (const float*)d_in[5]; a.w_kv = (const float*)d_in[6]; a.k_norm = (const float*)d_in[7]; a.w_q = (const float*)d_in[8]; a.q_norm = (const float*)d_in[9]; a.w_o = (const float*)d_in[10];
    a.w_grp = (const float*)d_in[11]; a.b_grp = (const float*)d_in[12]; a.w_rt = (const float*)d_in[13]; a.b_rt = (const float*)d_in[14]; a.w_gate = (const float*)d_in[15]; a.w_up = (const float*)d_in[16]; a.w_down = (const float*)d_in[17];
    a.out = (float*)d_out; a.ws = (unsigned char*)d_ws;
    if (N_LAUNCH_MODE == 1) { a.ph_lo = 0; a.ph_hi = N_PHASES; hipLaunchKernelGGL(fwd, dim3(grid), dim3(NTHR), LDS_BYTES, stream, a); }
    else for (int p = 0; p < N_PHASES; ++p) { a.ph_lo = p; a.ph_hi = p + 1; hipLaunchKernelGGL(fwd, dim3(grid), dim3(NTHR), LDS_BYTES, stream, a); }
}
```

```cpp
#include <hip/hip_runtime.h>
#include <cstdio>
#include <cstdint>

#ifndef STOP_AFTER
#define STOP_AFTER 4
#endif
#ifndef N_LAUNCH_MODE
#define N_LAUNCH_MODE 1
#endif

#define LAS __attribute__((address_space(3)))
#define GAS __attribute__((address_space(1)))
typedef unsigned short bf16_t;
typedef short bf16x8 __attribute__((ext_vector_type(8)));
typedef short s16x4 __attribute__((ext_vector_type(4)));
typedef float f32x2 __attribute__((ext_vector_type(2)));
typedef float f32x4 __attribute__((ext_vector_type(4)));
typedef float f32x16 __attribute__((ext_vector_type(16)));
typedef unsigned u32x2 __attribute__((ext_vector_type(2)));
typedef unsigned u32x4 __attribute__((ext_vector_type(4)));

constexpr int BATCH = 16, SEQ = 2048, DM = 2048, T = BATCH * SEQ, NH = 16, HD = 128;
constexpr int NGRP = 4, EPG = 4, NE = 16, FF = 512, NBKT = 24;
constexpr int PGC = 512;
constexpr float EPS = 1e-6f;
constexpr int MAXRT = 152;
constexpr int NWAVES = 8, NTHR = 512;

constexpr size_t MiB = 1u << 20;
constexpr size_t WS_CTL = 0, CTL_BYTES = 1 * MiB;
constexpr size_t WS_WPOOL = 1 * MiB;
constexpr size_t WS_WQKV = 3 * MiB;
constexpr size_t WS_WO = 27 * MiB;
constexpr size_t WS_WGU = 35 * MiB;
constexpr size_t WS_WD = 163 * MiB;
constexpr size_t WS_WR = 227 * MiB;
constexpr size_t WS_RSTD = 228 * MiB;
constexpr size_t WS_LIST = 229 * MiB;
constexpr size_t WS_META = 232 * MiB;
constexpr size_t WS_HMOE = 244 * MiB;
constexpr size_t WS_HB = 320 * MiB;
constexpr size_t WS_HC = 448 * MiB;
constexpr size_t WS_Q = 576 * MiB;
constexpr size_t WS_K = 704 * MiB;
constexpr size_t WS_V = 832 * MiB;
constexpr size_t WS_END = 960 * MiB;
constexpr int CW_BAR = 4096;
constexpr int CW_CNT = 16384;

constexpr int RING_BYTES = 131072;
constexpr int EX_OFF = RING_BYTES;
constexpr int ROWTAB_OFF = EX_OFF + 8192;
constexpr int UDESC_OFF = ROWTAB_OFF + 8192;
constexpr int MISC_OFF = UDESC_OFF + 1024;
constexpr int LDS_BYTES = 151552;
static_assert(MISC_OFF + 256 <= LDS_BYTES, "lds map");
static_assert(WS_V - WS_K == WS_K - WS_Q, "q|k|v spacing");

__device__ __forceinline__ unsigned f2bf(float f) { unsigned u = __builtin_bit_cast(unsigned, f); return (u + 0x7fffu + ((u >> 16) & 1u)) >> 16; }
__device__ __forceinline__ unsigned pk2(float lo, float hi) { return f2bf(lo) | (f2bf(hi) << 16); }
__device__ __forceinline__ float bf2f(unsigned short b) { return __builtin_bit_cast(float, ((unsigned)b) << 16); }
__device__ __forceinline__ float bflo(unsigned w) { return __builtin_bit_cast(float, w << 16); }
__device__ __forceinline__ float bfhi(unsigned w) { return __builtin_bit_cast(float, w & 0xffff0000u); }
__device__ __forceinline__ unsigned cvt_pk_bf16(float lo, float hi) { unsigned r; asm volatile("v_cvt_pk_bf16_f32 %0, %1, %2" : "=v"(r) : "v"(lo), "v"(hi)); return r; }
__device__ __forceinline__ float wave_sum(float v) {
#pragma unroll
    for (int o = 1; o < 64; o <<= 1) v += __shfl_xor(v, o);
    return v;
}
#define LDS_WAIT() asm volatile("s_waitcnt lgkmcnt(0)" ::: "memory")
#define VM_WAIT() asm volatile("s_waitcnt vmcnt(0)" ::: "memory")

#define XB_TMO      128
#define XB_XCNT(j)  (256  + 64 * (j))
#define XB_XSUB(j)  (1280 + 64 * (j))
#define XB_XGEN(j)  (2304 + 64 * (j))
#define XB_TOP      3328
#define XB_TOPGEN   3392
#define XCD_BAR_WORDS 3456
#define XB_SPIN_CAP (1u << 18)
__device__ __forceinline__ unsigned xb_ld(unsigned* p)              { return __hip_atomic_load(p, __ATOMIC_RELAXED, __HIP_MEMORY_SCOPE_AGENT); }
__device__ __forceinline__ unsigned xb_add(unsigned* p, unsigned v) { return __hip_atomic_fetch_add(p, v, __ATOMIC_RELAXED, __HIP_MEMORY_SCOPE_AGENT); }
__device__ __forceinline__ unsigned xb_xcc_id() { return (unsigned)__builtin_amdgcn_s_getreg((3 << 11) | 20) & 0xFu; }
#define XB_SPIN(cond, bar) do { unsigned _sp = 0; while (cond) { __builtin_amdgcn_s_sleep(1); \
    if ((++_sp & 255u) == 0u) { if (xb_ld(&(bar)[XB_TMO])) break; if (_sp > XB_SPIN_CAP) { atomicAdd(&(bar)[XB_TMO], 1u); break; } } } } while (0)
struct XcdBarrier { unsigned* bar; unsigned x; volatile LAS unsigned* st; };
__device__ __forceinline__ XcdBarrier xcd_barrier_post(unsigned* bar, volatile LAS unsigned* st) {
    XcdBarrier b; b.bar = bar; b.x = xb_xcc_id(); b.st = st;
    if (threadIdx.x == 0) (void)xb_add(&bar[XB_XCNT(b.x)], 1u);
    return b;
}
__device__ __forceinline__ void xcd_barrier_complete(unsigned* bar, unsigned x, unsigned& nloc, unsigned& nx) {
    const unsigned G = gridDim.x * gridDim.y * gridDim.z;
    unsigned sum, cnt, mine, sp = 0u;
    for (;;) {
        sum = 0u; cnt = 0u; mine = 0u;
#pragma unroll
        for (unsigned j = 0; j < 16; ++j) { const unsigned c = xb_ld(&bar[XB_XCNT(j)]); sum += c; cnt += (c > 0u) ? 1u : 0u; mine = (j == x) ? c : mine; }
        if (sum == G) break;
        __builtin_amdgcn_s_sleep(1);
        if ((++sp & 255u) == 0u) { if (xb_ld(&bar[XB_TMO])) break; if (sp > XB_SPIN_CAP) { atomicAdd(&bar[XB_TMO], 1u); break; } }
    }
    nloc = mine > 0u ? mine : 1u; nx = cnt > 0u ? cnt : 1u;
}
__device__ __forceinline__ void xcd_barrier(const XcdBarrier& b) {
    asm volatile("s_waitcnt vmcnt(0)" ::: "memory");
    __syncthreads();
    if (threadIdx.x == 0) {
        unsigned* bar = b.bar;
        __builtin_amdgcn_s_waitcnt(0);
        unsigned nloc = b.st[0], nx = b.st[1];
        if (nloc == 0u) { xcd_barrier_complete(bar, b.x, nloc, nx); b.st[0] = nloc; b.st[1] = nx; }
        const unsigned old = xb_add(&bar[XB_XSUB(b.x)], 1u);
        const unsigned gen = old / nloc;
        if (old + 1u == (gen + 1u) * nloc) {
            __builtin_amdgcn_fence(__ATOMIC_RELEASE, "agent");
            asm volatile("s_waitcnt vmcnt(0)" ::: "memory");
            const unsigned og = xb_add(&bar[XB_TOP], 1u);
            const unsigned tg = og / nx;
            if (og + 1u == (tg + 1u) * nx) xb_add(&bar[XB_TOPGEN], 1u);
            else XB_SPIN(xb_ld(&bar[XB_TOPGEN]) == tg, bar);
            __builtin_amdgcn_fence(__ATOMIC_ACQUIRE, "agent");
            xb_add(&bar[XB_XGEN(b.x)], 1u);
            asm volatile("s_waitcnt vmcnt(0)" ::: "memory");
        } else {
            XB_SPIN(xb_ld(&bar[XB_XGEN(b.x)]) == gen, bar);
            __builtin_amdgcn_fence(__ATOMIC_ACQUIRE, "agent");
            asm volatile("s_waitcnt vmcnt(0)" ::: "memory");
        }
    }
    __syncthreads();
}

namespace pg8 {
constexpr int BM = 256, BK = 64, HALF = 128, HTB = HALF * BK * 2, STAGE_BYTES = 8 * HTB;
__host__ __device__ __forceinline__ int lds_byte(int r, int c) { const int st = (r >> 4) * 2 + (c >> 5), rr = r & 15, cc = c & 31, ob = rr * 64 + cc * 2; return st * 1024 + (ob ^ (((ob >> 9) & 1) << 5)); }
__host__ __device__ __forceinline__ void stage_rc(int b, int& R, int& C) { const int st = b / 1024, sb = b % 1024, swz = sb ^ (((sb >> 9) & 1) << 5); R = (st >> 1) * 16 + swz / 64; C = (st & 1) * 32 + (swz % 64) / 2; }
__host__ __device__ __forceinline__ int perm32(int rho) { const int n = rho >> 4, i = rho & 15; return 8 * (i >> 2) + 4 * n + (i & 3); }

struct Unit { int j, pm, pn, aux; };

template <class Epi, class Sched>
__device__ __forceinline__ void gemm_phase(LAS unsigned char* lds, const int K, const Sched& S, const Epi& E) {
    const int tid = threadIdx.x, wid = __builtin_amdgcn_readfirstlane(tid >> 6), lane = tid & 63, wr = wid >> 2, wc = wid & 3, fr = lane & 15, fq = lane >> 4;
    const int nt = K / BK;
    int Rl[2], Cl2[2]; unsigned voffB[2];
#pragma unroll
    for (int i = 0; i < 2; ++i) { int R, C; stage_rc(tid * 16 + i * 8192, R, C); Rl[i] = R; Cl2[i] = C * 2; const int Rb = (R & ~31) + perm32(R & 31); voffB[i] = (unsigned)Rb * S.ldb_bytes + (unsigned)C * 2u; }
    const size_t kstep = (size_t)(BK * 2);
    const size_t hstepB = (size_t)HALF * S.ldb_bytes;
    const unsigned ldsw = (unsigned)wid * 1024u;
    const int aoff = lds_byte(wr * 64 + fr, fq * 8), boff = lds_byte(wc * 32 + fr, fq * 8);
#define PG8_SA(b, h) (((b) * 2 + (h)) * HTB)
#define PG8_SB(b, h) ((4 + (b) * 2 + (h)) * HTB)
#define PG8_STAGEB(bufoff, gbase) do { _Pragma("unroll") for (int _i = 0; _i < 2; ++_i) \
        __builtin_amdgcn_global_load_lds((const unsigned*)((const char*)(gbase) + voffB[_i]), (LAS unsigned*)(lds + (bufoff) + ldsw + _i * 8192), 16, 0, 0); } while (0)
#define PG8_STAGEA(bufoff, offs, h, kb) do { _Pragma("unroll") for (int _i = 0; _i < 2; ++_i) \
        __builtin_amdgcn_global_load_lds((const unsigned*)(S.A + (kb) + (offs)[(h) * 2 + _i]), (LAS unsigned*)(lds + (bufoff) + ldsw + _i * 8192), 16, 0, 0); } while (0)
#define PG8_LDA(dst, b, h) do { _Pragma("unroll") for (int m = 0; m < 4; ++m) _Pragma("unroll") for (int k = 0; k < 2; ++k) dst[m][k] = *(const LAS bf16x8*)(lds + PG8_SA(b, h) + aoff + m * 2048 + k * 1024); } while (0)
#define PG8_LDB(dst, b, h) do { _Pragma("unroll") for (int n = 0; n < 2; ++n) _Pragma("unroll") for (int k = 0; k < 2; ++k) dst[n][k] = *(const LAS bf16x8*)(lds + PG8_SB(b, h) + boff + n * 2048 + k * 1024); } while (0)
#define PG8_MMA(ai, bj, At, Bt) do { __builtin_amdgcn_s_setprio(1); _Pragma("unroll") for (int m = 0; m < 4; ++m) _Pragma("unroll") for (int n = 0; n < 2; ++n) _Pragma("unroll") for (int k = 0; k < 2; ++k) \
        acc[ai][bj][m][n] = __builtin_amdgcn_mfma_f32_16x16x32_bf16(Bt[n][k], At[m][k], acc[ai][bj][m][n], 0, 0, 0); __builtin_amdgcn_s_setprio(0); } while (0)
#define PG8_WAIT_V(n) asm volatile("s_waitcnt vmcnt(" #n ")" ::: "memory")
#define PG8_WAIT_L(n) asm volatile("s_waitcnt lgkmcnt(" #n ")" ::: "memory")
#define PG8_BAR __builtin_amdgcn_s_barrier()
#define PG8_SCHED __builtin_amdgcn_sched_barrier(0)
#define PG8_OFFS(dst, u) do { _Pragma("unroll") for (int _h = 0; _h < 2; ++_h) _Pragma("unroll") for (int _i = 0; _i < 2; ++_i) dst[_h * 2 + _i] = S.row_off(u, _h * HALF + Rl[_i]) + (unsigned)Cl2[_i]; } while (0)
    Unit cur, nxt; int ui = 0;
    if (!S.next(0, cur)) return;
    f32x4 acc[2][2][4][2];
#pragma unroll
    for (int a = 0; a < 2; ++a)
#pragma unroll
        for (int b = 0; b < 2; ++b)
#pragma unroll
            for (int m = 0; m < 4; ++m)
#pragma unroll
                for (int n = 0; n < 2; ++n) acc[a][b][m][n] = (f32x4){0.f, 0.f, 0.f, 0.f};
    bf16x8 At[4][2], B0[2][2], B1[2][2];
    unsigned offC[4], offN[4];
    PG8_OFFS(offC, cur);
#pragma unroll
    for (int q = 0; q < 4; ++q) offN[q] = offC[q];
    const char* cB0 = S.b_ptr(cur, 0); const char* cB1 = S.b_ptr(cur, 1);
    PG8_STAGEB(PG8_SB(0, 0), cB0); PG8_STAGEB(PG8_SB(0, 1), cB0 + hstepB); PG8_STAGEA(PG8_SA(0, 0), offC, 0, 0); PG8_STAGEA(PG8_SA(0, 1), offC, 1, 0);
    if (wr == 1) PG8_BAR;
    PG8_WAIT_V(2); PG8_BAR;
    PG8_STAGEB(PG8_SB(1, 0), cB1); PG8_STAGEA(PG8_SA(1, 0), offC, 0, kstep); PG8_STAGEB(PG8_SB(1, 1), cB1 + hstepB);
    PG8_WAIT_V(6); PG8_BAR;
    for (;;) {
        const bool has_next = S.next(ui + 1, nxt);
        if (!has_next) nxt = cur;
        for (int t = 0; t < nt; t += 2) {
            const bool last = (t == nt - 2);
            const size_t a1 = (size_t)(t + 1) * kstep;
            const size_t a2 = last ? (size_t)0 : (size_t)(t + 2) * kstep; const size_t a3 = a2 + kstep;
            const char* b2 = last ? S.b_ptr(nxt, 0) : S.b_ptr(cur, t + 2);
            const char* b3 = last ? S.b_ptr(nxt, 1) : S.b_ptr(cur, t + 3);
            if (last && has_next) { PG8_OFFS(offN, nxt); }
            PG8_LDB(B0, 0, 0); PG8_LDB(B1, 0, 1); PG8_SCHED; PG8_LDA(At, 0, 0); PG8_STAGEA(PG8_SA(1, 1), offC, 1, a1);
            PG8_WAIT_V(8); PG8_WAIT_L(0); PG8_BAR; PG8_MMA(0, 0, At, B0); PG8_MMA(0, 1, At, B1); PG8_BAR; PG8_SCHED;
            PG8_LDA(At, 0, 1); PG8_STAGEB(PG8_SB(0, 0), b2); PG8_STAGEB(PG8_SB(0, 1), b2 + hstepB); PG8_STAGEA(PG8_SA(0, 0), offN, 0, a2);
            PG8_WAIT_V(8); PG8_WAIT_L(0); PG8_BAR; PG8_MMA(1, 0, At, B0); PG8_MMA(1, 1, At, B1); PG8_BAR; PG8_SCHED;
            PG8_LDB(B0, 1, 0); PG8_LDB(B1, 1, 1); PG8_SCHED; PG8_LDA(At, 1, 0); PG8_STAGEA(PG8_SA(0, 1), offN, 1, a2);
            PG8_WAIT_V(8); PG8_WAIT_L(0); PG8_BAR; PG8_MMA(0, 0, At, B0); PG8_MMA(0, 1, At, B1); PG8_BAR; PG8_SCHED;
            PG8_LDA(At, 1, 1); PG8_STAGEB(PG8_SB(1, 0), b3); PG8_STAGEB(PG8_SB(1, 1), b3 + hstepB); PG8_STAGEA(PG8_SA(1, 0), offN, 0, a3);
            PG8_WAIT_V(8); PG8_WAIT_L(0); PG8_BAR; PG8_MMA(1, 0, At, B0); PG8_MMA(1, 1, At, B1); PG8_BAR; PG8_SCHED;
        }
        if (wr == 0) PG8_BAR;
        E(acc, cur, wr, wc, fr, fq, lds);
        if (!has_next) break;
#pragma unroll
        for (int a = 0; a < 2; ++a)
#pragma unroll
            for (int b = 0; b < 2; ++b)
#pragma unroll
                for (int m = 0; m < 4; ++m)
#pragma unroll
                    for (int n = 0; n < 2; ++n) acc[a][b][m][n] = (f32x4){0.f, 0.f, 0.f, 0.f};
        cur = nxt; ++ui;
#pragma unroll
        for (int q = 0; q < 4; ++q) offC[q] = offN[q];
        if (wr == 1) PG8_BAR;
    }
    PG8_WAIT_V(0);
    PG8_BAR;
#undef PG8_SA
#undef PG8_SB
#undef PG8_STAGEA
#undef PG8_STAGEB
#undef PG8_LDA
#undef PG8_LDB
#undef PG8_MMA
#undef PG8_WAIT_V
#undef PG8_WAIT_L
#undef PG8_BAR
#undef PG8_SCHED
#undef PG8_OFFS
}
}

struct Args {
    const float* x; const float* norm_mix; const float* norm_ffn; const float* pool_w; const float* pool_scale; const float* kv_norm; const float* w_kv; const float* k_norm;
    const float* w_q; const float* q_norm; const float* w_o; const float* w_grp; const float* b_grp; const float* w_rt; const float* b_rt; const float* w_gate; const float* w_up; const float* w_down;
    float* out; unsigned char* ws; int ph_lo, ph_hi;
};
struct Frame {
    LAS unsigned char* lds; int tid, lane, wave, vcu, G;
};

__device__ __forceinline__ void transpose_item(const float* W, int ldw, const float* gk, const float* gn, bf16_t* WT, int ldk, int k0, int n0, int drow0, LAS float* scr, int lane) {
    const float gnv = gn ? gn[n0 + (lane & 31)] : 1.f;
#pragma unroll 8
    for (int i = 0; i < 32; ++i) { const int kk = 2 * i + (lane >> 5); const float g = (gk ? gk[k0 + kk] : 1.f) * gnv; scr[kk * 33 + (lane & 31)] = W[(size_t)(k0 + kk) * ldw + n0 + (lane & 31)] * g; }
    LDS_WAIT(); asm volatile("" ::: "memory");
    const int c = lane & 7;
#pragma unroll
    for (int j = 0; j < 4; ++j) { const int n = (lane >> 3) + 8 * j; const LAS float* s = scr + (8 * c) * 33 + n;
        u32x4 o; o.x = pk2(s[0 * 33], s[1 * 33]); o.y = pk2(s[2 * 33], s[3 * 33]); o.z = pk2(s[4 * 33], s[5 * 33]); o.w = pk2(s[6 * 33], s[7 * 33]);
        *(u32x4*)(WT + (size_t)(drow0 + n) * ldk + k0 + 8 * c) = o; }
    LDS_WAIT(); asm volatile("" ::: "memory");
}

__device__ __forceinline__ void p0_weights(const Args& a, Frame& F) {
    LAS float* scr = (LAS float*)(F.lds + F.wave * 16384);
    const int gw = F.vcu * NWAVES + F.wave, NGW = F.G * NWAVES;
    bf16_t* Wpool = (bf16_t*)(a.ws + WS_WPOOL); bf16_t* Wqkv = (bf16_t*)(a.ws + WS_WQKV); bf16_t* Wo = (bf16_t*)(a.ws + WS_WO);
    bf16_t* Wgu = (bf16_t*)(a.ws + WS_WGU); bf16_t* Wd = (bf16_t*)(a.ws + WS_WD);
    constexpr int I_POOL = 4 * 8 * 16, I_Q = 32 * 64, I_KV = 32 * 128, I_O = 32 * 64, I_G = 32 * 32 * 16  , I_D = 32 * 8 * 64;
    constexpr int NITEMS = I_POOL + I_Q + I_KV + I_O + 2 * I_G + I_D;
    for (int it = gw; it < NITEMS; it += NGW) {
        int r = it;
        if (r < I_POOL) { const int g = r / 128, rr = r % 128, kb = rr / 16, nb = rr % 16;
            transpose_item(a.pool_w + (size_t)g * PGC * PGC, PGC, a.norm_mix + g * PGC, a.pool_scale + g * PGC, Wpool + (size_t)g * PGC * PGC, PGC, 64 * kb, 32 * nb, 32 * nb, scr, F.lane); continue; } r -= I_POOL;
        if (r < I_Q) { const int kb = r / 64, nb = r % 64; transpose_item(a.w_q, DM, a.norm_mix + DM, nullptr, Wqkv, DM, 64 * kb, 32 * nb, 32 * nb, scr, F.lane); continue; } r -= I_Q;
        if (r < I_KV) { const int kb = r / 128, nb = r % 128; transpose_item(a.w_kv, 2 * DM, a.kv_norm, nullptr, Wqkv + (size_t)DM * DM, DM, 64 * kb, 32 * nb, 32 * nb, scr, F.lane); continue; } r -= I_KV;
        if (r < I_O) { const int kb = r / 64, nb = r % 64; transpose_item(a.w_o, DM, nullptr, nullptr, Wo, DM, 64 * kb, 32 * nb, 32 * nb, scr, F.lane); continue; } r -= I_O;
        if (r < 2 * I_G) { const int which = r / I_G; r %= I_G; const int le = r / 512, rr = r % 512, kb = rr / 16, nb = rr % 16;
            const int f0 = 32 * nb, drow0 = (f0 >> 7) * 256 + which * 128 + (f0 & 127);
            transpose_item((which ? a.w_up : a.w_gate) + (size_t)le * DM * FF, FF, a.norm_ffn + (le >> 4) * DM, nullptr, Wgu + (size_t)le * 1024 * DM, DM, 64 * kb, f0, drow0, scr, F.lane); continue; } r -= 2 * I_G;
        { const int le = r / 512, rr = r % 512, kb = rr / 64, nb = rr % 64;
            transpose_item(a.w_down + (size_t)le * FF * DM, DM, nullptr, nullptr, Wd + (size_t)le * DM * FF, FF, 64 * kb, 32 * nb, 32 * nb, scr, F.lane); }
    }
    bf16_t* Wr = (bf16_t*)(a.ws + WS_WR);
    for (int idx = (F.vcu * NTHR + F.tid); idx < 2 * 32 * DM; idx += F.G * NTHR) {
        const int l = idx / (32 * DM), rr = (idx / DM) % 32, k = idx % DM; float v = 0.f;
        if (rr < 16) v = a.w_rt[(((size_t)l * NGRP + (rr >> 2)) * DM + k) * EPG + (rr & 3)];
        else if (rr < 20) v = a.w_grp[((size_t)l * DM + k) * NGRP + (rr - 16)];
        v *= a.norm_ffn[l * DM + k];
        const unsigned hi = f2bf(v); const float rem = v - __builtin_bit_cast(float, hi << 16);
        Wr[idx] = (bf16_t)hi; Wr[2 * 32 * DM + idx] = (bf16_t)f2bf(rem);
    }
}

__device__ __forceinline__ void p0_pool(const Args& a, Frame& F, bf16_t* pooled) {
    constexpr int TC = 64;
    LAS float* rs = (LAS float*)(F.lds);
    const int c0 = F.tid * 4, gi = c0 / PGC, w = 2 << gi;
    for (int u = F.vcu; u < T / TC; u += F.G) {
        const int b = u / (SEQ / TC), t0 = (u % (SEQ / TC)) * TC;
        const float* xb = a.x + (size_t)b * SEQ * DM;
        __syncthreads();
        for (int r = F.wave - 16 + 0; r < TC; r += NWAVES) {
            const int t = t0 + r; float ss = 0.f;
            if (t >= 0) { const f32x4* xr = (const f32x4*)(xb + (size_t)t * DM) + F.lane;
#pragma unroll
                for (int j = 0; j < 8; ++j) { const f32x4 v = xr[64 * j]; ss += (v.x * v.x + v.y * v.y) + (v.z * v.z + v.w * v.w); }
                ss = wave_sum(ss); }
            if (F.lane == 0) rs[r + 16] = (t >= 0) ? 1.0f / sqrtf(ss * (1.0f / DM) + EPS) : 0.f;
        }
        __syncthreads();
        f32x4 S = (f32x4){0.f, 0.f, 0.f, 0.f};
        for (int r = -(w - 1); r < 0; ++r) { const int t = t0 + r; if (t >= 0) { const f32x4 v = *(const f32x4*)(xb + (size_t)t * DM + c0); S += v * rs[r + 16]; } }
        for (int r = 0; r < TC; ++r) {
            const int t = t0 + r;
            const f32x4 cur = *(const f32x4*)(xb + (size_t)t * DM + c0) * rs[r + 16];
            S += cur;
            const float inv = 1.0f / (float)((t + 1 < w) ? (t + 1) : w);
            const f32x4 p = S * inv - cur;
            u32x2 o; o.x = pk2(p.x, p.y); o.y = pk2(p.z, p.w);
            *(u32x2*)(pooled + ((size_t)b * SEQ + t) * DM + c0) = o;
            const int tw = t - w + 1;
            if (tw >= 0) { const f32x4 v = *(const f32x4*)(xb + (size_t)tw * DM + c0); S -= v * rs[r - w + 1 + 16]; }
        }
    }
    __syncthreads();
}

struct SchedPlain {
    const char* A; const char* B; unsigned lda_bytes, ldb_bytes; int nM, nN, G, vcu; int pool;
    __device__ __forceinline__ bool next(int i, pg8::Unit& u) const { const int L = i * G + vcu; if (L >= nM * nN) return false; u.j = i; u.pm = L / nN; u.pn = L % nN; u.aux = 0; return true; }
    __device__ __forceinline__ unsigned row_off(const pg8::Unit& u, int r) const { return (unsigned)(u.pm * 256 + r) * lda_bytes + (pool ? (unsigned)(u.pn >> 1) * (PGC * 2) : 0u); }
    __device__ __forceinline__ const char* b_ptr(const pg8::Unit& u, int kt) const { return B + (size_t)u.pn * 256 * ldb_bytes + (size_t)kt * 128; }
};

struct EpiPool {
    const float* x; bf16_t* out;
    __device__ __forceinline__ void operator()(const f32x4 (&acc)[2][2][4][2], const pg8::Unit& u, int wr, int wc, int fr, int fq, LAS unsigned char*) const {
        const int row0 = u.pm * 256 + wr * 64 + fr, col0 = u.pn * 256 + wc * 32 + 8 * fq;
#pragma unroll
        for (int ai = 0; ai < 2; ++ai)
#pragma unroll
            for (int m = 0; m < 4; ++m) { const size_t ro = (size_t)(row0 + ai * 128 + m * 16) * DM + col0;
#pragma unroll
                for (int bj = 0; bj < 2; ++bj) { const f32x4 x0 = *(const f32x4*)(x + ro + bj * 128), x1 = *(const f32x4*)(x + ro + bj * 128 + 4);
                    const f32x4 v0 = acc[ai][bj][m][0] + x0, v1 = acc[ai][bj][m][1] + x1;
                    u32x4 w; w.x = cvt_pk_bf16(v0[0], v0[1]); w.y = cvt_pk_bf16(v0[2], v0[3]); w.z = cvt_pk_bf16(v1[0], v1[1]); w.w = cvt_pk_bf16(v1[2], v1[3]);
                    *(u32x4*)(out + ro + bj * 128) = w; } }
    }
};


__device__ __forceinline__ void bucket_experts(int b, int& ge_lo, int& ge_hi) { const int g = b / 6, p = b % 6; const int el = p < 3 ? 0 : (p < 5 ? 1 : 2), eh = p < 3 ? p + 1 : (p < 5 ? p - 1 : 3); ge_lo = g * 4 + el; ge_hi = g * 4 + eh; }
__device__ __forceinline__ void router_phase(const Args& a, Frame& F, const bf16_t* h, int layer) {
    const bf16_t* Wh = (const bf16_t*)(a.ws + WS_WR) + (size_t)layer * 32 * DM; const bf16_t* Wl = Wh + (size_t)2 * 32 * DM;
    unsigned* cnt = (unsigned*)(a.ws + WS_CTL) + CW_CNT + layer * NBKT * 64;
    int* list = (int*)(a.ws + WS_LIST); f32x4* meta = (f32x4*)(a.ws + WS_META);
    LAS float* lg = (LAS float*)(F.lds + F.wave * 2048);
    const int gw = F.vcu * NWAVES + F.wave, NGW = F.G * NWAVES, tk = F.lane & 15, q = F.lane >> 4;
    for (int tile = gw; tile < T / 16; tile += NGW) {
        const int tok0 = tile * 16;
        f32x4 c0 = {0.f, 0.f, 0.f, 0.f}, c1 = c0, css = c0;
        const bf16_t* hp = h + (size_t)(tok0 + tk) * DM + 8 * q; const bf16_t* w0 = Wh + (size_t)tk * DM + 8 * q; const bf16_t* w0l = Wl + (size_t)tk * DM + 8 * q;
#pragma unroll 4
        for (int s = 0; s < DM / 32; ++s) {
            const bf16x8 hf = *(const bf16x8*)(hp + 32 * s);
            const bf16x8 a0 = *(const bf16x8*)(w0 + 32 * s), a0l = *(const bf16x8*)(w0l + 32 * s), a1 = *(const bf16x8*)(w0 + 16 * DM + 32 * s), a1l = *(const bf16x8*)(w0l + 16 * DM + 32 * s);
            c0 = __builtin_amdgcn_mfma_f32_16x16x32_bf16(a0, hf, c0, 0, 0, 0); c0 = __builtin_amdgcn_mfma_f32_16x16x32_bf16(a0l, hf, c0, 0, 0, 0);
            c1 = __builtin_amdgcn_mfma_f32_16x16x32_bf16(a1, hf, c1, 0, 0, 0); c1 = __builtin_amdgcn_mfma_f32_16x16x32_bf16(a1l, hf, c1, 0, 0, 0);
            css = __builtin_amdgcn_mfma_f32_16x16x32_bf16(hf, hf, css, 0, 0, 0);
        }
#pragma unroll
        for (int r = 0; r < 4; ++r) lg[tk * 24 + 4 * q + r] = c0[r];
        if (q == 0) {
#pragma unroll
            for (int r = 0; r < 4; ++r) lg[tk * 24 + 16 + r] = c1[r]; }
        if (q == (tk >> 2)) { const int rr = tk & 3; lg[384 + tk] = rr == 0 ? css[0] : (rr == 1 ? css[1] : (rr == 2 ? css[2] : css[3])); }
        LDS_WAIT(); asm volatile("" ::: "memory");
        if (F.lane < 16) {
            const float rstd = 1.0f / sqrtf(lg[384 + tk] * (1.0f / DM) + EPS);
            float gl[4], el[4];
#pragma unroll
            for (int g = 0; g < 4; ++g) gl[g] = lg[tk * 24 + 16 + g] * rstd + a.b_grp[layer * NGRP + g];
            int gs = 0; float gm = gl[0];
#pragma unroll
            for (int g = 1; g < 4; ++g) if (gl[g] > gm) { gm = gl[g]; gs = g; }
            float den = 0.f;
#pragma unroll
            for (int g = 0; g < 4; ++g) den += __expf(gl[g] - gm);
            const float gwt = 1.0f / den;
#pragma unroll
            for (int e = 0; e < 4; ++e) el[e] = lg[tk * 24 + gs * 4 + e] * rstd + a.b_rt[(layer * NGRP + gs) * EPG + e];
            int i1 = 0; float v1 = el[0];
#pragma unroll
            for (int e = 1; e < 4; ++e) if (el[e] > v1) { v1 = el[e]; i1 = e; }
            int i2 = -1; float v2 = -3.0e38f;
#pragma unroll
            for (int e = 0; e < 4; ++e) if (e != i1 && el[e] > v2) { v2 = el[e]; i2 = e; }
            const float w1 = gwt / (1.0f + __expf(v2 - v1)), w2 = gwt - w1;
            const int elo = i1 < i2 ? i1 : i2, ehi = i1 < i2 ? i2 : i1; const float wlo = i1 < i2 ? w1 : w2, whi = i1 < i2 ? w2 : w1;
            const int pidx = elo == 0 ? ehi - 1 : (elo == 1 ? ehi + 1 : 5);
            const int b = gs * 6 + pidx;
            const unsigned pos = __hip_atomic_fetch_add(cnt + b * 64, 1u, __ATOMIC_RELAXED, __HIP_MEMORY_SCOPE_AGENT);
            list[(size_t)b * T + pos] = tok0 + tk;
            meta[(size_t)b * T + pos] = (f32x4){rstd, wlo, whi, 0.f};
        }
        LDS_WAIT(); asm volatile("" ::: "memory");
    }
}

constexpr int MAXU = 8;
struct MoeTab { LAS int* ud; LAS unsigned* rowtab; };
__device__ __forceinline__ void moe_build(const Args& a, Frame& F, int layer, bool gather) {
    LAS int* ud = (LAS int*)(F.lds + UDESC_OFF); LAS int* tb = ud + MAXU * 8;
    LAS unsigned* rowtab = (LAS unsigned*)(F.lds + ROWTAB_OFF);
    const unsigned* cnt = (const unsigned*)(a.ws + WS_CTL) + CW_CNT + layer * NBKT * 64;
    const int* list = (const int*)(a.ws + WS_LIST);
    __syncthreads();
    if (F.tid == 0) { int base = 0; for (int b = 0; b < NBKT; ++b) { const int c = (int)__hip_atomic_load(cnt + b * 64, __ATOMIC_RELAXED, __HIP_MEMORY_SCOPE_AGENT); tb[b] = base; tb[32 + b] = c; base += (c + 255) >> 8; } tb[NBKT] = base; }
    __syncthreads();
    if (F.tid < MAXU) { const int i = F.tid, L = i * F.G + F.vcu, R = tb[NBKT]; int v = 0, rt = 0, pn = 0, b = 0, ti = 0, nv = 0;
        if (L < 8 * R) { v = 1; rt = L >> 3; pn = L & 7; while (tb[b + 1] <= rt) ++b; ti = rt - tb[b]; nv = tb[32 + b] - 256 * ti; if (nv > 256) nv = 256; }
        ud[i * 8 + 0] = rt; ud[i * 8 + 1] = pn; ud[i * 8 + 2] = b; ud[i * 8 + 3] = ti; ud[i * 8 + 4] = nv; ud[i * 8 + 5] = v; }
    __syncthreads();
    if (gather) for (int e = F.tid; e < MAXU * 256; e += NTHR) { const int i = e >> 8, r = e & 255; unsigned off = 0;
        if (ud[i * 8 + 5]) { const int b = ud[i * 8 + 2], ti = ud[i * 8 + 3], nv = ud[i * 8 + 4]; const int rr = r < nv ? r : nv - 1; off = (unsigned)list[(size_t)b * T + 256 * ti + rr] * (unsigned)(DM * 2); }
        rowtab[e] = off; }
    VM_WAIT(); __syncthreads();
}
__device__ __forceinline__ int rfl(int v) { return __builtin_amdgcn_readfirstlane(v); }
struct SchedMoe {
    const char* A; const char* W; unsigned ldb_bytes; LAS int* ud; LAS unsigned* rowtab; int layer; int down;
    __device__ __forceinline__ bool next(int i, pg8::Unit& u) const { if (i >= MAXU) return false; if (!rfl(ud[i * 8 + 5])) return false; u.j = i; u.pm = rfl(ud[i * 8 + 0]); u.pn = rfl(ud[i * 8 + 1]); u.aux = rfl(ud[i * 8 + 2]); return true; }
    __device__ __forceinline__ unsigned row_off(const pg8::Unit& u, int r) const { return down ? (unsigned)(u.pm * 256 + r) * (unsigned)(2 * FF * 2) : rowtab[u.j * 256 + r]; }
    __device__ __forceinline__ const char* b_ptr(const pg8::Unit& u, int kt) const {
        int gl, gh; bucket_experts(u.aux, gl, gh);
        if (!down) { const int ge = u.pn < 4 ? gl : gh; return W + ((size_t)(layer * NE + ge) * 1024 + (size_t)(u.pn & 3) * 256) * (size_t)(DM * 2) + (size_t)kt * 128; }
        const int ge = kt < 8 ? gl : gh; return W + ((size_t)(layer * NE + ge) * DM + (size_t)u.pn * 256) * (size_t)(FF * 2) + (size_t)(kt & 7) * 128;
    }
};
struct EpiSwiGLU {
    const f32x4* meta; bf16_t* H; LAS int* ud;
    __device__ __forceinline__ void operator()(const f32x4 (&acc)[2][2][4][2], const pg8::Unit& u, int wr, int wc, int fr, int fq, LAS unsigned char*) const {
        const int b = u.aux, ti = rfl(ud[u.j * 8 + 3]);
        const size_t mrow0 = (size_t)b * T + 256 * ti; const int hi = u.pn >> 2;
        const int hcol = hi * 512 + (u.pn & 3) * 128 + wc * 32 + 8 * fq;
#pragma unroll
        for (int ai = 0; ai < 2; ++ai)
#pragma unroll
            for (int m = 0; m < 4; ++m) { const int r = ai * 128 + wr * 64 + m * 16 + fr; const f32x4 mt = meta[mrow0 + r]; const float rstd = mt.x, w = hi ? mt.z : mt.y;
                float o[8];
#pragma unroll
                for (int n = 0; n < 2; ++n)
#pragma unroll
                    for (int j = 0; j < 4; ++j) { const float g = acc[ai][0][m][n][j] * rstd, up = acc[ai][1][m][n][j] * rstd; o[n * 4 + j] = g * __builtin_amdgcn_rcpf(1.0f + __expf(-g)) * up * w; }
                u32x4 pk; pk.x = cvt_pk_bf16(o[0], o[1]); pk.y = cvt_pk_bf16(o[2], o[3]); pk.z = cvt_pk_bf16(o[4], o[5]); pk.w = cvt_pk_bf16(o[6], o[7]);
                *(u32x4*)(H + (size_t)(u.pm * 256 + r) * (2 * FF) + hcol) = pk; }
    }
};
template <bool OUT_F32> struct EpiDown {
    const int* list; const bf16_t* hin; void* out; LAS int* ud;
    __device__ __forceinline__ void operator()(const f32x4 (&acc)[2][2][4][2], const pg8::Unit& u, int wr, int wc, int fr, int fq, LAS unsigned char*) const {
        const int b = u.aux, ti = rfl(ud[u.j * 8 + 3]), nv = rfl(ud[u.j * 8 + 4]);
        const int col0 = u.pn * 256 + wc * 32 + 8 * fq;
#pragma unroll
        for (int ai = 0; ai < 2; ++ai)
#pragma unroll
            for (int m = 0; m < 4; ++m) { const int r = ai * 128 + wr * 64 + m * 16 + fr;
                if (r < nv) { const int tok = list[(size_t)b * T + 256 * ti + r]; const size_t ro = (size_t)tok * DM + col0;
#pragma unroll
                    for (int bj = 0; bj < 2; ++bj) { const u32x4 hv = *(const u32x4*)(hin + ro + bj * 128);
                        const f32x4 v0 = acc[ai][bj][m][0] + (f32x4){bflo(hv.x), bfhi(hv.x), bflo(hv.y), bfhi(hv.y)}, v1 = acc[ai][bj][m][1] + (f32x4){bflo(hv.z), bfhi(hv.z), bflo(hv.w), bfhi(hv.w)};
                        if (OUT_F32) { float* o = (float*)out + ro + bj * 128; *(f32x4*)o = v0; *(f32x4*)(o + 4) = v1; }
                        else { u32x4 w; w.x = cvt_pk_bf16(v0[0], v0[1]); w.y = cvt_pk_bf16(v0[2], v0[3]); w.z = cvt_pk_bf16(v1[0], v1[1]); w.w = cvt_pk_bf16(v1[2], v1[3]); *(u32x4*)((bf16_t*)out + ro + bj * 128) = w; } } } }
    }
};


__device__ __forceinline__ void rstd_phase(Frame& F, const bf16_t* h, float* rstd) {
    const int gw = F.vcu * NWAVES + F.wave, NGW = F.G * NWAVES;
    for (int row = gw; row < T; row += NGW) {
        const u32x4* p = (const u32x4*)(h + (size_t)row * DM) + F.lane; float ss = 0.f;
#pragma unroll
        for (int j = 0; j < 4; ++j) { const u32x4 v = p[64 * j];
            const float a0 = bflo(v.x), a1 = bfhi(v.x), a2 = bflo(v.y), a3 = bfhi(v.y), a4 = bflo(v.z), a5 = bfhi(v.z), a6 = bflo(v.w), a7 = bfhi(v.w);
            ss += (a0 * a0 + a1 * a1) + (a2 * a2 + a3 * a3) + (a4 * a4 + a5 * a5) + (a6 * a6 + a7 * a7); }
        ss = wave_sum(ss);
        if (F.lane == 0) rstd[row] = 1.0f / sqrtf(ss * (1.0f / DM) + EPS);
    }
}

struct EpiRes {
    const bf16_t* hin; bf16_t* out;
    __device__ __forceinline__ void operator()(const f32x4 (&acc)[2][2][4][2], const pg8::Unit& u, int wr, int wc, int fr, int fq, LAS unsigned char*) const {
        const int row0 = u.pm * 256 + wr * 64 + fr, col0 = u.pn * 256 + wc * 32 + 8 * fq;
#pragma unroll
        for (int ai = 0; ai < 2; ++ai)
#pragma unroll
            for (int m = 0; m < 4; ++m) { const size_t ro = (size_t)(row0 + ai * 128 + m * 16) * DM + col0;
#pragma unroll
                for (int bj = 0; bj < 2; ++bj) { const u32x4 hv = *(const u32x4*)(hin + ro + bj * 128);
                    const f32x4 v0 = acc[ai][bj][m][0] + (f32x4){bflo(hv.x), bfhi(hv.x), bflo(hv.y), bfhi(hv.y)}, v1 = acc[ai][bj][m][1] + (f32x4){bflo(hv.z), bfhi(hv.z), bflo(hv.w), bfhi(hv.w)};
                    u32x4 w; w.x = cvt_pk_bf16(v0[0], v0[1]); w.y = cvt_pk_bf16(v0[2], v0[3]); w.z = cvt_pk_bf16(v1[0], v1[1]); w.w = cvt_pk_bf16(v1[2], v1[3]);
                    *(u32x4*)(out + ro + bj * 128) = w; } }
    }
};

constexpr float QSCALE = 0.08838834764831845f * 1.4426950408889634f;
struct EpiQKV {
    const float* rstd; const float* qn; const float* kn; bf16_t* q; bf16_t* k; bf16_t* v;
    __device__ __forceinline__ void operator()(const f32x4 (&acc)[2][2][4][2], const pg8::Unit& u, int wr, int wc, int fr, int fq, LAS unsigned char* lds) const {
        const int which = u.pn >> 3, colt = (u.pn & 7) * 256;
        bf16_t* dst = q + (size_t)which * ((WS_K - WS_Q) / 2);
        const int col0 = colt + wc * 32 + 8 * fq;
        LAS float* EX = (LAS float*)(lds + EX_OFF);
        const bool normed = which != 2;
        if (normed) {
#pragma unroll
            for (int ai = 0; ai < 2; ++ai)
#pragma unroll
                for (int m = 0; m < 4; ++m)
#pragma unroll
                    for (int bj = 0; bj < 2; ++bj) { const f32x4 v0 = acc[ai][bj][m][0], v1 = acc[ai][bj][m][1];
                        float s = (v0[0] * v0[0] + v0[1] * v0[1]) + (v0[2] * v0[2] + v0[3] * v0[3]) + (v1[0] * v1[0] + v1[1] * v1[1]) + (v1[2] * v1[2] + v1[3] * v1[3]);
                        s += __shfl_xor(s, 16); s += __shfl_xor(s, 32);
                        if (fq == 0) EX[((ai * 128 + wr * 64 + m * 16 + fr) * 2 + bj) * 4 + wc] = s; }
            asm volatile("s_waitcnt lgkmcnt(0)" ::: "memory"); __builtin_amdgcn_s_barrier(); asm volatile("" ::: "memory");
        }
        f32x4 g0 = (f32x4){1.f, 1.f, 1.f, 1.f}, g1 = g0;
        if (which == 0) { g0 = *(const f32x4*)(qn + wc * 32 + 8 * fq) * QSCALE; g1 = *(const f32x4*)(qn + wc * 32 + 8 * fq + 4) * QSCALE; }
        if (which == 1) { g0 = *(const f32x4*)(kn + wc * 32 + 8 * fq); g1 = *(const f32x4*)(kn + wc * 32 + 8 * fq + 4); }
#pragma unroll
        for (int ai = 0; ai < 2; ++ai)
#pragma unroll
            for (int m = 0; m < 4; ++m) { const int r = ai * 128 + wr * 64 + m * 16 + fr; const size_t ro = (size_t)(u.pm * 256 + r) * DM + col0;
                const float rs = rstd[u.pm * 256 + r];
#pragma unroll
                for (int bj = 0; bj < 2; ++bj) { float f = rs;
                    if (normed) { const f32x4 pp = *(const LAS f32x4*)(EX + (r * 2 + bj) * 4); const float tot = ((pp[0] + pp[1]) + (pp[2] + pp[3])) * rs * rs; f = rs / sqrtf(tot * (1.0f / HD) + EPS); }
                    const f32x4 v0 = acc[ai][bj][m][0] * f * g0, v1 = acc[ai][bj][m][1] * f * g1;
                    u32x4 w; w.x = cvt_pk_bf16(v0[0], v0[1]); w.y = cvt_pk_bf16(v0[2], v0[3]); w.z = cvt_pk_bf16(v1[0], v1[1]); w.w = cvt_pk_bf16(v1[2], v1[3]);
                    *(u32x4*)(dst + ro + bj * 128) = w; }
                asm volatile("" ::: "memory"); }
    }
};

typedef short v4i16_t __attribute__((ext_vector_type(4)));
__device__ __forceinline__ s16x4 vtr(const LAS char* p) { return __builtin_bit_cast(s16x4, __builtin_amdgcn_ds_read_tr16_b64_v4i16((LAS v4i16_t*)p)); }
__device__ __forceinline__ void attn_phase(Frame& F, const bf16_t* Q, const bf16_t* K, const bf16_t* V, bf16_t* O) {
    const int lane = F.lane, wid = F.wave, tid = F.tid, r32 = lane & 31, hi = lane >> 5;
    LAS char* lds = (LAS char*)F.lds;
    unsigned ksrc[2], vsrc[2];
#pragma unroll
    for (int i = 0; i < 2; ++i) { const int p = i * 512 + tid, row = p >> 4, cp = p & 15; const int X = ((row & 3) << 2) | ((row >> 2) & 3);
        ksrc[i] = (unsigned)(row * (DM * 2) + ((cp ^ X) * 16)); vsrc[i] = (unsigned)(row * (DM * 2) + ((cp ^ ((row & 3) << 2)) * 16)); }
    const int Xr = ((r32 & 3) << 2) | ((r32 >> 2) & 3);
    const int kbase = 256 * r32 + 16 * (hi ^ Xr);
    const int g4 = lane >> 4, qq = (lane & 15) >> 2, pp = lane & 3;
    int vb[4];
#pragma unroll
    for (int db = 0; db < 4; ++db) vb[db] = 256 * (4 * (g4 >> 1) + qq) + 64 * (db ^ qq) + 32 * (g4 & 1) + 16 * (pp >> 1) + 8 * (pp & 1);
#define AT_STAGE(jt, buf) do { const char* _kt = kg + (size_t)(jt) * 64 * (DM * 2); const char* _vt = vg + (size_t)(jt) * 64 * (DM * 2); \
        _Pragma("unroll") for (int _i = 0; _i < 2; ++_i) __builtin_amdgcn_global_load_lds((const unsigned*)(_kt + ksrc[_i]), (LAS unsigned*)(lds + (buf) * 16384 + _i * 8192 + wid * 1024), 16, 0, 0); \
        _Pragma("unroll") for (int _i = 0; _i < 2; ++_i) __builtin_amdgcn_global_load_lds((const unsigned*)(_vt + vsrc[_i]), (LAS unsigned*)(lds + 32768 + (buf) * 16384 + _i * 8192 + wid * 1024), 16, 0, 0); } while (0)
    for (int it = 0;; ++it) {
        const int idx = it * F.G + F.vcu; if (idx >= BATCH * NH * (SEQ / 256)) break;
        const int bh = idx & 255, qb = idx >> 8, b = bh >> 4, h = bh & 15;
        const size_t rowbase = (size_t)b * SEQ;
        const int t0w = qb * 256 + wid * 32, t = t0w + r32;
        bf16x8 qf[8];
        { const bf16_t* qp = Q + (rowbase + t) * DM + h * HD + 8 * hi;
#pragma unroll
          for (int s = 0; s < 8; ++s) qf[s] = *(const bf16x8*)(qp + 16 * s); }
        f32x16 o[4];
#pragma unroll
        for (int db = 0; db < 4; ++db)
#pragma unroll
            for (int r = 0; r < 16; ++r) o[db][r] = 0.f;
        float C = 1.0f;
        const char* kg = (const char*)(K + rowbase * DM + h * HD); const char* vg = (const char*)(V + rowbase * DM + h * HD);
        const int jmax = 4 * qb + 3;
        __builtin_amdgcn_s_barrier();
        AT_STAGE(jmax, 0);
        for (int jt = jmax, n = 0; jt >= 0; --jt, ++n) {
            const int buf = n & 1;
            if (jt > 0) { AT_STAGE(jt - 1, buf ^ 1); asm volatile("s_waitcnt vmcnt(4)" ::: "memory"); }
            else asm volatile("s_waitcnt vmcnt(0)" ::: "memory");
            __builtin_amdgcn_s_barrier(); asm volatile("" ::: "memory");
            if (64 * jt <= t0w + 30) {
                const LAS char* kb = lds + buf * 16384; const LAS char* vbuf = lds + 32768 + buf * 16384;
                f32x16 p[2];
#pragma unroll
                for (int sub = 0; sub < 2; ++sub) {
#pragma unroll
                    for (int r = 0; r < 16; ++r) p[sub][r] = 0.f;
#pragma unroll
                    for (int s = 0; s < 8; ++s) { const bf16x8 kf = *(const LAS bf16x8*)(kb + sub * 8192 + (kbase ^ (32 * s))); p[sub] = __builtin_amdgcn_mfma_f32_32x32x16_bf16(kf, qf[s], p[sub], 0, 0, 0); } }
                const bool needmask = (64 * jt + 63 >= t0w);
                bf16x8 pf[4];
#pragma unroll
                for (int sub = 1; sub >= 0; --sub) {
                    float E[16], sfx[16], gt[4], pr[4], om[4];
#pragma unroll
                    for (int r = 0; r < 16; ++r) { float e = __builtin_amdgcn_exp2f(p[sub][r]);
                        if (needmask) { const int key = 64 * jt + 32 * sub + (r & 3) + 8 * (r >> 2) + 4 * hi; e = key < t ? e : 0.f; }
                        E[r] = e; }
#pragma unroll
                    for (int a = 0; a < 4; ++a) { const float s3 = 1.0f + E[4 * a + 3], s2 = (1.0f + E[4 * a + 2]) * s3, s1 = (1.0f + E[4 * a + 1]) * s2, s0 = (1.0f + E[4 * a]) * s1;
                        sfx[4 * a + 3] = s3; sfx[4 * a + 2] = s2; sfx[4 * a + 1] = s1; sfx[4 * a] = s0; gt[a] = s0; }
#pragma unroll
                    for (int a = 0; a < 4; ++a) { auto rr = __builtin_amdgcn_permlane32_swap(__float_as_uint(gt[a]), __float_as_uint(gt[a]), false, false);
                        const float x0 = __uint_as_float(rr[0]), x1 = __uint_as_float(rr[1]); pr[a] = x0 * x1; om[a] = hi ? 1.0f : x1; }
                    float R[4]; R[3] = C; R[2] = R[3] * pr[3]; R[1] = R[2] * pr[2]; R[0] = R[1] * pr[1]; C = R[0] * pr[0];
                    float A[16];
#pragma unroll
                    for (int a = 0; a < 4; ++a) { const float ap = R[a] * om[a];
#pragma unroll
                        for (int bb = 0; bb < 4; ++bb) A[4 * a + bb] = E[4 * a + bb] * __builtin_amdgcn_rcpf(sfx[4 * a + bb] * ap); }
#pragma unroll
                    for (int s2 = 0; s2 < 2; ++s2) { u32x4 w; w.x = cvt_pk_bf16(A[8 * s2 + 0], A[8 * s2 + 1]); w.y = cvt_pk_bf16(A[8 * s2 + 2], A[8 * s2 + 3]); w.z = cvt_pk_bf16(A[8 * s2 + 4], A[8 * s2 + 5]); w.w = cvt_pk_bf16(A[8 * s2 + 6], A[8 * s2 + 7]);
                        pf[sub * 2 + s2] = __builtin_bit_cast(bf16x8, w); }
                }
#pragma unroll
                for (int ks = 0; ks < 4; ++ks) { const int kb0 = 16 * ks;
#pragma unroll
                    for (int db = 0; db < 4; ++db) { const s16x4 v0 = vtr(vbuf + vb[db] + 256 * kb0), v1 = vtr(vbuf + vb[db] + 256 * (kb0 + 8));
                        const bf16x8 vf = __builtin_shufflevector(v0, v1, 0, 1, 2, 3, 4, 5, 6, 7);
                        o[db] = __builtin_amdgcn_mfma_f32_32x32x16_bf16(vf, pf[ks], o[db], 0, 0, 0); } }
            }
            asm volatile("s_waitcnt lgkmcnt(0)" ::: "memory"); __builtin_amdgcn_s_barrier(); asm volatile("" ::: "memory");
        }
        bf16_t* op = O + (rowbase + t) * DM + h * HD + 4 * hi;
#pragma unroll
        for (int db = 0; db < 4; ++db)
#pragma unroll
            for (int a = 0; a < 4; ++a) { u32x2 w; w.x = cvt_pk_bf16(o[db][4 * a], o[db][4 * a + 1]); w.y = cvt_pk_bf16(o[db][4 * a + 2], o[db][4 * a + 3]); *(u32x2*)(op + 32 * db + 8 * a) = w; }
    }
#undef AT_STAGE
    asm volatile("s_waitcnt vmcnt(0)" ::: "memory"); __builtin_amdgcn_s_barrier();
}

__device__ __forceinline__ void dump_bf16(Frame& F, const bf16_t* src, float* out) {
    const size_t n8 = (size_t)T * DM / 8;
    for (size_t i = (size_t)F.vcu * NTHR + F.tid; i < n8; i += (size_t)F.G * NTHR) {
        const u32x4 v = *(const u32x4*)(src + i * 8);
        f32x4 a = (f32x4){bflo(v.x), bfhi(v.x), bflo(v.y), bfhi(v.y)}, b = (f32x4){bflo(v.z), bfhi(v.z), bflo(v.w), bfhi(v.w)};
        *(f32x4*)(out + i * 8) = a; *(f32x4*)(out + i * 8 + 4) = b;
    }
}

constexpr int N_PHASES = 13;
__global__ void __launch_bounds__(NTHR, 2) fwd(Args args) {
    extern __shared__ __attribute__((aligned(16))) unsigned char lds_raw[];
    Frame F;
    F.lds = (LAS unsigned char*)lds_raw;
    F.tid = threadIdx.x; F.lane = F.tid & 63; F.wave = __builtin_amdgcn_readfirstlane(F.tid >> 6);
    F.G = gridDim.x; { const int bx = blockIdx.x; F.vcu = (F.G % 8 == 0) ? (bx % 8) * (F.G / 8) + bx / 8 : bx; }
    volatile LAS unsigned* MISC = (volatile LAS unsigned*)(F.lds + MISC_OFF);
    if (F.tid < 64) MISC[F.tid] = 0u;
    __syncthreads();
    unsigned* ctl = (unsigned*)(args.ws + WS_CTL);
    XcdBarrier bar; bar.bar = ctl + CW_BAR; bar.x = 0; bar.st = nullptr;
    if (N_LAUNCH_MODE == 1) bar = xcd_barrier_post(ctl + CW_BAR, MISC + 8);
    const int lo = args.ph_lo, hi = args.ph_hi;
#define IN(k) (lo <= (k) && (k) < hi)
#define SEAM(k) do { if (N_LAUNCH_MODE == 1 && IN(k) && IN((k) + 1)) xcd_barrier(bar); } while (0)
    bf16_t* pooled = (bf16_t*)(args.ws + WS_Q);
    bf16_t* h1 = (bf16_t*)(args.ws + WS_K);
    bf16_t* h2 = (bf16_t*)(args.ws + WS_HB);
    bf16_t* h3 = (bf16_t*)(args.ws + WS_HC);

    if (IN(0)) { p0_weights(args, F); p0_pool(args, F, pooled); }
    SEAM(0);
    if (IN(1)) {
        SchedPlain S{(const char*)pooled, (const char*)(args.ws + WS_WPOOL), DM * 2, PGC * 2, T / 256, 8, F.G, F.vcu, 1};
        EpiPool E{args.x, h1};
        pg8::gemm_phase<EpiPool, SchedPlain>(F.lds, PGC, S, E);
    }
    SEAM(1);
    if (IN(2)) router_phase(args, F, h1, 0);
    SEAM(2);
    if (IN(3)) {
        moe_build(args, F, 0, true);
        SchedMoe S{(const char*)h1, (const char*)(args.ws + WS_WGU), DM * 2, (LAS int*)(F.lds + UDESC_OFF), (LAS unsigned*)(F.lds + ROWTAB_OFF), 0, 0};
        EpiSwiGLU E{(const f32x4*)(args.ws + WS_META), (bf16_t*)(args.ws + WS_HMOE), (LAS int*)(F.lds + UDESC_OFF)};
        pg8::gemm_phase<EpiSwiGLU, SchedMoe>(F.lds, DM, S, E);
    }
    SEAM(3);
    if (IN(4)) {
        moe_build(args, F, 0, false);
        SchedMoe S{(const char*)(args.ws + WS_HMOE), (const char*)(args.ws + WS_WD), FF * 2, (LAS int*)(F.lds + UDESC_OFF), (LAS unsigned*)(F.lds + ROWTAB_OFF), 0, 1};
        EpiDown<false> E{(const int*)(args.ws + WS_LIST), h1, (void*)h2, (LAS int*)(F.lds + UDESC_OFF)};
        pg8::gemm_phase<EpiDown<false>, SchedMoe>(F.lds, 2 * FF, S, E);
    }
    SEAM(4);
#if STOP_AFTER == 1
    if (IN(12)) dump_bf16(F, h1, args.out);
#endif
#if STOP_AFTER == 2
    if (IN(12)) dump_bf16(F, h2, args.out);
#endif
#if STOP_AFTER >= 3
    bf16_t* qb_ = (bf16_t*)(args.ws + WS_Q); bf16_t* kb_ = (bf16_t*)(args.ws + WS_K); bf16_t* vb_ = (bf16_t*)(args.ws + WS_V);
    bf16_t* ob_ = (bf16_t*)args.out;
    float* rstd2 = (float*)(args.ws + WS_RSTD);
    if (IN(5)) rstd_phase(F, h2, rstd2);
    SEAM(5);
#ifndef SKIP_QKV
    if (IN(6)) {
        SchedPlain S{(const char*)h2, (const char*)(args.ws + WS_WQKV), DM * 2, DM * 2, T / 256, 24, F.G, F.vcu, 0};
        EpiQKV E{rstd2, args.q_norm, args.k_norm, qb_, kb_, vb_};
        pg8::gemm_phase<EpiQKV, SchedPlain>(F.lds, DM, S, E);
    }
#endif
    SEAM(6);
#ifndef SKIP_ATTN
    if (IN(7)) attn_phase(F, qb_, kb_, vb_, ob_);
#endif
    SEAM(7);
    if (IN(8)) {
        SchedPlain S{(const char*)ob_, (const char*)(args.ws + WS_WO), DM * 2, DM * 2, T / 256, 8, F.G, F.vcu, 0};
        EpiRes E{h2, h3};
        pg8::gemm_phase<EpiRes, SchedPlain>(F.lds, DM, S, E);
    }
    SEAM(8);
#endif
#if STOP_AFTER == 3
    if (IN(12)) dump_bf16(F, h3, args.out);
#endif
#if STOP_AFTER >= 4
    if (IN(9)) router_phase(args, F, h3, 1);
    SEAM(9);
    if (IN(10)) {
        moe_build(args, F, 1, true);
        SchedMoe S{(const char*)h3, (const char*)(args.ws + WS_WGU), DM * 2, (LAS int*)(F.lds + UDESC_OFF), (LAS unsigned*)(F.lds + ROWTAB_OFF), 1, 0};
        EpiSwiGLU E{(const f32x4*)(args.ws + WS_META), (bf16_t*)(args.ws + WS_HMOE), (LAS int*)(F.lds + UDESC_OFF)};
        pg8::gemm_phase<EpiSwiGLU, SchedMoe>(F.lds, DM, S, E);
    }
    SEAM(10);
    if (IN(11)) {
        moe_build(args, F, 1, false);
        SchedMoe S{(const char*)(args.ws + WS_HMOE), (const char*)(args.ws + WS_WD), FF * 2, (LAS int*)(F.lds + UDESC_OFF), (LAS unsigned*)(F.lds + ROWTAB_OFF), 1, 1};
        EpiDown<true> E{(const int*)(args.ws + WS_LIST), h3, (void*)args.out, (LAS int*)(F.lds + UDESC_OFF)};
        pg8::gemm_phase<EpiDown<true>, SchedMoe>(F.lds, 2 * FF, S, E);
    }
#endif
#undef IN
#undef SEAM
}

extern "C" void kernel_launch(void* const* d_in, const int* in_sizes, int n_in, void* d_out, int out_size, void* d_ws, size_t ws_size, hipStream_t stream) {
    static int grid = 0;
    if (grid == 0) {
        if (n_in != 18 || out_size != T * DM || ws_size < WS_END) { fprintf(stderr, "kernel_launch: unexpected sizes (n_in %d out %d ws %zu)\n", n_in, out_size, ws_size); grid = -1; return; }
        int dev = 0, cus = 0, per_cu = 0;
        if (hipGetDevice(&dev) != hipSuccess || hipDeviceGetAttribute(&cus, hipDeviceAttributeMultiprocessorCount, dev) != hipSuccess) { grid = -1; return; }
        if (hipFuncSetAttribute((const void*)fwd, hipFuncAttributeMaxDynamicSharedMemorySize, LDS_BYTES) != hipSuccess) { fprintf(stderr, "kernel_launch: hipFuncSetAttribute failed\n"); grid = -1; return; }
        if (hipOccupancyMaxActiveBlocksPerMultiprocessor(&per_cu, (const void*)fwd, NTHR, LDS_BYTES) != hipSuccess || per_cu < 1) fprintf(stderr, "kernel_launch: occupancy query says %d\n", per_cu);
        (void)hipGetLastError();
        grid = cus;
    }
    if (grid < 0) return;
    hipMemsetAsync((char*)d_ws + WS_CTL, 0, CTL_BYTES, stream);
    Args a{};
    a.x = (const float*)d_in[0]; a.norm_mix = (const float*)d_in[1]; a.norm_ffn = (const float*)d_in[2]; a.pool_w = (const float*)d_in[3]; a.pool_scale = (const float*)d_in[4];
    a.kv_norm = (const float*)d_in[5]; a.w_kv = (const float*)d_in[6]; a.k_norm = (const float*)d_in[7]; a.w_q = (const float*)d_in[8]; a.q_norm = (const float*)d_in[9]; a.w_o = (const float*)d_in[10];
    a.w_grp = (const float*)d_in[11]; a.b_grp = (const float*)d_in[12]; a.w_rt = (const float*)d_in[13]; a.b_rt = (const float*)d_in[14]; a.w_gate = (const float*)d_in[15]; a.w_up = (const float*)d_in[16]; a.w_down = (const float*)d_in[17];
    a.out = (float*)d_out; a.ws = (unsigned char*)d_ws;
    if (N_LAUNCH_MODE == 1) { a.ph_lo = 0; a.ph_hi = N_PHASES; hipLaunchKernelGGL(fwd, dim3(grid), dim3(NTHR), LDS_BYTES, stream, a); }
    else for (int p = 0; p < N_PHASES; ++p) { a.ph_lo = p; a.ph_hi = p + 1; hipLaunchKernelGGL(fwd, dim3(grid), dim3(NTHR), LDS_BYTES, stream, a); }
}
```

```cpp
#include <hip/hip_runtime.h>
#include <cstdio>
#include <cstdint>

#ifndef STOP_AFTER
#define STOP_AFTER 4
#endif
#ifndef REP_ATTN
#define REP_ATTN 1
#endif
#ifndef REP_P0
#define REP_P0 1
#endif
#ifndef N_LAUNCH_MODE
#define N_LAUNCH_MODE 1
#endif

#define LAS __attribute__((address_space(3)))
#define GAS __attribute__((address_space(1)))
typedef unsigned short bf16_t;
typedef short bf16x8 __attribute__((ext_vector_type(8)));
typedef short s16x4 __attribute__((ext_vector_type(4)));
typedef float f32x2 __attribute__((ext_vector_type(2)));
typedef float f32x4 __attribute__((ext_vector_type(4)));
typedef float f32x16 __attribute__((ext_vector_type(16)));
typedef unsigned u32x2 __attribute__((ext_vector_type(2)));
typedef unsigned u32x4 __attribute__((ext_vector_type(4)));

constexpr int BATCH = 16, SEQ = 2048, DM = 2048, T = BATCH * SEQ, NH = 16, HD = 128;
constexpr int NGRP = 4, EPG = 4, NE = 16, FF = 512, NBKT = 24;
constexpr int PGC = 512;
constexpr float EPS = 1e-6f;
constexpr int MAXRT = 152;
constexpr int NWAVES = 8, NTHR = 512;

constexpr size_t MiB = 1u << 20;
constexpr size_t WS_CTL = 0, CTL_BYTES = 1 * MiB;
constexpr size_t WS_WPOOL = 1 * MiB;
constexpr size_t WS_WQKV = 3 * MiB;
constexpr size_t WS_WO = 27 * MiB;
constexpr size_t WS_WGU = 35 * MiB;
constexpr size_t WS_WD = 163 * MiB;
constexpr size_t WS_WR = 227 * MiB;
constexpr size_t WS_RSTD = 228 * MiB;
constexpr size_t WS_LIST = 229 * MiB;
constexpr size_t WS_META = 232 * MiB;
constexpr size_t WS_HMOE = 244 * MiB;
constexpr size_t WS_HB = 320 * MiB;
constexpr size_t WS_HC = 448 * MiB;
constexpr size_t WS_Q = 576 * MiB;
constexpr size_t WS_K = 704 * MiB;
constexpr size_t WS_V = 832 * MiB;
constexpr size_t WS_END = 960 * MiB;
constexpr int CW_BAR = 4096;
constexpr int CW_CNT = 16384;

constexpr int RING_BYTES = 131072;
constexpr int EX_OFF = RING_BYTES;
constexpr int ROWTAB_OFF = EX_OFF + 8192;
constexpr int UDESC_OFF = ROWTAB_OFF + 8192;
constexpr int MISC_OFF = UDESC_OFF + 1024;
constexpr int LDS_BYTES = 151552;
static_assert(MISC_OFF + 256 <= LDS_BYTES, "lds map");
static_assert(WS_V - WS_K == WS_K - WS_Q, "q|k|v spacing");

__device__ __forceinline__ unsigned f2bf(float f) { unsigned u = __builtin_bit_cast(unsigned, f); return (u + 0x7fffu + ((u >> 16) & 1u)) >> 16; }
__device__ __forceinline__ unsigned pk2(float lo, float hi) { return f2bf(lo) | (f2bf(hi) << 16); }
__device__ __forceinline__ float bf2f(unsigned short b) { return __builtin_bit_cast(float, ((unsigned)b) << 16); }
__device__ __forceinline__ float bflo(unsigned w) { return __builtin_bit_cast(float, w << 16); }
__device__ __forceinline__ float bfhi(unsigned w) { return __builtin_bit_cast(float, w & 0xffff0000u); }
__device__ __forceinline__ unsigned cvt_pk_bf16(float lo, float hi) { unsigned r; asm volatile("v_cvt_pk_bf16_f32 %0, %1, %2" : "=v"(r) : "v"(lo), "v"(hi)); return r; }
__device__ __forceinline__ float wave_sum(float v) {
#pragma unroll
    for (int o = 1; o < 64; o <<= 1) v += __shfl_xor(v, o);
    return v;
}
#define LDS_WAIT() asm volatile("s_waitcnt lgkmcnt(0)" ::: "memory")
#define VM_WAIT() asm volatile("s_waitcnt vmcnt(0)" ::: "memory")

#define XB_TMO      128
#define XB_XCNT(j)  (256  + 64 * (j))
#define XB_XSUB(j)  (1280 + 64 * (j))
#define XB_XGEN(j)  (2304 + 64 * (j))
#define XB_TOP      3328
#define XB_TOPGEN   3392
#define XCD_BAR_WORDS 3456
#define XB_SPIN_CAP (1u << 18)
__device__ __forceinline__ unsigned xb_ld(unsigned* p)              { return __hip_atomic_load(p, __ATOMIC_RELAXED, __HIP_MEMORY_SCOPE_AGENT); }
__device__ __forceinline__ unsigned xb_add(unsigned* p, unsigned v) { return __hip_atomic_fetch_add(p, v, __ATOMIC_RELAXED, __HIP_MEMORY_SCOPE_AGENT); }
__device__ __forceinline__ unsigned xb_xcc_id() { return (unsigned)__builtin_amdgcn_s_getreg((3 << 11) | 20) & 0xFu; }
#define XB_SPIN(cond, bar) do { unsigned _sp = 0; while (cond) { __builtin_amdgcn_s_sleep(1); \
    if ((++_sp & 255u) == 0u) { if (xb_ld(&(bar)[XB_TMO])) break; if (_sp > XB_SPIN_CAP) { atomicAdd(&(bar)[XB_TMO], 1u); break; } } } } while (0)
struct XcdBarrier { unsigned* bar; unsigned x; volatile LAS unsigned* st; };
__device__ __forceinline__ XcdBarrier xcd_barrier_post(unsigned* bar, volatile LAS unsigned* st) {
    XcdBarrier b; b.bar = bar; b.x = xb_xcc_id(); b.st = st;
    if (threadIdx.x == 0) (void)xb_add(&bar[XB_XCNT(b.x)], 1u);
    return b;
}
__device__ __forceinline__ void xcd_barrier_complete(unsigned* bar, unsigned x, unsigned& nloc, unsigned& nx) {
    const unsigned G = gridDim.x * gridDim.y * gridDim.z;
    unsigned sum, cnt, mine, sp = 0u;
    for (;;) {
        sum = 0u; cnt = 0u; mine = 0u;
#pragma unroll
        for (unsigned j = 0; j < 16; ++j) { const unsigned c = xb_ld(&bar[XB_XCNT(j)]); sum += c; cnt += (c > 0u) ? 1u : 0u; mine = (j == x) ? c : mine; }
        if (sum == G) break;
        __builtin_amdgcn_s_sleep(1);
        if ((++sp & 255u) == 0u) { if (xb_ld(&bar[XB_TMO])) break; if (sp > XB_SPIN_CAP) { atomicAdd(&bar[XB_TMO], 1u); break; } }
    }
    nloc = mine > 0u ? mine : 1u; nx = cnt > 0u ? cnt : 1u;
}
__device__ __forceinline__ void xcd_barrier(const XcdBarrier& b) {
    asm volatile("s_waitcnt vmcnt(0)" ::: "memory");
    __syncthreads();
    if (threadIdx.x == 0) {
        unsigned* bar = b.bar;
        __builtin_amdgcn_s_waitcnt(0);
        unsigned nloc = b.st[0], nx = b.st[1];
        if (nloc == 0u) { xcd_barrier_complete(bar, b.x, nloc, nx); b.st[0] = nloc; b.st[1] = nx; }
        const unsigned old = xb_add(&bar[XB_XSUB(b.x)], 1u);
        const unsigned gen = old / nloc;
        if (old + 1u == (gen + 1u) * nloc) {
            __builtin_amdgcn_fence(__ATOMIC_RELEASE, "agent");
            asm volatile("s_waitcnt vmcnt(0)" ::: "memory");
            const unsigned og = xb_add(&bar[XB_TOP], 1u);
            const unsigned tg = og / nx;
            if (og + 1u == (tg + 1u) * nx) xb_add(&bar[XB_TOPGEN], 1u);
            else XB_SPIN(xb_ld(&bar[XB_TOPGEN]) == tg, bar);
            __builtin_amdgcn_fence(__ATOMIC_ACQUIRE, "agent");
            xb_add(&bar[XB_XGEN(b.x)], 1u);
            asm volatile("s_waitcnt vmcnt(0)" ::: "memory");
        } else {
            XB_SPIN(xb_ld(&bar[XB_XGEN(b.x)]) == gen, bar);
            __builtin_amdgcn_fence(__ATOMIC_ACQUIRE, "agent");
            asm volatile("s_waitcnt vmcnt(0)" ::: "memory");
        }
    }
    __syncthreads();
}

namespace pg8 {
constexpr int BM = 256, BK = 64, HALF = 128, HTB = HALF * BK * 2, STAGE_BYTES = 8 * HTB;
__host__ __device__ __forceinline__ int lds_byte(int r, int c) { const int st = (r >> 4) * 2 + (c >> 5), rr = r & 15, cc = c & 31, ob = rr * 64 + cc * 2; return st * 1024 + (ob ^ (((ob >> 9) & 1) << 5)); }
__host__ __device__ __forceinline__ void stage_rc(int b, int& R, int& C) { const int st = b / 1024, sb = b % 1024, swz = sb ^ (((sb >> 9) & 1) << 5); R = (st >> 1) * 16 + swz / 64; C = (st & 1) * 32 + (swz % 64) / 2; }
__host__ __device__ __forceinline__ int perm32(int rho) { const int n = rho >> 4, i = rho & 15; return 8 * (i >> 2) + 4 * n + (i & 3); }

struct Unit { int j, pm, pn, aux; };

template <class Epi, class Sched>
__device__ __forceinline__ void gemm_phase(LAS unsigned char* lds, const int K, const Sched& S, const Epi& E) {
    const int tid = threadIdx.x, wid = __builtin_amdgcn_readfirstlane(tid >> 6), lane = tid & 63, wr = wid >> 2, wc = wid & 3, fr = lane & 15, fq = lane >> 4;
    const int nt = K / BK;
    int Rl[2], Cl2[2]; unsigned voffB[2];
#pragma unroll
    for (int i = 0; i < 2; ++i) { int R, C; stage_rc(tid * 16 + i * 8192, R, C); Rl[i] = R; Cl2[i] = C * 2; const int Rb = (R & ~31) + perm32(R & 31); voffB[i] = (unsigned)Rb * S.ldb_bytes + (unsigned)C * 2u; }
    const size_t kstep = (size_t)(BK * 2);
    const size_t hstepB = (size_t)HALF * S.ldb_bytes;
    const unsigned ldsw = (unsigned)wid * 1024u;
    const int aoff = lds_byte(wr * 64 + fr, fq * 8), boff = lds_byte(wc * 32 + fr, fq * 8);
#define PG8_SA(b, h) (((b) * 2 + (h)) * HTB)
#define PG8_SB(b, h) ((4 + (b) * 2 + (h)) * HTB)
#define PG8_STAGEB(bufoff, gbase) do { _Pragma("unroll") for (int _i = 0; _i < 2; ++_i) \
        __builtin_amdgcn_global_load_lds((const unsigned*)((const char*)(gbase) + voffB[_i]), (LAS unsigned*)(lds + (bufoff) + ldsw + _i * 8192), 16, 0, 0); } while (0)
#define PG8_STAGEA(bufoff, offs, h, kb) do { _Pragma("unroll") for (int _i = 0; _i < 2; ++_i) \
        __builtin_amdgcn_global_load_lds((const unsigned*)(S.A + (kb) + (offs)[(h) * 2 + _i]), (LAS unsigned*)(lds + (bufoff) + ldsw + _i * 8192), 16, 0, 0); } while (0)
#define PG8_LDA(dst, b, h) do { _Pragma("unroll") for (int m = 0; m < 4; ++m) _Pragma("unroll") for (int k = 0; k < 2; ++k) dst[m][k] = *(const LAS bf16x8*)(lds + PG8_SA(b, h) + aoff + m * 2048 + k * 1024); } while (0)
#define PG8_LDB(dst, b, h) do { _Pragma("unroll") for (int n = 0; n < 2; ++n) _Pragma("unroll") for (int k = 0; k < 2; ++k) dst[n][k] = *(const LAS bf16x8*)(lds + PG8_SB(b, h) + boff + n * 2048 + k * 1024); } while (0)
#define PG8_MMA(ai, bj, At, Bt) do { __builtin_amdgcn_s_setprio(1); _Pragma("unroll") for (int m = 0; m < 4; ++m) _Pragma("unroll") for (int n = 0; n < 2; ++n) _Pragma("unroll") for (int k = 0; k < 2; ++k) \
        acc[ai][bj][m][n] = __builtin_amdgcn_mfma_f32_16x16x32_bf16(Bt[n][k], At[m][k], acc[ai][bj][m][n], 0, 0, 0); __builtin_amdgcn_s_setprio(0); } while (0)
#define PG8_WAIT_V(n) asm volatile("s_waitcnt vmcnt(" #n ")" ::: "memory")
#define PG8_WAIT_L(n) asm volatile("s_waitcnt lgkmcnt(" #n ")" ::: "memory")
#define PG8_BAR __builtin_amdgcn_s_barrier()
#define PG8_SCHED __builtin_amdgcn_sched_barrier(0)
#define PG8_OFFS(dst, u) do { _Pragma("unroll") for (int _h = 0; _h < 2; ++_h) _Pragma("unroll") for (int _i = 0; _i < 2; ++_i) dst[_h * 2 + _i] = S.row_off(u, _h * HALF + Rl[_i]) + (unsigned)Cl2[_i]; } while (0)
    Unit cur, nxt; int ui = 0;
    if (!S.next(0, cur)) return;
    f32x4 acc[2][2][4][2];
#pragma unroll
    for (int a = 0; a < 2; ++a)
#pragma unroll
        for (int b = 0; b < 2; ++b)
#pragma unroll
            for (int m = 0; m < 4; ++m)
#pragma unroll
                for (int n = 0; n < 2; ++n) acc[a][b][m][n] = (f32x4){0.f, 0.f, 0.f, 0.f};
    bf16x8 At[4][2], B0[2][2], B1[2][2];
    unsigned offC[4], offN[4];
    PG8_OFFS(offC, cur);
#pragma unroll
    for (int q = 0; q < 4; ++q) offN[q] = offC[q];
    const char* cB0 = S.b_ptr(cur, 0); const char* cB1 = S.b_ptr(cur, 1);
    PG8_STAGEB(PG8_SB(0, 0), cB0); PG8_STAGEB(PG8_SB(0, 1), cB0 + hstepB); PG8_STAGEA(PG8_SA(0, 0), offC, 0, 0); PG8_STAGEA(PG8_SA(0, 1), offC, 1, 0);
    if (wr == 1) PG8_BAR;
    PG8_WAIT_V(2); PG8_BAR;
    PG8_STAGEB(PG8_SB(1, 0), cB1); PG8_STAGEA(PG8_SA(1, 0), offC, 0, kstep); PG8_STAGEB(PG8_SB(1, 1), cB1 + hstepB);
    PG8_WAIT_V(6); PG8_BAR;
    for (;;) {
        const bool has_next = S.next(ui + 1, nxt);
        if (!has_next) nxt = cur;
        for (int t = 0; t < nt; t += 2) {
            const bool last = (t == nt - 2);
            const size_t a1 = (size_t)(t + 1) * kstep;
            const size_t a2 = last ? (size_t)0 : (size_t)(t + 2) * kstep; const size_t a3 = a2 + kstep;
            const char* b2 = last ? S.b_ptr(nxt, 0) : S.b_ptr(cur, t + 2);
            const char* b3 = last ? S.b_ptr(nxt, 1) : S.b_ptr(cur, t + 3);
            if (last && has_next) { PG8_OFFS(offN, nxt); }
            PG8_LDB(B0, 0, 0); PG8_LDB(B1, 0, 1); PG8_SCHED; PG8_LDA(At, 0, 0); PG8_STAGEA(PG8_SA(1, 1), offC, 1, a1);
            PG8_WAIT_V(8); PG8_WAIT_L(0); PG8_BAR; PG8_MMA(0, 0, At, B0); PG8_MMA(0, 1, At, B1); PG8_BAR; PG8_SCHED;
            PG8_LDA(At, 0, 1); PG8_STAGEB(PG8_SB(0, 0), b2); PG8_STAGEB(PG8_SB(0, 1), b2 + hstepB); PG8_STAGEA(PG8_SA(0, 0), offN, 0, a2);
            PG8_WAIT_V(8); PG8_WAIT_L(0); PG8_BAR; PG8_MMA(1, 0, At, B0); PG8_MMA(1, 1, At, B1); PG8_BAR; PG8_SCHED;
            PG8_LDB(B0, 1, 0); PG8_LDB(B1, 1, 1); PG8_SCHED; PG8_LDA(At, 1, 0); PG8_STAGEA(PG8_SA(0, 1), offN, 1, a2);
            PG8_WAIT_V(8); PG8_WAIT_L(0); PG8_BAR; PG8_MMA(0, 0, At, B0); PG8_MMA(0, 1, At, B1); PG8_BAR; PG8_SCHED;
            PG8_LDA(At, 1, 1); PG8_STAGEB(PG8_SB(1, 0), b3); PG8_STAGEB(PG8_SB(1, 1), b3 + hstepB); PG8_STAGEA(PG8_SA(1, 0), offN, 0, a3);
            PG8_WAIT_V(8); PG8_WAIT_L(0); PG8_BAR; PG8_MMA(1, 0, At, B0); PG8_MMA(1, 1, At, B1); PG8_BAR; PG8_SCHED;
        }
        if (wr == 0) PG8_BAR;
        E(acc, cur, wr, wc, fr, fq, lds);
        if (!has_next) break;
#pragma unroll
        for (int a = 0; a < 2; ++a)
#pragma unroll
            for (int b = 0; b < 2; ++b)
#pragma unroll
                for (int m = 0; m < 4; ++m)
#pragma unroll
                    for (int n = 0; n < 2; ++n) acc[a][b][m][n] = (f32x4){0.f, 0.f, 0.f, 0.f};
        cur = nxt; ++ui;
#pragma unroll
        for (int q = 0; q < 4; ++q) offC[q] = offN[q];
        if (wr == 1) PG8_BAR;
    }
    PG8_WAIT_V(0);
    PG8_BAR;
#undef PG8_SA
#undef PG8_SB
#undef PG8_STAGEA
#undef PG8_STAGEB
#undef PG8_LDA
#undef PG8_LDB
#undef PG8_MMA
#undef PG8_WAIT_V
#undef PG8_WAIT_L
#undef PG8_BAR
#undef PG8_SCHED
#undef PG8_OFFS
}
}

struct Args {
    const float* x; const float* norm_mix; const float* norm_ffn; const float* pool_w; const float* pool_scale; const float* kv_norm; const float* w_kv; const float* k_norm;
    const float* w_q; const float* q_norm; const float* w_o; const float* w_grp; const float* b_grp; const float* w_rt; const float* b_rt; const float* w_gate; const float* w_up; const float* w_down;
    float* out; unsigned char* ws; int ph_lo, ph_hi;
};
struct Frame {
    LAS unsigned char* lds; int tid, lane, wave, vcu, G;
};

__device__ __forceinline__ void transpose_item(const float* W, int ldw, const float* gk, const float* gn, bf16_t* WT, int ldk, int k0, int n0, int drow0, LAS float* scr, int lane) {
    const float gnv = gn ? gn[n0 + (lane & 31)] : 1.f;
#pragma unroll 8
    for (int i = 0; i < 32; ++i) { const int kk = 2 * i + (lane >> 5); const float g = (gk ? gk[k0 + kk] : 1.f) * gnv; scr[kk * 33 + (lane & 31)] = W[(size_t)(k0 + kk) * ldw + n0 + (lane & 31)] * g; }
    LDS_WAIT(); asm volatile("" ::: "memory");
    const int c = lane & 7;
#pragma unroll
    for (int j = 0; j < 4; ++j) { const int n = (lane >> 3) + 8 * j; const LAS float* s = scr + (8 * c) * 33 + n;
        u32x4 o; o.x = pk2(s[0 * 33], s[1 * 33]); o.y = pk2(s[2 * 33], s[3 * 33]); o.z = pk2(s[4 * 33], s[5 * 33]); o.w = pk2(s[6 * 33], s[7 * 33]);
        *(u32x4*)(WT + (size_t)(drow0 + n) * ldk + k0 + 8 * c) = o; }
    LDS_WAIT(); asm volatile("" ::: "memory");
}

__device__ __forceinline__ void p0_weights(const Args& a, Frame& F) {
    LAS float* scr = (LAS float*)(F.lds + F.wave * 16384);
    const int gw = F.vcu * NWAVES + F.wave, NGW = F.G * NWAVES;
    bf16_t* Wpool = (bf16_t*)(a.ws + WS_WPOOL); bf16_t* Wqkv = (bf16_t*)(a.ws + WS_WQKV); bf16_t* Wo = (bf16_t*)(a.ws + WS_WO);
    bf16_t* Wgu = (bf16_t*)(a.ws + WS_WGU); bf16_t* Wd = (bf16_t*)(a.ws + WS_WD);
    constexpr int I_POOL = 4 * 8 * 16, I_Q = 32 * 64, I_KV = 32 * 128, I_O = 32 * 64, I_G = 32 * 32 * 16  , I_D = 32 * 8 * 64;
    constexpr int NITEMS = I_POOL + I_Q + I_KV + I_O + 2 * I_G + I_D;
    for (int it = gw; it < NITEMS; it += NGW) {
        int r = it;
        if (r < I_POOL) { const int g = r / 128, rr = r % 128, kb = rr / 16, nb = rr % 16;
            transpose_item(a.pool_w + (size_t)g * PGC * PGC, PGC, a.norm_mix + g * PGC, a.pool_scale + g * PGC, Wpool + (size_t)g * PGC * PGC, PGC, 64 * kb, 32 * nb, 32 * nb, scr, F.lane); continue; } r -= I_POOL;
        if (r < I_Q) { const int kb = r / 64, nb = r % 64; transpose_item(a.w_q, DM, a.norm_mix + DM, nullptr, Wqkv, DM, 64 * kb, 32 * nb, 32 * nb, scr, F.lane); continue; } r -= I_Q;
        if (r < I_KV) { const int kb = r / 128, nb = r % 128; transpose_item(a.w_kv, 2 * DM, a.kv_norm, nullptr, Wqkv + (size_t)DM * DM, DM, 64 * kb, 32 * nb, 32 * nb, scr, F.lane); continue; } r -= I_KV;
        if (r < I_O) { const int kb = r / 64, nb = r % 64; transpose_item(a.w_o, DM, nullptr, nullptr, Wo, DM, 64 * kb, 32 * nb, 32 * nb, scr, F.lane); continue; } r -= I_O;
        if (r < 2 * I_G) { const int which = r / I_G; r %= I_G; const int le = r / 512, rr = r % 512, kb = rr / 16, nb = rr % 16;
            const int f0 = 32 * nb, drow0 = (f0 >> 7) * 256 + which * 128 + (f0 & 127);
            transpose_item((which ? a.w_up : a.w_gate) + (size_t)le * DM * FF, FF, a.norm_ffn + (le >> 4) * DM, nullptr, Wgu + (size_t)le * 1024 * DM, DM, 64 * kb, f0, drow0, scr, F.lane); continue; } r -= 2 * I_G;
        { const int le = r / 512, rr = r % 512, kb = rr / 64, nb = rr % 64;
            transpose_item(a.w_down + (size_t)le * FF * DM, DM, nullptr, nullptr, Wd + (size_t)le * DM * FF, FF, 64 * kb, 32 * nb, 32 * nb, scr, F.lane); }
    }
    bf16_t* Wr = (bf16_t*)(a.ws + WS_WR);
    for (int idx = (F.vcu * NTHR + F.tid); idx < 2 * 32 * DM; idx += F.G * NTHR) {
        const int l = idx / (32 * DM), rr = (idx / DM) % 32, k = idx % DM; float v = 0.f;
        if (rr < 16) v = a.w_rt[(((size_t)l * NGRP + (rr >> 2)) * DM + k) * EPG + (rr & 3)];
        else if (rr < 20) v = a.w_grp[((size_t)l * DM + k) * NGRP + (rr - 16)];
        v *= a.norm_ffn[l * DM + k];
        const unsigned hi = f2bf(v); const float rem = v - __builtin_bit_cast(float, hi << 16);
        Wr[idx] = (bf16_t)hi; Wr[2 * 32 * DM + idx] = (bf16_t)f2bf(rem);
    }
}

__device__ __forceinline__ void p0_pool(const Args& a, Frame& F, bf16_t* pooled) {
    constexpr int TC = 64;
    LAS float* rs = (LAS float*)(F.lds);
    const int c0 = F.tid * 4, gi = c0 / PGC, w = 2 << gi;
    for (int u = F.vcu; u < T / TC; u += F.G) {
        const int b = u / (SEQ / TC), t0 = (u % (SEQ / TC)) * TC;
        const float* xb = a.x + (size_t)b * SEQ * DM;
        __syncthreads();
        for (int r = F.wave - 16 + 0; r < TC; r += NWAVES) {
            const int t = t0 + r; float ss = 0.f;
            if (t >= 0) { const f32x4* xr = (const f32x4*)(xb + (size_t)t * DM) + F.lane;
#pragma unroll
                for (int j = 0; j < 8; ++j) { const f32x4 v = xr[64 * j]; ss += (v.x * v.x + v.y * v.y) + (v.z * v.z + v.w * v.w); }
                ss = wave_sum(ss); }
            if (F.lane == 0) rs[r + 16] = (t >= 0) ? 1.0f / sqrtf(ss * (1.0f / DM) + EPS) : 0.f;
        }
        __syncthreads();
        f32x4 S = (f32x4){0.f, 0.f, 0.f, 0.f};
        for (int r = -(w - 1); r < 0; ++r) { const int t = t0 + r; if (t >= 0) { const f32x4 v = *(const f32x4*)(xb + (size_t)t * DM + c0); S += v * rs[r + 16]; } }
        for (int r = 0; r < TC; ++r) {
            const int t = t0 + r;
            const f32x4 cur = *(const f32x4*)(xb + (size_t)t * DM + c0) * rs[r + 16];
            S += cur;
            const float inv = 1.0f / (float)((t + 1 < w) ? (t + 1) : w);
            const f32x4 p = S * inv - cur;
            u32x2 o; o.x = pk2(p.x, p.y); o.y = pk2(p.z, p.w);
            *(u32x2*)(pooled + ((size_t)b * SEQ + t) * DM + c0) = o;
            const int tw = t - w + 1;
            if (tw >= 0) { const f32x4 v = *(const f32x4*)(xb + (size_t)tw * DM + c0); S -= v * rs[r - w + 1 + 16]; }
        }
    }
    __syncthreads();
}

struct SchedPlain {
    const char* A; const char* B; unsigned lda_bytes, ldb_bytes; int nM, nN, G, vcu; int pool;
    __device__ __forceinline__ bool next(int i, pg8::Unit& u) const { const int L = i * G + vcu; if (L >= nM * nN) return false; u.j = i; u.pm = L / nN; u.pn = L % nN; u.aux = 0; return true; }
    __device__ __forceinline__ unsigned row_off(const pg8::Unit& u, int r) const { return (unsigned)(u.pm * 256 + r) * lda_bytes + (pool ? (unsigned)(u.pn >> 1) * (PGC * 2) : 0u); }
    __device__ __forceinline__ const char* b_ptr(const pg8::Unit& u, int kt) const { return B + (size_t)u.pn * 256 * ldb_bytes + (size_t)kt * 128; }
};

struct EpiPool {
    const float* x; bf16_t* out;
    __device__ __forceinline__ void operator()(const f32x4 (&acc)[2][2][4][2], const pg8::Unit& u, int wr, int wc, int fr, int fq, LAS unsigned char*) const {
        const int row0 = u.pm * 256 + wr * 64 + fr, col0 = u.pn * 256 + wc * 32 + 8 * fq;
#pragma unroll
        for (int ai = 0; ai < 2; ++ai)
#pragma unroll
            for (int m = 0; m < 4; ++m) { const size_t ro = (size_t)(row0 + ai * 128 + m * 16) * DM + col0;
#pragma unroll
                for (int bj = 0; bj < 2; ++bj) { const f32x4 x0 = *(const f32x4*)(x + ro + bj * 128), x1 = *(const f32x4*)(x + ro + bj * 128 + 4);
                    const f32x4 v0 = acc[ai][bj][m][0] + x0, v1 = acc[ai][bj][m][1] + x1;
                    u32x4 w; w.x = cvt_pk_bf16(v0[0], v0[1]); w.y = cvt_pk_bf16(v0[2], v0[3]); w.z = cvt_pk_bf16(v1[0], v1[1]); w.w = cvt_pk_bf16(v1[2], v1[3]);
                    *(u32x4*)(out + ro + bj * 128) = w; } }
    }
};


__device__ __forceinline__ void bucket_experts(int b, int& ge_lo, int& ge_hi) { const int g = b / 6, p = b % 6; const int el = p < 3 ? 0 : (p < 5 ? 1 : 2), eh = p < 3 ? p + 1 : (p < 5 ? p - 1 : 3); ge_lo = g * 4 + el; ge_hi = g * 4 + eh; }
__device__ __forceinline__ void router_phase(const Args& a, Frame& F, const bf16_t* h, int layer) {
    const bf16_t* Wh = (const bf16_t*)(a.ws + WS_WR) + (size_t)layer * 32 * DM; const bf16_t* Wl = Wh + (size_t)2 * 32 * DM;
    unsigned* cnt = (unsigned*)(a.ws + WS_CTL) + CW_CNT + layer * NBKT * 64;
    int* list = (int*)(a.ws + WS_LIST); f32x4* meta = (f32x4*)(a.ws + WS_META);
    LAS float* lg = (LAS float*)(F.lds + F.wave * 2048);
    const int gw = F.vcu * NWAVES + F.wave, NGW = F.G * NWAVES, tk = F.lane & 15, q = F.lane >> 4;
    for (int tile = gw; tile < T / 16; tile += NGW) {
        const int tok0 = tile * 16;
        f32x4 c0 = {0.f, 0.f, 0.f, 0.f}, c1 = c0, css = c0;
        const bf16_t* hp = h + (size_t)(tok0 + tk) * DM + 8 * q; const bf16_t* w0 = Wh + (size_t)tk * DM + 8 * q; const bf16_t* w0l = Wl + (size_t)tk * DM + 8 * q;
#pragma unroll 4
        for (int s = 0; s < DM / 32; ++s) {
            const bf16x8 hf = *(const bf16x8*)(hp + 32 * s);
            const bf16x8 a0 = *(const bf16x8*)(w0 + 32 * s), a0l = *(const bf16x8*)(w0l + 32 * s), a1 = *(const bf16x8*)(w0 + 16 * DM + 32 * s), a1l = *(const bf16x8*)(w0l + 16 * DM + 32 * s);
            c0 = __builtin_amdgcn_mfma_f32_16x16x32_bf16(a0, hf, c0, 0, 0, 0); c0 = __builtin_amdgcn_mfma_f32_16x16x32_bf16(a0l, hf, c0, 0, 0, 0);
            c1 = __builtin_amdgcn_mfma_f32_16x16x32_bf16(a1, hf, c1, 0, 0, 0); c1 = __builtin_amdgcn_mfma_f32_16x16x32_bf16(a1l, hf, c1, 0, 0, 0);
            css = __builtin_amdgcn_mfma_f32_16x16x32_bf16(hf, hf, css, 0, 0, 0);
        }
#pragma unroll
        for (int r = 0; r < 4; ++r) lg[tk * 24 + 4 * q + r] = c0[r];
        if (q == 0) {
#pragma unroll
            for (int r = 0; r < 4; ++r) lg[tk * 24 + 16 + r] = c1[r]; }
        if (q == (tk >> 2)) { const int rr = tk & 3; lg[384 + tk] = rr == 0 ? css[0] : (rr == 1 ? css[1] : (rr == 2 ? css[2] : css[3])); }
        LDS_WAIT(); asm volatile("" ::: "memory");
        if (F.lane < 16) {
            const float rstd = 1.0f / sqrtf(lg[384 + tk] * (1.0f / DM) + EPS);
            float gl[4], el[4];
#pragma unroll
            for (int g = 0; g < 4; ++g) gl[g] = lg[tk * 24 + 16 + g] * rstd + a.b_grp[layer * NGRP + g];
            int gs = 0; float gm = gl[0];
#pragma unroll
            for (int g = 1; g < 4; ++g) if (gl[g] > gm) { gm = gl[g]; gs = g; }
            float den = 0.f;
#pragma unroll
            for (int g = 0; g < 4; ++g) den += __expf(gl[g] - gm);
            const float gwt = 1.0f / den;
#pragma unroll
            for (int e = 0; e < 4; ++e) el[e] = lg[tk * 24 + gs * 4 + e] * rstd + a.b_rt[(layer * NGRP + gs) * EPG + e];
            int i1 = 0; float v1 = el[0];
#pragma unroll
            for (int e = 1; e < 4; ++e) if (el[e] > v1) { v1 = el[e]; i1 = e; }
            int i2 = -1; float v2 = -3.0e38f;
#pragma unroll
            for (int e = 0; e < 4; ++e) if (e != i1 && el[e] > v2) { v2 = el[e]; i2 = e; }
            const float w1 = gwt / (1.0f + __expf(v2 - v1)), w2 = gwt - w1;
            const int elo = i1 < i2 ? i1 : i2, ehi = i1 < i2 ? i2 : i1; const float wlo = i1 < i2 ? w1 : w2, whi = i1 < i2 ? w2 : w1;
            const int pidx = elo == 0 ? ehi - 1 : (elo == 1 ? ehi + 1 : 5);
            const int b = gs * 6 + pidx;
            const unsigned pos = __hip_atomic_fetch_add(cnt + b * 64, 1u, __ATOMIC_RELAXED, __HIP_MEMORY_SCOPE_AGENT);
            list[(size_t)b * T + pos] = tok0 + tk;
            meta[(size_t)b * T + pos] = (f32x4){rstd, wlo, whi, 0.f};
        }
        LDS_WAIT(); asm volatile("" ::: "memory");
    }
}

constexpr int MAXU = 8;
struct MoeTab { LAS int* ud; LAS unsigned* rowtab; };
__device__ __forceinline__ void moe_build(const Args& a, Frame& F, int layer, bool gather) {
    LAS int* ud = (LAS int*)(F.lds + UDESC_OFF); LAS int* tb = ud + MAXU * 8;
    LAS unsigned* rowtab = (LAS unsigned*)(F.lds + ROWTAB_OFF);
    const unsigned* cnt = (const unsigned*)(a.ws + WS_CTL) + CW_CNT + layer * NBKT * 64;
    const int* list = (const int*)(a.ws + WS_LIST);
    __syncthreads();
    if (F.tid == 0) { int base = 0; for (int b = 0; b < NBKT; ++b) { const int c = (int)__hip_atomic_load(cnt + b * 64, __ATOMIC_RELAXED, __HIP_MEMORY_SCOPE_AGENT); tb[b] = base; tb[32 + b] = c; base += (c + 255) >> 8; } tb[NBKT] = base; }
    __syncthreads();
    if (F.tid < MAXU) { const int i = F.tid, L = i * F.G + F.vcu, R = tb[NBKT]; int v = 0, rt = 0, pn = 0, b = 0, ti = 0, nv = 0;
        if (L < 8 * R) { v = 1; rt = L >> 3; pn = L & 7; while (tb[b + 1] <= rt) ++b; ti = rt - tb[b]; nv = tb[32 + b] - 256 * ti; if (nv > 256) nv = 256; }
        ud[i * 8 + 0] = rt; ud[i * 8 + 1] = pn; ud[i * 8 + 2] = b; ud[i * 8 + 3] = ti; ud[i * 8 + 4] = nv; ud[i * 8 + 5] = v; }
    __syncthreads();
    if (gather) for (int e = F.tid; e < MAXU * 256; e += NTHR) { const int i = e >> 8, r = e & 255; unsigned off = 0;
        if (ud[i * 8 + 5]) { const int b = ud[i * 8 + 2], ti = ud[i * 8 + 3], nv = ud[i * 8 + 4]; const int rr = r < nv ? r : nv - 1; off = (unsigned)list[(size_t)b * T + 256 * ti + rr] * (unsigned)(DM * 2); }
        rowtab[e] = off; }
    VM_WAIT(); __syncthreads();
}
__device__ __forceinline__ int rfl(int v) { return __builtin_amdgcn_readfirstlane(v); }
struct SchedMoe {
    const char* A; const char* W; unsigned ldb_bytes; LAS int* ud; LAS unsigned* rowtab; int layer; int down;
    __device__ __forceinline__ bool next(int i, pg8::Unit& u) const { if (i >= MAXU) return false; if (!rfl(ud[i * 8 + 5])) return false; u.j = i; u.pm = rfl(ud[i * 8 + 0]); u.pn = rfl(ud[i * 8 + 1]); u.aux = rfl(ud[i * 8 + 2]); return true; }
    __device__ __forceinline__ unsigned row_off(const pg8::Unit& u, int r) const { return down ? (unsigned)(u.pm * 256 + r) * (unsigned)(2 * FF * 2) : rowtab[u.j * 256 + r]; }
    __device__ __forceinline__ const char* b_ptr(const pg8::Unit& u, int kt) const {
        int gl, gh; bucket_experts(u.aux, gl, gh);
        if (!down) { const int ge = u.pn < 4 ? gl : gh; return W + ((size_t)(layer * NE + ge) * 1024 + (size_t)(u.pn & 3) * 256) * (size_t)(DM * 2) + (size_t)kt * 128; }
        const int ge = kt < 8 ? gl : gh; return W + ((size_t)(layer * NE + ge) * DM + (size_t)u.pn * 256) * (size_t)(FF * 2) + (size_t)(kt & 7) * 128;
    }
};
struct EpiSwiGLU {
    const f32x4* meta; bf16_t* H; LAS int* ud;
    __device__ __forceinline__ void operator()(const f32x4 (&acc)[2][2][4][2], const pg8::Unit& u, int wr, int wc, int fr, int fq, LAS unsigned char*) const {
        const int b = u.aux, ti = rfl(ud[u.j * 8 + 3]);
        const size_t mrow0 = (size_t)b * T + 256 * ti; const int hi = u.pn >> 2;
        const int hcol = hi * 512 + (u.pn & 3) * 128 + wc * 32 + 8 * fq;
#pragma unroll
        for (int ai = 0; ai < 2; ++ai)
#pragma unroll
            for (int m = 0; m < 4; ++m) { const int r = ai * 128 + wr * 64 + m * 16 + fr; const f32x4 mt = meta[mrow0 + r]; const float rstd = mt.x, w = hi ? mt.z : mt.y;
                float o[8];
#pragma unroll
                for (int n = 0; n < 2; ++n)
#pragma unroll
                    for (int j = 0; j < 4; ++j) { const float g = acc[ai][0][m][n][j] * rstd, up = acc[ai][1][m][n][j] * rstd; o[n * 4 + j] = g * __builtin_amdgcn_rcpf(1.0f + __expf(-g)) * up * w; }
                u32x4 pk; pk.x = cvt_pk_bf16(o[0], o[1]); pk.y = cvt_pk_bf16(o[2], o[3]); pk.z = cvt_pk_bf16(o[4], o[5]); pk.w = cvt_pk_bf16(o[6], o[7]);
                *(u32x4*)(H + (size_t)(u.pm * 256 + r) * (2 * FF) + hcol) = pk; }
    }
};
template <bool OUT_F32> struct EpiDown {
    const int* list; const bf16_t* hin; void* out; LAS int* ud;
    __device__ __forceinline__ void operator()(const f32x4 (&acc)[2][2][4][2], const pg8::Unit& u, int wr, int wc, int fr, int fq, LAS unsigned char*) const {
        const int b = u.aux, ti = rfl(ud[u.j * 8 + 3]), nv = rfl(ud[u.j * 8 + 4]);
        const int col0 = u.pn * 256 + wc * 32 + 8 * fq;
#pragma unroll
        for (int ai = 0; ai < 2; ++ai)
#pragma unroll
            for (int m = 0; m < 4; ++m) { const int r = ai * 128 + wr * 64 + m * 16 + fr;
                if (r < nv) { const int tok = list[(size_t)b * T + 256 * ti + r]; const size_t ro = (size_t)tok * DM + col0;
#pragma unroll
                    for (int bj = 0; bj < 2; ++bj) { const u32x4 hv = *(const u32x4*)(hin + ro + bj * 128);
                        const f32x4 v0 = acc[ai][bj][m][0] + (f32x4){bflo(hv.x), bfhi(hv.x), bflo(hv.y), bfhi(hv.y)}, v1 = acc[ai][bj][m][1] + (f32x4){bflo(hv.z), bfhi(hv.z), bflo(hv.w), bfhi(hv.w)};
                        if (OUT_F32) { float* o = (float*)out + ro + bj * 128; *(f32x4*)o = v0; *(f32x4*)(o + 4) = v1; }
                        else { u32x4 w; w.x = cvt_pk_bf16(v0[0], v0[1]); w.y = cvt_pk_bf16(v0[2], v0[3]); w.z = cvt_pk_bf16(v1[0], v1[1]); w.w = cvt_pk_bf16(v1[2], v1[3]); *(u32x4*)((bf16_t*)out + ro + bj * 128) = w; } } } }
    }
};


__device__ __forceinline__ void rstd_phase(Frame& F, const bf16_t* h, float* rstd) {
    const int gw = F.vcu * NWAVES + F.wave, NGW = F.G * NWAVES;
    for (int row = gw; row < T; row += NGW) {
        const u32x4* p = (const u32x4*)(h + (size_t)row * DM) + F.lane; float ss = 0.f;
#pragma unroll
        for (int j = 0; j < 4; ++j) { const u32x4 v = p[64 * j];
            const float a0 = bflo(v.x), a1 = bfhi(v.x), a2 = bflo(v.y), a3 = bfhi(v.y), a4 = bflo(v.z), a5 = bfhi(v.z), a6 = bflo(v.w), a7 = bfhi(v.w);
            ss += (a0 * a0 + a1 * a1) + (a2 * a2 + a3 * a3) + (a4 * a4 + a5 * a5) + (a6 * a6 + a7 * a7); }
        ss = wave_sum(ss);
        if (F.lane == 0) rstd[row] = 1.0f / sqrtf(ss * (1.0f / DM) + EPS);
    }
}

struct EpiRes {
    const bf16_t* hin; bf16_t* out;
    __device__ __forceinline__ void operator()(const f32x4 (&acc)[2][2][4][2], const pg8::Unit& u, int wr, int wc, int fr, int fq, LAS unsigned char*) const {
        const int row0 = u.pm * 256 + wr * 64 + fr, col0 = u.pn * 256 + wc * 32 + 8 * fq;
#pragma unroll
        for (int ai = 0; ai < 2; ++ai)
#pragma unroll
            for (int m = 0; m < 4; ++m) { const size_t ro = (size_t)(row0 + ai * 128 + m * 16) * DM + col0;
#pragma unroll
                for (int bj = 0; bj < 2; ++bj) { const u32x4 hv = *(const u32x4*)(hin + ro + bj * 128);
                    const f32x4 v0 = acc[ai][bj][m][0] + (f32x4){bflo(hv.x), bfhi(hv.x), bflo(hv.y), bfhi(hv.y)}, v1 = acc[ai][bj][m][1] + (f32x4){bflo(hv.z), bfhi(hv.z), bflo(hv.w), bfhi(hv.w)};
                    u32x4 w; w.x = cvt_pk_bf16(v0[0], v0[1]); w.y = cvt_pk_bf16(v0[2], v0[3]); w.z = cvt_pk_bf16(v1[0], v1[1]); w.w = cvt_pk_bf16(v1[2], v1[3]);
                    *(u32x4*)(out + ro + bj * 128) = w; } }
    }
};

constexpr float QSCALE = 0.08838834764831845f * 1.4426950408889634f;
struct EpiQKV {
    const float* rstd; const float* qn; const float* kn; bf16_t* q; bf16_t* k; bf16_t* v;
    __device__ __forceinline__ void operator()(const f32x4 (&acc)[2][2][4][2], const pg8::Unit& u, int wr, int wc, int fr, int fq, LAS unsigned char* lds) const {
        const int which = u.pn >> 3, colt = (u.pn & 7) * 256;
        bf16_t* dst = q + (size_t)which * ((WS_K - WS_Q) / 2);
        const int col0 = colt + wc * 32 + 8 * fq;
        LAS float* EX = (LAS float*)(lds + EX_OFF);
        const bool normed = which != 2;
        if (normed) {
#pragma unroll
            for (int ai = 0; ai < 2; ++ai)
#pragma unroll
                for (int m = 0; m < 4; ++m)
#pragma unroll
                    for (int bj = 0; bj < 2; ++bj) { const f32x4 v0 = acc[ai][bj][m][0], v1 = acc[ai][bj][m][1];
                        float s = (v0[0] * v0[0] + v0[1] * v0[1]) + (v0[2] * v0[2] + v0[3] * v0[3]) + (v1[0] * v1[0] + v1[1] * v1[1]) + (v1[2] * v1[2] + v1[3] * v1[3]);
                        s += __shfl_xor(s, 16); s += __shfl_xor(s, 32);
                        if (fq == 0) EX[((ai * 128 + wr * 64 + m * 16 + fr) * 2 + bj) * 4 + wc] = s; }
            asm volatile("s_waitcnt lgkmcnt(0)" ::: "memory"); __builtin_amdgcn_s_barrier(); asm volatile("" ::: "memory");
        }
        f32x4 g0 = (f32x4){1.f, 1.f, 1.f, 1.f}, g1 = g0;
        if (which == 0) { g0 = *(const f32x4*)(qn + wc * 32 + 8 * fq) * QSCALE; g1 = *(const f32x4*)(qn + wc * 32 + 8 * fq + 4) * QSCALE; }
        if (which == 1) { g0 = *(const f32x4*)(kn + wc * 32 + 8 * fq); g1 = *(const f32x4*)(kn + wc * 32 + 8 * fq + 4); }
#pragma unroll
        for (int ai = 0; ai < 2; ++ai)
#pragma unroll
            for (int m = 0; m < 4; ++m) { const int r = ai * 128 + wr * 64 + m * 16 + fr; const size_t ro = (size_t)(u.pm * 256 + r) * DM + col0;
                const float rs = rstd[u.pm * 256 + r];
#pragma unroll
                for (int bj = 0; bj < 2; ++bj) { float f = rs;
                    if (normed) { const f32x4 pp = *(const LAS f32x4*)(EX + (r * 2 + bj) * 4); const float tot = ((pp[0] + pp[1]) + (pp[2] + pp[3])) * rs * rs; f = rs / sqrtf(tot * (1.0f / HD) + EPS); }
                    const f32x4 v0 = acc[ai][bj][m][0] * f * g0, v1 = acc[ai][bj][m][1] * f * g1;
                    u32x4 w; w.x = cvt_pk_bf16(v0[0], v0[1]); w.y = cvt_pk_bf16(v0[2], v0[3]); w.z = cvt_pk_bf16(v1[0], v1[1]); w.w = cvt_pk_bf16(v1[2], v1[3]);
                    *(u32x4*)(dst + ro + bj * 128) = w; }
                asm volatile("" ::: "memory"); }
    }
};

typedef short v4i16_t __attribute__((ext_vector_type(4)));
__device__ __forceinline__ s16x4 vtr(const LAS char* p) { return __builtin_bit_cast(s16x4, __builtin_amdgcn_ds_read_tr16_b64_v4i16((LAS v4i16_t*)p)); }
__device__ __forceinline__ void attn_phase(Frame& F, const bf16_t* Q, const bf16_t* K, const bf16_t* V, bf16_t* O) {
    const int lane = F.lane, wid = F.wave, tid = F.tid, r32 = lane & 31, hi = lane >> 5;
    LAS char* lds = (LAS char*)F.lds;
    LAS unsigned* dflag = (LAS unsigned*)(F.lds + MISC_OFF + 64);
    unsigned ksrc[2], vsrc[2];
#pragma unroll
    for (int i = 0; i < 2; ++i) { const int p = i * 512 + tid, row = p >> 4, cp = p & 15; const int X = ((row & 3) << 2) | ((row >> 2) & 3);
        ksrc[i] = (unsigned)(row * (DM * 2) + ((cp ^ X) * 16)); vsrc[i] = (unsigned)(row * (DM * 2) + ((cp ^ ((row & 3) << 2)) * 16)); }
    const int Xr = ((r32 & 3) << 2) | ((r32 >> 2) & 3);
    const int kbase = 256 * r32 + 16 * (hi ^ Xr);
    const int g4 = lane >> 4, qq = (lane & 15) >> 2, pp = lane & 3;
    int vb[4];
#pragma unroll
    for (int db = 0; db < 4; ++db) vb[db] = 256 * (4 * (g4 >> 1) + qq) + 64 * (db ^ qq) + 32 * (g4 & 1) + 16 * (pp >> 1) + 8 * (pp & 1);
#define AT_STAGE(jt, buf) do { const char* _kt = kg + (size_t)(jt) * 64 * (DM * 2); const char* _vt = vg + (size_t)(jt) * 64 * (DM * 2); \
        _Pragma("unroll") for (int _i = 0; _i < 2; ++_i) __builtin_amdgcn_global_load_lds((const unsigned*)(_kt + ksrc[_i]), (LAS unsigned*)(lds + (buf) * 16384 + _i * 8192 + wid * 1024), 16, 0, 0); \
        _Pragma("unroll") for (int _i = 0; _i < 2; ++_i) __builtin_amdgcn_global_load_lds((const unsigned*)(_vt + vsrc[_i]), (LAS unsigned*)(lds + 32768 + (buf) * 16384 + _i * 8192 + wid * 1024), 16, 0, 0); } while (0)
    for (int it = 0;; ++it) {
        const int idx = it * F.G + F.vcu; if (idx >= BATCH * NH * (SEQ / 256)) break;
        const int bh = idx & 255, qb = idx >> 8, b = bh >> 4, h = bh & 15;
        const size_t rowbase = (size_t)b * SEQ;
        const int t0w = qb * 256 + wid * 32, t = t0w + r32;
        bf16x8 qf[8];
        { const bf16_t* qp = Q + (rowbase + t) * DM + h * HD + 8 * hi;
#pragma unroll
          for (int s = 0; s < 8; ++s) qf[s] = *(const bf16x8*)(qp + 16 * s); }
        f32x16 o[4];
#pragma unroll
        for (int db = 0; db < 4; ++db)
#pragma unroll
            for (int r = 0; r < 16; ++r) o[db][r] = 0.f;
        float C = 1.0f;
        const char* kg = (const char*)(K + rowbase * DM + h * HD); const char* vg = (const char*)(V + rowbase * DM + h * HD);
        const int jmax = 4 * qb + 3;
        __builtin_amdgcn_s_barrier();
        AT_STAGE(jmax, 0);
        for (int jt = jmax, n = 0; jt >= 0; --jt, ++n) {
            const int buf = n & 1;
            if (jt > 0) { AT_STAGE(jt - 1, buf ^ 1); asm volatile("s_waitcnt vmcnt(4)" ::: "memory"); }
            else asm volatile("s_waitcnt vmcnt(0)" ::: "memory");
            __builtin_amdgcn_s_barrier(); asm volatile("" ::: "memory");
            if (64 * jt <= t0w + 30) {
                const LAS char* kb = lds + buf * 16384; const LAS char* vbuf = lds + 32768 + buf * 16384;
                f32x16 p[2];
#pragma unroll
                for (int sub = 0; sub < 2; ++sub) {
#pragma unroll
                    for (int r = 0; r < 16; ++r) p[sub][r] = 0.f;
#pragma unroll
                    for (int s = 0; s < 8; ++s) { const bf16x8 kf = *(const LAS bf16x8*)(kb + sub * 8192 + (kbase ^ (32 * s))); p[sub] = __builtin_amdgcn_mfma_f32_32x32x16_bf16(kf, qf[s], p[sub], 0, 0, 0); } }
                const bool needmask = (64 * jt + 63 >= t0w);
                bf16x8 pf[4];
#pragma unroll
                for (int sub = 1; sub >= 0; --sub) {
                    float E[16], sfx[16], gt[4], pr[4], om[4];
#pragma unroll
                    for (int r = 0; r < 16; ++r) { float e = __builtin_amdgcn_exp2f(p[sub][r]);
                        if (needmask) { const int key = 64 * jt + 32 * sub + (r & 3) + 8 * (r >> 2) + 4 * hi; e = key < t ? e : 0.f; }
                        E[r] = e; }
#pragma unroll
                    for (int a = 0; a < 4; ++a) { const float s3 = 1.0f + E[4 * a + 3], s2 = (1.0f + E[4 * a + 2]) * s3, s1 = (1.0f + E[4 * a + 1]) * s2, s0 = (1.0f + E[4 * a]) * s1;
                        sfx[4 * a + 3] = s3; sfx[4 * a + 2] = s2; sfx[4 * a + 1] = s1; sfx[4 * a] = s0; gt[a] = s0; }
#pragma unroll
                    for (int a = 0; a < 4; ++a) { auto rr = __builtin_amdgcn_permlane32_swap(__float_as_uint(gt[a]), __float_as_uint(gt[a]), false, false);
                        const float x0 = __uint_as_float(rr[0]), x1 = __uint_as_float(rr[1]); pr[a] = x0 * x1; om[a] = hi ? 1.0f : x1; }
                    float R[4]; R[3] = C; R[2] = R[3] * pr[3]; R[1] = R[2] * pr[2]; R[0] = R[1] * pr[1]; C = R[0] * pr[0];
                    float A[16];
#pragma unroll
                    for (int a = 0; a < 4; ++a) { const float ap = R[a] * om[a];
#pragma unroll
                        for (int bb = 0; bb < 4; ++bb) A[4 * a + bb] = E[4 * a + bb] * __builtin_amdgcn_rcpf(sfx[4 * a + bb] * ap); }
#pragma unroll
                    for (int s2 = 0; s2 < 2; ++s2) { u32x4 w; w.x = cvt_pk_bf16(A[8 * s2 + 0], A[8 * s2 + 1]); w.y = cvt_pk_bf16(A[8 * s2 + 2], A[8 * s2 + 3]); w.z = cvt_pk_bf16(A[8 * s2 + 4], A[8 * s2 + 5]); w.w = cvt_pk_bf16(A[8 * s2 + 6], A[8 * s2 + 7]);
                        pf[sub * 2 + s2] = __builtin_bit_cast(bf16x8, w); }
                }
#pragma unroll
                for (int ks = 0; ks < 4; ++ks) { const int kb0 = 16 * ks;
#pragma unroll
                    for (int db = 0; db < 4; ++db) { const s16x4 v0 = vtr(vbuf + vb[db] + 256 * kb0), v1 = vtr(vbuf + vb[db] + 256 * (kb0 + 8));
                        const bf16x8 vf = __builtin_shufflevector(v0, v1, 0, 1, 2, 3, 4, 5, 6, 7);
                        o[db] = __builtin_amdgcn_mfma_f32_32x32x16_bf16(vf, pf[ks], o[db], 0, 0, 0); } }
            }
            { const unsigned wd = __all(C >= 4294967296.0f) ? 1u : 0u; if (lane == 0) dflag[wid] = wd; }
            asm volatile("s_waitcnt lgkmcnt(0)" ::: "memory"); __builtin_amdgcn_s_barrier(); asm volatile("" ::: "memory");
            if (jt > 0) { const u32x4 f0 = *(const LAS u32x4*)dflag, f1 = *(const LAS u32x4*)(dflag + 4);
                if ((f0.x & f0.y & f0.z & f0.w & f1.x & f1.y & f1.z & f1.w) != 0u) break; }
        }
        bf16_t* op = O + (rowbase + t) * DM + h * HD + 4 * hi;
#pragma unroll
        for (int db = 0; db < 4; ++db)
#pragma unroll
            for (int a = 0; a < 4; ++a) { u32x2 w; w.x = cvt_pk_bf16(o[db][4 * a], o[db][4 * a + 1]); w.y = cvt_pk_bf16(o[db][4 * a + 2], o[db][4 * a + 3]); *(u32x2*)(op + 32 * db + 8 * a) = w; }
    }
#undef AT_STAGE
    asm volatile("s_waitcnt vmcnt(0)" ::: "memory"); __builtin_amdgcn_s_barrier();
}

__device__ __forceinline__ void dump_bf16(Frame& F, const bf16_t* src, float* out) {
    const size_t n8 = (size_t)T * DM / 8;
    for (size_t i = (size_t)F.vcu * NTHR + F.tid; i < n8; i += (size_t)F.G * NTHR) {
        const u32x4 v = *(const u32x4*)(src + i * 8);
        f32x4 a = (f32x4){bflo(v.x), bfhi(v.x), bflo(v.y), bfhi(v.y)}, b = (f32x4){bflo(v.z), bfhi(v.z), bflo(v.w), bfhi(v.w)};
        *(f32x4*)(out + i * 8) = a; *(f32x4*)(out + i * 8 + 4) = b;
    }
}

constexpr int N_PHASES = 13;
__global__ void __launch_bounds__(NTHR, 2) fwd(Args args) {
    extern __shared__ __attribute__((aligned(16))) unsigned char lds_raw[];
    Frame F;
    F.lds = (LAS unsigned char*)lds_raw;
    F.tid = threadIdx.x; F.lane = F.tid & 63; F.wave = __builtin_amdgcn_readfirstlane(F.tid >> 6);
    F.G = gridDim.x; { const int bx = blockIdx.x; F.vcu = (F.G % 8 == 0) ? (bx % 8) * (F.G / 8) + bx / 8 : bx; }
    volatile LAS unsigned* MISC = (volatile LAS unsigned*)(F.lds + MISC_OFF);
    if (F.tid < 64) MISC[F.tid] = 0u;
    __syncthreads();
    unsigned* ctl = (unsigned*)(args.ws + WS_CTL);
    XcdBarrier bar; bar.bar = ctl + CW_BAR; bar.x = 0; bar.st = nullptr;
    if (N_LAUNCH_MODE == 1) bar = xcd_barrier_post(ctl + CW_BAR, MISC + 8);
    const int lo = args.ph_lo, hi = args.ph_hi;
#define IN(k) (lo <= (k) && (k) < hi)
#define SEAM(k) do { if (N_LAUNCH_MODE == 1 && IN(k) && IN((k) + 1)) xcd_barrier(bar); } while (0)
    bf16_t* pooled = (bf16_t*)(args.ws + WS_Q);
    bf16_t* h1 = (bf16_t*)(args.ws + WS_K);
    bf16_t* h2 = (bf16_t*)(args.ws + WS_HB);
    bf16_t* h3 = (bf16_t*)(args.ws + WS_HC);

    if (IN(0)) for (int rep = 0; rep < REP_P0; ++rep) { p0_weights(args, F); p0_pool(args, F, pooled); }
    SEAM(0);
    if (IN(1)) {
        SchedPlain S{(const char*)pooled, (const char*)(args.ws + WS_WPOOL), DM * 2, PGC * 2, T / 256, 8, F.G, F.vcu, 1};
        EpiPool E{args.x, h1};
        pg8::gemm_phase<EpiPool, SchedPlain>(F.lds, PGC, S, E);
    }
    SEAM(1);
    if (IN(2)) router_phase(args, F, h1, 0);
    SEAM(2);
    if (IN(3)) {
        moe_build(args, F, 0, true);
        SchedMoe S{(const char*)h1, (const char*)(args.ws + WS_WGU), DM * 2, (LAS int*)(F.lds + UDESC_OFF), (LAS unsigned*)(F.lds + ROWTAB_OFF), 0, 0};
        EpiSwiGLU E{(const f32x4*)(args.ws + WS_META), (bf16_t*)(args.ws + WS_HMOE), (LAS int*)(F.lds + UDESC_OFF)};
        pg8::gemm_phase<EpiSwiGLU, SchedMoe>(F.lds, DM, S, E);
    }
    SEAM(3);
    if (IN(4)) {
        moe_build(args, F, 0, false);
        SchedMoe S{(const char*)(args.ws + WS_HMOE), (const char*)(args.ws + WS_WD), FF * 2, (LAS int*)(F.lds + UDESC_OFF), (LAS unsigned*)(F.lds + ROWTAB_OFF), 0, 1};
        EpiDown<false> E{(const int*)(args.ws + WS_LIST), h1, (void*)h2, (LAS int*)(F.lds + UDESC_OFF)};
        pg8::gemm_phase<EpiDown<false>, SchedMoe>(F.lds, 2 * FF, S, E);
    }
    SEAM(4);
#if STOP_AFTER == 1
    if (IN(12)) dump_bf16(F, h1, args.out);
#endif
#if STOP_AFTER == 2
    if (IN(12)) dump_bf16(F, h2, args.out);
#endif
#if STOP_AFTER >= 3
    bf16_t* qb_ = (bf16_t*)(args.ws + WS_Q); bf16_t* kb_ = (bf16_t*)(args.ws + WS_K); bf16_t* vb_ = (bf16_t*)(args.ws + WS_V);
    bf16_t* ob_ = (bf16_t*)args.out;
    float* rstd2 = (float*)(args.ws + WS_RSTD);
    if (IN(5)) rstd_phase(F, h2, rstd2);
    SEAM(5);
#ifndef SKIP_QKV
    if (IN(6)) {
        SchedPlain S{(const char*)h2, (const char*)(args.ws + WS_WQKV), DM * 2, DM * 2, T / 256, 24, F.G, F.vcu, 0};
        EpiQKV E{rstd2, args.q_norm, args.k_norm, qb_, kb_, vb_};
        pg8::gemm_phase<EpiQKV, SchedPlain>(F.lds, DM, S, E);
    }
#endif
    SEAM(6);
#ifndef SKIP_ATTN
    if (IN(7)) for (int rep = 0; rep < REP_ATTN; ++rep) attn_phase(F, qb_, kb_, vb_, ob_);
#endif
    SEAM(7);
    if (IN(8)) {
        SchedPlain S{(const char*)ob_, (const char*)(args.ws + WS_WO), DM * 2, DM * 2, T / 256, 8, F.G, F.vcu, 0};
        EpiRes E{h2, h3};
        pg8::gemm_phase<EpiRes, SchedPlain>(F.lds, DM, S, E);
    }
    SEAM(8);
#endif
#if STOP_AFTER == 3
    if (IN(12)) dump_bf16(F, h3, args.out);
#endif
#if STOP_AFTER >= 4
    if (IN(9)) router_phase(args, F, h3, 1);
    SEAM(9);
    if (IN(10)) {
        moe_build(args, F, 1, true);
        SchedMoe S{(const char*)h3, (const char*)(args.ws + WS_WGU), DM * 2, (LAS int*)(F.lds + UDESC_OFF), (LAS unsigned*)(F.lds + ROWTAB_OFF), 1, 0};
        EpiSwiGLU E{(const f32x4*)(args.ws + WS_META), (bf16_t*)(args.ws + WS_HMOE), (LAS int*)(F.lds + UDESC_OFF)};
        pg8::gemm_phase<EpiSwiGLU, SchedMoe>(F.lds, DM, S, E);
    }
    SEAM(10);
    if (IN(11)) {
        moe_build(args, F, 1, false);
        SchedMoe S{(const char*)(args.ws + WS_HMOE), (const char*)(args.ws + WS_WD), FF * 2, (LAS int*)(F.lds + UDESC_OFF), (LAS unsigned*)(F.lds + ROWTAB_OFF), 1, 1};
        EpiDown<true> E{(const int*)(args.ws + WS_LIST), h3, (void*)args.out, (LAS int*)(F.lds + UDESC_OFF)};
        pg8::gemm_phase<EpiDown<true>, SchedMoe>(F.lds, 2 * FF, S, E);
    }
#endif
#undef IN
#undef SEAM
}

extern "C" void kernel_launch(void* const* d_in, const int* in_sizes, int n_in, void* d_out, int out_size, void* d_ws, size_t ws_size, hipStream_t stream) {
    static int grid = 0;
    if (grid == 0) {
        if (n_in != 18 || out_size != T * DM || ws_size < WS_END) { fprintf(stderr, "kernel_launch: unexpected sizes (n_in %d out %d ws %zu)\n", n_in, out_size, ws_size); grid = -1; return; }
        int dev = 0, cus = 0, per_cu = 0;
        if (hipGetDevice(&dev) != hipSuccess || hipDeviceGetAttribute(&cus, hipDeviceAttributeMultiprocessorCount, dev) != hipSuccess) { grid = -1; return; }
        if (hipFuncSetAttribute((const void*)fwd, hipFuncAttributeMaxDynamicSharedMemorySize, LDS_BYTES) != hipSuccess) { fprintf(stderr, "kernel_launch: hipFuncSetAttribute failed\n"); grid = -1; return; }
        if (hipOccupancyMaxActiveBlocksPerMultiprocessor(&per_cu, (const void*)fwd, NTHR, LDS_BYTES) != hipSuccess || per_cu < 1) fprintf(stderr, "kernel_launch: occupancy query says %d\n", per_cu);
        (void)hipGetLastError();
        grid = cus;
    }
    if (grid < 0) return;
    hipMemsetAsync((char*)d_ws + WS_CTL, 0, CTL_BYTES, stream);
    Args a{};
    a.x = (const float*)d_in[0]; a.norm_mix = (const float*)d_in[1]; a.norm_ffn = (const float*)d_in[2]; a.pool_w = (const float*)d_in[3]; a.pool_scale = (const float*)d_in[4];
    a.kv_norm = (const float*)d_in[5]; a.w_kv = (const float*)d_in[6]; a.k_norm = (const float*)d_in[7]; a.w_q = (const float*)d_in[8]; a.q_norm = (const float*)d_in[9]; a.w_o = (const float*)d_in[10];
    a.w_grp = (const float*)d_in[11]; a.b_grp = (const float*)d_in[12]; a.w_rt = (const float*)d_in[13]; a.b_rt = (const float*)d_in[14]; a.w_gate = (const float*)d_in[15]; a.w_up = (const float*)d_in[16]; a.w_down = (const float*)d_in[17];
    a.out = (float*)d_out; a.ws = (unsigned char*)d_ws;
    if (N_LAUNCH_MODE == 1) { a.ph_lo = 0; a.ph_hi = N_PHASES; hipLaunchKernelGGL(fwd, dim3(grid), dim3(NTHR), LDS_BYTES, stream, a); }
    else for (int p = 0; p < N_PHASES; ++p) { a.ph_lo = p; a.ph_hi = p + 1; hipLaunchKernelGGL(fwd, dim3(grid), dim3(NTHR), LDS_BYTES, stream, a); }
}
```

```cpp
#include <hip/hip_runtime.h>
#include <cstdio>
#include <cstdint>

#ifndef STOP_AFTER
#define STOP_AFTER 4
#endif
#ifndef REP_ATTN
#define REP_ATTN 1
#endif
#ifndef REP_P0
#define REP_P0 1
#endif
#ifndef N_LAUNCH_MODE
#define N_LAUNCH_MODE 1
#endif

#define LAS __attribute__((address_space(3)))
#define GAS __attribute__((address_space(1)))
typedef unsigned short bf16_t;
typedef short bf16x8 __attribute__((ext_vector_type(8)));
typedef short s16x4 __attribute__((ext_vector_type(4)));
typedef float f32x2 __attribute__((ext_vector_type(2)));
typedef float f32x4 __attribute__((ext_vector_type(4)));
typedef float f32x16 __attribute__((ext_vector_type(16)));
typedef unsigned u32x2 __attribute__((ext_vector_type(2)));
typedef unsigned u32x4 __attribute__((ext_vector_type(4)));

constexpr int BATCH = 16, SEQ = 2048, DM = 2048, T = BATCH * SEQ, NH = 16, HD = 128;
constexpr int NGRP = 4, EPG = 4, NE = 16, FF = 512, NBKT = 24;
constexpr int PGC = 512;
constexpr float EPS = 1e-6f;
constexpr int MAXRT = 152;
constexpr int NWAVES = 8, NTHR = 512;

constexpr size_t MiB = 1u << 20;
constexpr size_t WS_CTL = 0, CTL_BYTES = 1 * MiB;
constexpr size_t WS_WPOOL = 1 * MiB;
constexpr size_t WS_WQKV = 3 * MiB;
constexpr size_t WS_WO = 27 * MiB;
constexpr size_t WS_WGU = 35 * MiB;
constexpr size_t WS_X8 = 99 * MiB;
constexpr size_t WS_WD = 163 * MiB;
constexpr size_t WS_WR = 227 * MiB;
constexpr size_t WS_RSTD = 228 * MiB;
constexpr size_t WS_LIST = 229 * MiB;
constexpr size_t WS_META = 232 * MiB;
constexpr size_t WS_HMOE = 244 * MiB;
constexpr size_t WS_HB = 320 * MiB;
constexpr size_t WS_HC = 448 * MiB;
constexpr size_t WS_Q = 576 * MiB;
constexpr size_t WS_K = 704 * MiB;
constexpr size_t WS_V = 832 * MiB;
constexpr size_t WS_END = 960 * MiB;
constexpr int CW_BAR = 4096;
constexpr int CW_CNT = 16384;

constexpr int RING_BYTES = 131072;
constexpr int EX_OFF = RING_BYTES;
constexpr int ROWTAB_OFF = EX_OFF + 8192;
constexpr int UDESC_OFF = ROWTAB_OFF + 8192;
constexpr int MISC_OFF = UDESC_OFF + 1024;
constexpr int LDS_BYTES = 151552;
static_assert(MISC_OFF + 256 <= LDS_BYTES, "lds map");
static_assert(WS_V - WS_K == WS_K - WS_Q, "q|k|v spacing");

__device__ __forceinline__ unsigned f2bf(float f) { unsigned u = __builtin_bit_cast(unsigned, f); return (u + 0x7fffu + ((u >> 16) & 1u)) >> 16; }
__device__ __forceinline__ unsigned pk2(float lo, float hi) { return f2bf(lo) | (f2bf(hi) << 16); }
__device__ __forceinline__ float bf2f(unsigned short b) { return __builtin_bit_cast(float, ((unsigned)b) << 16); }
__device__ __forceinline__ float bflo(unsigned w) { return __builtin_bit_cast(float, w << 16); }
__device__ __forceinline__ float bfhi(unsigned w) { return __builtin_bit_cast(float, w & 0xffff0000u); }
__device__ __forceinline__ unsigned cvt_pk_bf16(float lo, float hi) { unsigned r; asm volatile("v_cvt_pk_bf16_f32 %0, %1, %2" : "=v"(r) : "v"(lo), "v"(hi)); return r; }
__device__ __forceinline__ float wave_sum(float v) {
#pragma unroll
    for (int o = 1; o < 64; o <<= 1) v += __shfl_xor(v, o);
    return v;
}
__device__ __forceinline__ unsigned pk4_fp8(float a, float b, float c, float d) {
    a = __builtin_amdgcn_fmed3f(a, -448.f, 448.f); b = __builtin_amdgcn_fmed3f(b, -448.f, 448.f); c = __builtin_amdgcn_fmed3f(c, -448.f, 448.f); d = __builtin_amdgcn_fmed3f(d, -448.f, 448.f);
    int r = __builtin_amdgcn_cvt_pk_fp8_f32(a, b, 0, false); r = __builtin_amdgcn_cvt_pk_fp8_f32(c, d, r, true); return (unsigned)r; }
#define LDS_WAIT() asm volatile("s_waitcnt lgkmcnt(0)" ::: "memory")
#define VM_WAIT() asm volatile("s_waitcnt vmcnt(0)" ::: "memory")

#define XB_TMO      128
#define XB_XCNT(j)  (256  + 64 * (j))
#define XB_XSUB(j)  (1280 + 64 * (j))
#define XB_XGEN(j)  (2304 + 64 * (j))
#define XB_TOP      3328
#define XB_TOPGEN   3392
#define XCD_BAR_WORDS 3456
#define XB_SPIN_CAP (1u << 18)
__device__ __forceinline__ unsigned xb_ld(unsigned* p)              { return __hip_atomic_load(p, __ATOMIC_RELAXED, __HIP_MEMORY_SCOPE_AGENT); }
__device__ __forceinline__ unsigned xb_add(unsigned* p, unsigned v) { return __hip_atomic_fetch_add(p, v, __ATOMIC_RELAXED, __HIP_MEMORY_SCOPE_AGENT); }
__device__ __forceinline__ unsigned xb_xcc_id() { return (unsigned)__builtin_amdgcn_s_getreg((3 << 11) | 20) & 0xFu; }
#define XB_SPIN(cond, bar) do { unsigned _sp = 0; while (cond) { __builtin_amdgcn_s_sleep(1); \
    if ((++_sp & 255u) == 0u) { if (xb_ld(&(bar)[XB_TMO])) break; if (_sp > XB_SPIN_CAP) { atomicAdd(&(bar)[XB_TMO], 1u); break; } } } } while (0)
struct XcdBarrier { unsigned* bar; unsigned x; volatile LAS unsigned* st; };
__device__ __forceinline__ XcdBarrier xcd_barrier_post(unsigned* bar, volatile LAS unsigned* st) {
    XcdBarrier b; b.bar = bar; b.x = xb_xcc_id(); b.st = st;
    if (threadIdx.x == 0) (void)xb_add(&bar[XB_XCNT(b.x)], 1u);
    return b;
}
__device__ __forceinline__ void xcd_barrier_complete(unsigned* bar, unsigned x, unsigned& nloc, unsigned& nx) {
    const unsigned G = gridDim.x * gridDim.y * gridDim.z;
    unsigned sum, cnt, mine, sp = 0u;
    for (;;) {
        sum = 0u; cnt = 0u; mine = 0u;
#pragma unroll
        for (unsigned j = 0; j < 16; ++j) { const unsigned c = xb_ld(&bar[XB_XCNT(j)]); sum += c; cnt += (c > 0u) ? 1u : 0u; mine = (j == x) ? c : mine; }
        if (sum == G) break;
        __builtin_amdgcn_s_sleep(1);
        if ((++sp & 255u) == 0u) { if (xb_ld(&bar[XB_TMO])) break; if (sp > XB_SPIN_CAP) { atomicAdd(&bar[XB_TMO], 1u); break; } }
    }
    nloc = mine > 0u ? mine : 1u; nx = cnt > 0u ? cnt : 1u;
}
__device__ __forceinline__ void xcd_barrier(const XcdBarrier& b) {
    asm volatile("s_waitcnt vmcnt(0)" ::: "memory");
    __syncthreads();
    if (threadIdx.x == 0) {
        unsigned* bar = b.bar;
        __builtin_amdgcn_s_waitcnt(0);
        unsigned nloc = b.st[0], nx = b.st[1];
        if (nloc == 0u) { xcd_barrier_complete(bar, b.x, nloc, nx); b.st[0] = nloc; b.st[1] = nx; }
        const unsigned old = xb_add(&bar[XB_XSUB(b.x)], 1u);
        const unsigned gen = old / nloc;
        if (old + 1u == (gen + 1u) * nloc) {
            __builtin_amdgcn_fence(__ATOMIC_RELEASE, "agent");
            asm volatile("s_waitcnt vmcnt(0)" ::: "memory");
            const unsigned og = xb_add(&bar[XB_TOP], 1u);
            const unsigned tg = og / nx;
            if (og + 1u == (tg + 1u) * nx) xb_add(&bar[XB_TOPGEN], 1u);
            else XB_SPIN(xb_ld(&bar[XB_TOPGEN]) == tg, bar);
            __builtin_amdgcn_fence(__ATOMIC_ACQUIRE, "agent");
            xb_add(&bar[XB_XGEN(b.x)], 1u);
            asm volatile("s_waitcnt vmcnt(0)" ::: "memory");
        } else {
            XB_SPIN(xb_ld(&bar[XB_XGEN(b.x)]) == gen, bar);
            __builtin_amdgcn_fence(__ATOMIC_ACQUIRE, "agent");
            asm volatile("s_waitcnt vmcnt(0)" ::: "memory");
        }
    }
    __syncthreads();
}

namespace pg8 {
constexpr int BM = 256, BK = 64, HALF = 128, HTB = HALF * BK * 2, STAGE_BYTES = 8 * HTB;
__host__ __device__ __forceinline__ int lds_byte(int r, int c) { const int st = (r >> 4) * 2 + (c >> 5), rr = r & 15, cc = c & 31, ob = rr * 64 + cc * 2; return st * 1024 + (ob ^ (((ob >> 9) & 1) << 5)); }
__host__ __device__ __forceinline__ void stage_rc(int b, int& R, int& C) { const int st = b / 1024, sb = b % 1024, swz = sb ^ (((sb >> 9) & 1) << 5); R = (st >> 1) * 16 + swz / 64; C = (st & 1) * 32 + (swz % 64) / 2; }
__host__ __device__ __forceinline__ int perm32(int rho) { const int n = rho >> 4, i = rho & 15; return 8 * (i >> 2) + 4 * n + (i & 3); }

struct Unit { int j, pm, pn, aux; };

typedef int v4i_t __attribute__((ext_vector_type(4)));
typedef int v8i_t __attribute__((ext_vector_type(8)));
template <class Epi, class Sched, bool FP8 = false>
__device__ __forceinline__ void gemm_phase(LAS unsigned char* lds, const int K, const Sched& S, const Epi& E) {
    const int tid = threadIdx.x, wid = __builtin_amdgcn_readfirstlane(tid >> 6), lane = tid & 63, wr = wid >> 2, wc = wid & 3, fr = lane & 15, fq = lane >> 4;
    const int nt = FP8 ? K / 128 : K / BK;
    int Rl[2], Cl2[2]; unsigned voffB[2];
#pragma unroll
    for (int i = 0; i < 2; ++i) { int R, C; stage_rc(tid * 16 + i * 8192, R, C); Rl[i] = R; Cl2[i] = C * 2; const int Rb = (R & ~31) + perm32(R & 31); voffB[i] = (unsigned)Rb * S.ldb_bytes + (unsigned)C * 2u; }
    const size_t kstep = (size_t)(BK * 2);
    const size_t hstepB = (size_t)HALF * S.ldb_bytes;
    const unsigned ldsw = (unsigned)wid * 1024u;
    const int aoff = lds_byte(wr * 64 + fr, fq * 8), boff = lds_byte(wc * 32 + fr, fq * 8);
#define PG8_SA(b, h) (((b) * 2 + (h)) * HTB)
#define PG8_SB(b, h) ((4 + (b) * 2 + (h)) * HTB)
#define PG8_STAGEB(bufoff, gbase) do { _Pragma("unroll") for (int _i = 0; _i < 2; ++_i) \
        __builtin_amdgcn_global_load_lds((const unsigned*)((const char*)(gbase) + voffB[_i]), (LAS unsigned*)(lds + (bufoff) + ldsw + _i * 8192), 16, 0, 0); } while (0)
#define PG8_STAGEA(bufoff, offs, h, kb) do { _Pragma("unroll") for (int _i = 0; _i < 2; ++_i) \
        __builtin_amdgcn_global_load_lds((const unsigned*)(S.A + (kb) + (offs)[(h) * 2 + _i]), (LAS unsigned*)(lds + (bufoff) + ldsw + _i * 8192), 16, 0, 0); } while (0)
#define PG8_LDA(dst, b, h) do { _Pragma("unroll") for (int m = 0; m < 4; ++m) _Pragma("unroll") for (int k = 0; k < 2; ++k) dst[m][k] = *(const LAS bf16x8*)(lds + PG8_SA(b, h) + aoff + m * 2048 + k * 1024); } while (0)
#define PG8_LDB(dst, b, h) do { _Pragma("unroll") for (int n = 0; n < 2; ++n) _Pragma("unroll") for (int k = 0; k < 2; ++k) dst[n][k] = *(const LAS bf16x8*)(lds + PG8_SB(b, h) + boff + n * 2048 + k * 1024); } while (0)
#define PG8_CAT(x0, x1) __builtin_shufflevector(__builtin_bit_cast(v4i_t, x0), __builtin_bit_cast(v4i_t, x1), 0, 1, 2, 3, 4, 5, 6, 7)
#define PG8_MMA(ai, bj, At, Bt) do { __builtin_amdgcn_s_setprio(1); _Pragma("unroll") for (int m = 0; m < 4; ++m) _Pragma("unroll") for (int n = 0; n < 2; ++n) { \
        if constexpr (FP8) acc[ai][bj][m][n] = __builtin_amdgcn_mfma_scale_f32_16x16x128_f8f6f4(PG8_CAT(Bt[n][0], Bt[n][1]), PG8_CAT(At[m][0], At[m][1]), acc[ai][bj][m][n], 0, 0, 0, 0, 0, 0); \
        else { _Pragma("unroll") for (int k = 0; k < 2; ++k) acc[ai][bj][m][n] = __builtin_amdgcn_mfma_f32_16x16x32_bf16(Bt[n][k], At[m][k], acc[ai][bj][m][n], 0, 0, 0); } } __builtin_amdgcn_s_setprio(0); } while (0)
#define PG8_WAIT_V(n) asm volatile("s_waitcnt vmcnt(" #n ")" ::: "memory")
#define PG8_WAIT_L(n) asm volatile("s_waitcnt lgkmcnt(" #n ")" ::: "memory")
#define PG8_BAR __builtin_amdgcn_s_barrier()
#define PG8_SCHED __builtin_amdgcn_sched_barrier(0)
#define PG8_OFFS(dst, u) do { _Pragma("unroll") for (int _h = 0; _h < 2; ++_h) _Pragma("unroll") for (int _i = 0; _i < 2; ++_i) dst[_h * 2 + _i] = S.row_off(u, _h * HALF + Rl[_i]) + (unsigned)Cl2[_i]; } while (0)
    Unit cur, nxt; int ui = 0;
    if (!S.next(0, cur)) return;
    f32x4 acc[2][2][4][2];
#pragma unroll
    for (int a = 0; a < 2; ++a)
#pragma unroll
        for (int b = 0; b < 2; ++b)
#pragma unroll
            for (int m = 0; m < 4; ++m)
#pragma unroll
                for (int n = 0; n < 2; ++n) acc[a][b][m][n] = (f32x4){0.f, 0.f, 0.f, 0.f};
    bf16x8 At[4][2], B0[2][2], B1[2][2];
    unsigned offC[4];
    PG8_OFFS(offC, cur);
    const char* cB0 = S.b_ptr(cur, 0); const char* cB1 = S.b_ptr(cur, 1);
    PG8_STAGEB(PG8_SB(0, 0), cB0); PG8_STAGEB(PG8_SB(0, 1), cB0 + hstepB); PG8_STAGEA(PG8_SA(0, 0), offC, 0, 0); PG8_STAGEA(PG8_SA(0, 1), offC, 1, 0);
    if (wr == 1) PG8_BAR;
    PG8_WAIT_V(2); PG8_BAR;
    PG8_STAGEB(PG8_SB(1, 0), cB1); PG8_STAGEA(PG8_SA(1, 0), offC, 0, kstep); PG8_STAGEB(PG8_SB(1, 1), cB1 + hstepB);
    PG8_WAIT_V(6); PG8_BAR;
    for (;;) {
        const bool has_next = S.next(ui + 1, nxt);
        if (!has_next) nxt = cur;
        for (int t = 0; t < nt; t += 2) {
            const bool last = (t == nt - 2);
            const size_t a1 = (size_t)(t + 1) * kstep;
            const size_t a2 = last ? (size_t)0 : (size_t)(t + 2) * kstep; const size_t a3 = a2 + kstep;
            const char* b2 = last ? S.b_ptr(nxt, 0) : S.b_ptr(cur, t + 2);
            const char* b3 = last ? S.b_ptr(nxt, 1) : S.b_ptr(cur, t + 3);
            PG8_LDB(B0, 0, 0); PG8_LDB(B1, 0, 1); PG8_SCHED; PG8_LDA(At, 0, 0); PG8_STAGEA(PG8_SA(1, 1), offC, 1, a1);
            if (last && has_next) { PG8_OFFS(offC, nxt); }
            PG8_WAIT_V(8); PG8_WAIT_L(0); PG8_BAR; PG8_MMA(0, 0, At, B0); PG8_MMA(0, 1, At, B1); PG8_BAR; PG8_SCHED;
            PG8_LDA(At, 0, 1); PG8_STAGEB(PG8_SB(0, 0), b2); PG8_STAGEB(PG8_SB(0, 1), b2 + hstepB); PG8_STAGEA(PG8_SA(0, 0), offC, 0, a2);
            PG8_WAIT_V(8); PG8_WAIT_L(0); PG8_BAR; PG8_MMA(1, 0, At, B0); PG8_MMA(1, 1, At, B1); PG8_BAR; PG8_SCHED;
            PG8_LDB(B0, 1, 0); PG8_LDB(B1, 1, 1); PG8_SCHED; PG8_LDA(At, 1, 0); PG8_STAGEA(PG8_SA(0, 1), offC, 1, a2);
            PG8_WAIT_V(8); PG8_WAIT_L(0); PG8_BAR; PG8_MMA(0, 0, At, B0); PG8_MMA(0, 1, At, B1); PG8_BAR; PG8_SCHED;
            PG8_LDA(At, 1, 1); PG8_STAGEB(PG8_SB(1, 0), b3); PG8_STAGEB(PG8_SB(1, 1), b3 + hstepB); PG8_STAGEA(PG8_SA(1, 0), offC, 0, a3);
            PG8_WAIT_V(8); PG8_WAIT_L(0); PG8_BAR; PG8_MMA(1, 0, At, B0); PG8_MMA(1, 1, At, B1); PG8_BAR; PG8_SCHED;
        }
        if (wr == 0) PG8_BAR;
        E(acc, cur, wr, wc, fr, fq, lds);
        if (!has_next) break;
#pragma unroll
        for (int a = 0; a < 2; ++a)
#pragma unroll
            for (int b = 0; b < 2; ++b)
#pragma unroll
                for (int m = 0; m < 4; ++m)
#pragma unroll
                    for (int n = 0; n < 2; ++n) acc[a][b][m][n] = (f32x4){0.f, 0.f, 0.f, 0.f};
        cur = nxt; ++ui;
        if (wr == 1) PG8_BAR;
    }
    PG8_WAIT_V(0);
    PG8_BAR;
#undef PG8_SA
#undef PG8_SB
#undef PG8_STAGEA
#undef PG8_STAGEB
#undef PG8_LDA
#undef PG8_LDB
#undef PG8_MMA
#undef PG8_CAT
#undef PG8_WAIT_V
#undef PG8_WAIT_L
#undef PG8_BAR
#undef PG8_SCHED
#undef PG8_OFFS
}
}

struct Args {
    const float* x; const float* norm_mix; const float* norm_ffn; const float* pool_w; const float* pool_scale; const float* kv_norm; const float* w_kv; const float* k_norm;
    const float* w_q; const float* q_norm; const float* w_o; const float* w_grp; const float* b_grp; const float* w_rt; const float* b_rt; const float* w_gate; const float* w_up; const float* w_down;
    float* out; unsigned char* ws; int ph_lo, ph_hi;
};
struct Frame {
    LAS unsigned char* lds; int tid, lane, wave, vcu, G;
};

template <bool OUT8> __device__ __forceinline__ void transpose_item(const float* W, int ldw, const float* gk, const float* gn, void* WTv, int ldk, int k0, int n0, int drow0, LAS float* scr, int lane, float scale = 1.f) {
    float v[32];
    const float* src = W + (size_t)(k0 + (lane >> 5)) * ldw + n0 + (lane & 31);
#pragma unroll
    for (int i = 0; i < 32; ++i) v[i] = src[(size_t)(2 * i) * ldw];
    const int c = lane & 7;
    f32x4 ga = (f32x4){1.f, 1.f, 1.f, 1.f}, gb = ga;
    if (gk) { ga = *(const f32x4*)(gk + k0 + 8 * c); gb = *(const f32x4*)(gk + k0 + 8 * c + 4); }
#pragma unroll
    for (int i = 0; i < 32; ++i) scr[(2 * i + (lane >> 5)) * 33 + (lane & 31)] = v[i];
    LDS_WAIT(); asm volatile("" ::: "memory");
#pragma unroll
    for (int j = 0; j < 4; ++j) { const int n = (lane >> 3) + 8 * j; const LAS float* s = scr + (8 * c) * 33 + n; const float g = (gn ? gn[n0 + n] : 1.f) * scale;
        if constexpr (OUT8) { u32x2 o; o.x = pk4_fp8(s[0 * 33] * ga[0] * g, s[1 * 33] * ga[1] * g, s[2 * 33] * ga[2] * g, s[3 * 33] * ga[3] * g); o.y = pk4_fp8(s[4 * 33] * gb[0] * g, s[5 * 33] * gb[1] * g, s[6 * 33] * gb[2] * g, s[7 * 33] * gb[3] * g);
            *(u32x2*)((unsigned char*)WTv + (size_t)(drow0 + n) * ldk + k0 + 8 * c) = o; }
        else { u32x4 o; o.x = pk2(s[0 * 33] * ga[0] * g, s[1 * 33] * ga[1] * g); o.y = pk2(s[2 * 33] * ga[2] * g, s[3 * 33] * ga[3] * g); o.z = pk2(s[4 * 33] * gb[0] * g, s[5 * 33] * gb[1] * g); o.w = pk2(s[6 * 33] * gb[2] * g, s[7 * 33] * gb[3] * g);
            *(u32x4*)((bf16_t*)WTv + (size_t)(drow0 + n) * ldk + k0 + 8 * c) = o; } }
    LDS_WAIT(); asm volatile("" ::: "memory");
}

__device__ __forceinline__ void p0_weights(const Args& a, Frame& F) {
    LAS float* scr = (LAS float*)(F.lds + F.wave * 16384);
    const int gw = F.vcu * NWAVES + F.wave, NGW = F.G * NWAVES;
    bf16_t* Wpool = (bf16_t*)(a.ws + WS_WPOOL); bf16_t* Wqkv = (bf16_t*)(a.ws + WS_WQKV); bf16_t* Wo = (bf16_t*)(a.ws + WS_WO);
    unsigned char* Wgu = a.ws + WS_WGU; unsigned char* Wd = a.ws + WS_WD;
    constexpr int I_POOL = 4 * 8 * 16, I_Q = 32 * 64, I_KV = 32 * 128, I_O = 32 * 64, I_G = 32 * 32 * 16  , I_D = 32 * 8 * 64;
    constexpr int NITEMS = I_POOL + I_Q + I_KV + I_O + 2 * I_G + I_D;
    for (int it = gw; it < NITEMS; it += NGW) {
        int r = it;
        if (r < I_POOL) { const int g = r / 128, rr = r % 128, kb = rr / 16, nb = rr % 16;
            transpose_item<false>(a.pool_w + (size_t)g * PGC * PGC, PGC, a.norm_mix + g * PGC, a.pool_scale + g * PGC, Wpool + (size_t)g * PGC * PGC, PGC, 64 * kb, 32 * nb, 32 * nb, scr, F.lane); continue; } r -= I_POOL;
        if (r < I_Q) { const int kb = r / 64, nb = r % 64; transpose_item<false>(a.w_q, DM, a.norm_mix + DM, nullptr, Wqkv, DM, 64 * kb, 32 * nb, 32 * nb, scr, F.lane); continue; } r -= I_Q;
        if (r < I_KV) { const int kb = r / 128, nb = r % 128; transpose_item<false>(a.w_kv, 2 * DM, a.kv_norm, nullptr, Wqkv + (size_t)DM * DM, DM, 64 * kb, 32 * nb, 32 * nb, scr, F.lane); continue; } r -= I_KV;
        if (r < I_O) { const int kb = r / 64, nb = r % 64; transpose_item<false>(a.w_o, DM, nullptr, nullptr, Wo, DM, 64 * kb, 32 * nb, 32 * nb, scr, F.lane); continue; } r -= I_O;
        if (r < 2 * I_G) { const int which = r / I_G; r %= I_G; const int le = r / 512, rr = r % 512, kb = rr / 16, nb = rr % 16;
            const int f0 = 32 * nb, drow0 = (f0 >> 7) * 256 + which * 128 + (f0 & 127);
            transpose_item<true>((which ? a.w_up : a.w_gate) + (size_t)le * DM * FF, FF, a.norm_ffn + (le >> 4) * DM, nullptr, Wgu + (size_t)le * 1024 * DM, DM, 64 * kb, f0, drow0, scr, F.lane, 64.f); continue; } r -= 2 * I_G;
        { const int le = r / 512, rr = r % 512, kb = rr / 64, nb = rr % 64;
            transpose_item<true>(a.w_down + (size_t)le * FF * DM, DM, nullptr, nullptr, Wd + (size_t)le * DM * FF, FF, 64 * kb, 32 * nb, 32 * nb, scr, F.lane, 32.f); }
    }
    bf16_t* Wr = (bf16_t*)(a.ws + WS_WR);
    for (int idx = (F.vcu * NTHR + F.tid); idx < 2 * 32 * DM; idx += F.G * NTHR) {
        const int l = idx / (32 * DM), rr = (idx / DM) % 32, k = idx % DM; float v = 0.f;
        if (rr < 16) v = a.w_rt[(((size_t)l * NGRP + (rr >> 2)) * DM + k) * EPG + (rr & 3)];
        else if (rr < 20) v = a.w_grp[((size_t)l * DM + k) * NGRP + (rr - 16)];
        v *= a.norm_ffn[l * DM + k];
        const unsigned hi = f2bf(v); const float rem = v - __builtin_bit_cast(float, hi << 16);
        Wr[idx] = (bf16_t)hi; Wr[2 * 32 * DM + idx] = (bf16_t)f2bf(rem);
    }
}

__device__ __forceinline__ void p0_pool(const Args& a, Frame& F, bf16_t* pooled) {
    constexpr int TC = 64;
    LAS float* rs = (LAS float*)(F.lds);
    const int c0 = F.tid * 4, gi = c0 / PGC, w = 2 << gi;
    for (int u = F.vcu; u < T / TC; u += F.G) {
        const int b = u / (SEQ / TC), t0 = (u % (SEQ / TC)) * TC;
        const float* xb = a.x + (size_t)b * SEQ * DM;
        __syncthreads();
        for (int r = F.wave - 16; r < TC; r += NWAVES) {
            const int t = t0 + r; float ss = 0.f;
            if (t >= 0) { const f32x4* xr = (const f32x4*)(xb + (size_t)t * DM) + F.lane;
                f32x4 v[8];
#pragma unroll
                for (int j = 0; j < 8; ++j) v[j] = xr[64 * j];
#pragma unroll
                for (int j = 0; j < 8; ++j) ss += (v[j].x * v[j].x + v[j].y * v[j].y) + (v[j].z * v[j].z + v[j].w * v[j].w);
                ss = wave_sum(ss); }
            if (F.lane == 0) rs[r + 16] = (t >= 0) ? 1.0f / sqrtf(ss * (1.0f / DM) + EPS) : 0.f;
        }
        __syncthreads();
        f32x4 S = (f32x4){0.f, 0.f, 0.f, 0.f};
        { f32x4 pv[15];
#pragma unroll
          for (int r = 1; r < 16; ++r) { int t = t0 - r; t = t < 0 ? 0 : t; pv[r - 1] = *(const f32x4*)(xb + (size_t)t * DM + c0); }
#pragma unroll
          for (int r = 1; r < 16; ++r) if (r < w) S += pv[r - 1] * rs[16 - r]; }
        for (int rb = 0; rb < TC; rb += 8) {
            f32x4 cv[8], ov[8];
#pragma unroll
            for (int i = 0; i < 8; ++i) { const int t = t0 + rb + i; cv[i] = *(const f32x4*)(xb + (size_t)t * DM + c0); int tw = t - w + 1; tw = tw < 0 ? 0 : tw; ov[i] = *(const f32x4*)(xb + (size_t)tw * DM + c0); }
#pragma unroll
            for (int i = 0; i < 8; ++i) { const int r = rb + i, t = t0 + r;
                const f32x4 cur = cv[i] * rs[r + 16];
                S += cur;
                const float inv = 1.0f / (float)((t + 1 < w) ? (t + 1) : w);
                const f32x4 p = S * inv - cur;
                u32x2 o; o.x = pk2(p.x, p.y); o.y = pk2(p.z, p.w);
                *(u32x2*)(pooled + ((size_t)b * SEQ + t) * DM + c0) = o;
                S -= ov[i] * rs[r - w + 1 + 16]; }
        }
    }
    __syncthreads();
}

struct SchedPlain {
    const char* A; const char* B; unsigned lda_bytes, ldb_bytes; int nM, nN, G, vcu; int pool;
    __device__ __forceinline__ bool next(int i, pg8::Unit& u) const { const int L = i * G + vcu; if (L >= nM * nN) return false; u.j = i; u.pm = L / nN; u.pn = L % nN; u.aux = 0; return true; }
    __device__ __forceinline__ unsigned row_off(const pg8::Unit& u, int r) const { return (unsigned)(u.pm * 256 + r) * lda_bytes + (pool ? (unsigned)(u.pn >> 1) * (PGC * 2) : 0u); }
    __device__ __forceinline__ const char* b_ptr(const pg8::Unit& u, int kt) const { return B + (size_t)u.pn * 256 * ldb_bytes + (size_t)kt * 128; }
};

struct EpiPool {
    const float* x; bf16_t* out; unsigned char* out8;
    __device__ __forceinline__ void operator()(const f32x4 (&acc)[2][2][4][2], const pg8::Unit& u, int wr, int wc, int fr, int fq, LAS unsigned char*) const {
        const int row0 = u.pm * 256 + wr * 64 + fr, col0 = u.pn * 256 + wc * 32 + 8 * fq;
#pragma unroll
        for (int ai = 0; ai < 2; ++ai)
#pragma unroll
            for (int m = 0; m < 4; ++m) { const size_t ro = (size_t)(row0 + ai * 128 + m * 16) * DM + col0;
#pragma unroll
                for (int bj = 0; bj < 2; ++bj) { const f32x4 x0 = *(const f32x4*)(x + ro + bj * 128), x1 = *(const f32x4*)(x + ro + bj * 128 + 4);
                    const f32x4 v0 = acc[ai][bj][m][0] + x0, v1 = acc[ai][bj][m][1] + x1;
                    u32x4 w; w.x = cvt_pk_bf16(v0[0], v0[1]); w.y = cvt_pk_bf16(v0[2], v0[3]); w.z = cvt_pk_bf16(v1[0], v1[1]); w.w = cvt_pk_bf16(v1[2], v1[3]);
                    *(u32x4*)(out + ro + bj * 128) = w;
                    u32x2 w8; w8.x = pk4_fp8(v0[0], v0[1], v0[2], v0[3]); w8.y = pk4_fp8(v1[0], v1[1], v1[2], v1[3]); *(u32x2*)(out8 + ro + bj * 128) = w8; } }
    }
};


__device__ __forceinline__ void bucket_experts(int b, int& ge_lo, int& ge_hi) { const int g = b / 6, p = b % 6; const int el = p < 3 ? 0 : (p < 5 ? 1 : 2), eh = p < 3 ? p + 1 : (p < 5 ? p - 1 : 3); ge_lo = g * 4 + el; ge_hi = g * 4 + eh; }
__device__ __forceinline__ void router_phase(const Args& a, Frame& F, const bf16_t* h, int layer) {
    const bf16_t* Wh = (const bf16_t*)(a.ws + WS_WR) + (size_t)layer * 32 * DM; const bf16_t* Wl = Wh + (size_t)2 * 32 * DM;
    unsigned* cnt = (unsigned*)(a.ws + WS_CTL) + CW_CNT + layer * NBKT * 64;
    int* list = (int*)(a.ws + WS_LIST); f32x4* meta = (f32x4*)(a.ws + WS_META);
    LAS float* lg = (LAS float*)(F.lds + F.wave * 2048);
    const int gw = F.vcu * NWAVES + F.wave, NGW = F.G * NWAVES, tk = F.lane & 15, q = F.lane >> 4;
    for (int tile = gw; tile < T / 16; tile += NGW) {
        const int tok0 = tile * 16;
        f32x4 c0 = {0.f, 0.f, 0.f, 0.f}, c1 = c0, css = c0;
        const bf16_t* hp = h + (size_t)(tok0 + tk) * DM + 8 * q; const bf16_t* w0 = Wh + (size_t)tk * DM + 8 * q; const bf16_t* w0l = Wl + (size_t)tk * DM + 8 * q;
#pragma unroll 4
        for (int s = 0; s < DM / 32; ++s) {
            const bf16x8 hf = *(const bf16x8*)(hp + 32 * s);
            const bf16x8 a0 = *(const bf16x8*)(w0 + 32 * s), a0l = *(const bf16x8*)(w0l + 32 * s), a1 = *(const bf16x8*)(w0 + 16 * DM + 32 * s), a1l = *(const bf16x8*)(w0l + 16 * DM + 32 * s);
            c0 = __builtin_amdgcn_mfma_f32_16x16x32_bf16(a0, hf, c0, 0, 0, 0); c0 = __builtin_amdgcn_mfma_f32_16x16x32_bf16(a0l, hf, c0, 0, 0, 0);
            c1 = __builtin_amdgcn_mfma_f32_16x16x32_bf16(a1, hf, c1, 0, 0, 0); c1 = __builtin_amdgcn_mfma_f32_16x16x32_bf16(a1l, hf, c1, 0, 0, 0);
            css = __builtin_amdgcn_mfma_f32_16x16x32_bf16(hf, hf, css, 0, 0, 0);
        }
#pragma unroll
        for (int r = 0; r < 4; ++r) lg[tk * 24 + 4 * q + r] = c0[r];
        if (q == 0) {
#pragma unroll
            for (int r = 0; r < 4; ++r) lg[tk * 24 + 16 + r] = c1[r]; }
        if (q == (tk >> 2)) { const int rr = tk & 3; lg[384 + tk] = rr == 0 ? css[0] : (rr == 1 ? css[1] : (rr == 2 ? css[2] : css[3])); }
        LDS_WAIT(); asm volatile("" ::: "memory");
        if (F.lane < 16) {
            const float rstd = 1.0f / sqrtf(lg[384 + tk] * (1.0f / DM) + EPS);
            float gl[4], el[4];
#pragma unroll
            for (int g = 0; g < 4; ++g) gl[g] = lg[tk * 24 + 16 + g] * rstd + a.b_grp[layer * NGRP + g];
            int gs = 0; float gm = gl[0];
#pragma unroll
            for (int g = 1; g < 4; ++g) if (gl[g] > gm) { gm = gl[g]; gs = g; }
            float den = 0.f;
#pragma unroll
            for (int g = 0; g < 4; ++g) den += __expf(gl[g] - gm);
            const float gwt = 1.0f / den;
#pragma unroll
            for (int e = 0; e < 4; ++e) el[e] = lg[tk * 24 + gs * 4 + e] * rstd + a.b_rt[(layer * NGRP + gs) * EPG + e];
            int i1 = 0; float v1 = el[0];
#pragma unroll
            for (int e = 1; e < 4; ++e) if (el[e] > v1) { v1 = el[e]; i1 = e; }
            int i2 = -1; float v2 = -3.0e38f;
#pragma unroll
            for (int e = 0; e < 4; ++e) if (e != i1 && el[e] > v2) { v2 = el[e]; i2 = e; }
            const float w1 = gwt / (1.0f + __expf(v2 - v1)), w2 = gwt - w1;
            const int elo = i1 < i2 ? i1 : i2, ehi = i1 < i2 ? i2 : i1; const float wlo = i1 < i2 ? w1 : w2, whi = i1 < i2 ? w2 : w1;
            const int pidx = elo == 0 ? ehi - 1 : (elo == 1 ? ehi + 1 : 5);
            const int b = gs * 6 + pidx;
            const unsigned pos = __hip_atomic_fetch_add(cnt + b * 64, 1u, __ATOMIC_RELAXED, __HIP_MEMORY_SCOPE_AGENT);
            list[(size_t)b * T + pos] = tok0 + tk;
            meta[(size_t)b * T + pos] = (f32x4){rstd, wlo, whi, 0.f};
        }
        LDS_WAIT(); asm volatile("" ::: "memory");
    }
}

constexpr int MAXU = 8;
struct MoeTab { LAS int* ud; LAS unsigned* rowtab; };
__device__ __forceinline__ void moe_build(const Args& a, Frame& F, int layer, bool gather) {
    LAS int* ud = (LAS int*)(F.lds + UDESC_OFF); LAS int* tb = ud + MAXU * 8;
    LAS unsigned* rowtab = (LAS unsigned*)(F.lds + ROWTAB_OFF);
    const unsigned* cnt = (const unsigned*)(a.ws + WS_CTL) + CW_CNT + layer * NBKT * 64;
    const int* list = (const int*)(a.ws + WS_LIST);
    __syncthreads();
    if (F.tid == 0) { int base = 0; for (int b = 0; b < NBKT; ++b) { const int c = (int)__hip_atomic_load(cnt + b * 64, __ATOMIC_RELAXED, __HIP_MEMORY_SCOPE_AGENT); tb[b] = base; tb[32 + b] = c; base += (c + 255) >> 8; } tb[NBKT] = base; }
    __syncthreads();
    if (F.tid < MAXU) { const int i = F.tid, L = i * F.G + F.vcu, R = tb[NBKT]; int v = 0, rt = 0, pn = 0, b = 0, ti = 0, nv = 0;
        if (L < 8 * R) { v = 1; rt = L >> 3; pn = L & 7; while (tb[b + 1] <= rt) ++b; ti = rt - tb[b]; nv = tb[32 + b] - 256 * ti; if (nv > 256) nv = 256; }
        ud[i * 8 + 0] = rt; ud[i * 8 + 1] = pn; ud[i * 8 + 2] = b; ud[i * 8 + 3] = ti; ud[i * 8 + 4] = nv; ud[i * 8 + 5] = v; }
    __syncthreads();
    if (gather) for (int e = F.tid; e < MAXU * 256; e += NTHR) { const int i = e >> 8, r = e & 255; unsigned off = 0;
        if (ud[i * 8 + 5]) { const int b = ud[i * 8 + 2], ti = ud[i * 8 + 3], nv = ud[i * 8 + 4]; const int rr = r < nv ? r : nv - 1; off = (unsigned)list[(size_t)b * T + 256 * ti + rr] * (unsigned)DM; }
        rowtab[e] = off; }
    VM_WAIT(); __syncthreads();
}
__device__ __forceinline__ int rfl(int v) { return __builtin_amdgcn_readfirstlane(v); }
struct SchedMoe {
    const char* A; const char* W; unsigned ldb_bytes; LAS int* ud; LAS unsigned* rowtab; int layer; int down;
    __device__ __forceinline__ bool next(int i, pg8::Unit& u) const { if (i >= MAXU) return false; if (!rfl(ud[i * 8 + 5])) return false; u.j = i; u.pm = rfl(ud[i * 8 + 0]); u.pn = rfl(ud[i * 8 + 1]); u.aux = rfl(ud[i * 8 + 2]); return true; }
    __device__ __forceinline__ unsigned row_off(const pg8::Unit& u, int r) const { return down ? (unsigned)(u.pm * 256 + r) * (unsigned)(2 * FF) : rowtab[u.j * 256 + r]; }
    __device__ __forceinline__ const char* b_ptr(const pg8::Unit& u, int kt) const {
        int gl, gh; bucket_experts(u.aux, gl, gh);
        if (!down) { const int ge = u.pn < 4 ? gl : gh; return W + ((size_t)(layer * NE + ge) * 1024 + (size_t)(u.pn & 3) * 256) * (size_t)DM + (size_t)kt * 128; }
        const int ge = kt < 4 ? gl : gh; return W + ((size_t)(layer * NE + ge) * DM + (size_t)u.pn * 256) * (size_t)FF + (size_t)(kt & 3) * 128;
    }
};
struct EpiSwiGLU {
    const f32x4* meta; unsigned char* H; LAS int* ud;
    __device__ __forceinline__ void operator()(const f32x4 (&acc)[2][2][4][2], const pg8::Unit& u, int wr, int wc, int fr, int fq, LAS unsigned char*) const {
        const int b = u.aux, ti = rfl(ud[u.j * 8 + 3]);
        const size_t mrow0 = (size_t)b * T + 256 * ti; const int hi = u.pn >> 2;
        const int hcol = hi * 512 + (u.pn & 3) * 128 + wc * 32 + 8 * fq;
#pragma unroll
        for (int ai = 0; ai < 2; ++ai)
#pragma unroll
            for (int m = 0; m < 4; ++m) { const int r = ai * 128 + wr * 64 + m * 16 + fr; const f32x4 mt = meta[mrow0 + r]; const float rstd = mt.x * (1.0f / 64.0f), w = (hi ? mt.z : mt.y) * 8.0f;
                float o[8];
#pragma unroll
                for (int n = 0; n < 2; ++n)
#pragma unroll
                    for (int j = 0; j < 4; ++j) { const float g = acc[ai][0][m][n][j] * rstd, up = acc[ai][1][m][n][j] * rstd; o[n * 4 + j] = g * __builtin_amdgcn_rcpf(1.0f + __expf(-g)) * up * w; }
                u32x2 pk; pk.x = pk4_fp8(o[0], o[1], o[2], o[3]); pk.y = pk4_fp8(o[4], o[5], o[6], o[7]);
                *(u32x2*)(H + (size_t)(u.pm * 256 + r) * (2 * FF) + hcol) = pk; }
    }
};
template <bool OUT_F32> struct EpiDown {
    const int* list; const bf16_t* hin; void* out; LAS int* ud;
    __device__ __forceinline__ void operator()(const f32x4 (&acc)[2][2][4][2], const pg8::Unit& u, int wr, int wc, int fr, int fq, LAS unsigned char*) const {
        const int b = u.aux, ti = rfl(ud[u.j * 8 + 3]), nv = rfl(ud[u.j * 8 + 4]);
        const int col0 = u.pn * 256 + wc * 32 + 8 * fq;
#pragma unroll
        for (int ai = 0; ai < 2; ++ai)
#pragma unroll
            for (int m = 0; m < 4; ++m) { const int r = ai * 128 + wr * 64 + m * 16 + fr;
                if (r < nv) { const int tok = list[(size_t)b * T + 256 * ti + r]; const size_t ro = (size_t)tok * DM + col0;
#pragma unroll
                    for (int bj = 0; bj < 2; ++bj) { const u32x4 hv = *(const u32x4*)(hin + ro + bj * 128);
                        const f32x4 v0 = acc[ai][bj][m][0] * (1.0f / 256.0f) + (f32x4){bflo(hv.x), bfhi(hv.x), bflo(hv.y), bfhi(hv.y)}, v1 = acc[ai][bj][m][1] * (1.0f / 256.0f) + (f32x4){bflo(hv.z), bfhi(hv.z), bflo(hv.w), bfhi(hv.w)};
                        if (OUT_F32) { float* o = (float*)out + ro + bj * 128; *(f32x4*)o = v0; *(f32x4*)(o + 4) = v1; }
                        else { u32x4 w; w.x = cvt_pk_bf16(v0[0], v0[1]); w.y = cvt_pk_bf16(v0[2], v0[3]); w.z = cvt_pk_bf16(v1[0], v1[1]); w.w = cvt_pk_bf16(v1[2], v1[3]); *(u32x4*)((bf16_t*)out + ro + bj * 128) = w; } } } }
    }
};


__device__ __forceinline__ void rstd_phase(Frame& F, const bf16_t* h, float* rstd) {
    const int gw = F.vcu * NWAVES + F.wave, NGW = F.G * NWAVES;
    for (int row = gw; row < T; row += NGW) {
        const u32x4* p = (const u32x4*)(h + (size_t)row * DM) + F.lane; float ss = 0.f;
#pragma unroll
        for (int j = 0; j < 4; ++j) { const u32x4 v = p[64 * j];
            const float a0 = bflo(v.x), a1 = bfhi(v.x), a2 = bflo(v.y), a3 = bfhi(v.y), a4 = bflo(v.z), a5 = bfhi(v.z), a6 = bflo(v.w), a7 = bfhi(v.w);
            ss += (a0 * a0 + a1 * a1) + (a2 * a2 + a3 * a3) + (a4 * a4 + a5 * a5) + (a6 * a6 + a7 * a7); }
        ss = wave_sum(ss);
        if (F.lane == 0) rstd[row] = 1.0f / sqrtf(ss * (1.0f / DM) + EPS);
    }
}

struct EpiRes {
    const bf16_t* hin; bf16_t* out; unsigned char* out8;
    __device__ __forceinline__ void operator()(const f32x4 (&acc)[2][2][4][2], const pg8::Unit& u, int wr, int wc, int fr, int fq, LAS unsigned char*) const {
        const int row0 = u.pm * 256 + wr * 64 + fr, col0 = u.pn * 256 + wc * 32 + 8 * fq;
#pragma unroll
        for (int ai = 0; ai < 2; ++ai)
#pragma unroll
            for (int m = 0; m < 4; ++m) { const size_t ro = (size_t)(row0 + ai * 128 + m * 16) * DM + col0;
#pragma unroll
                for (int bj = 0; bj < 2; ++bj) { const u32x4 hv = *(const u32x4*)(hin + ro + bj * 128);
                    const f32x4 v0 = acc[ai][bj][m][0] + (f32x4){bflo(hv.x), bfhi(hv.x), bflo(hv.y), bfhi(hv.y)}, v1 = acc[ai][bj][m][1] + (f32x4){bflo(hv.z), bfhi(hv.z), bflo(hv.w), bfhi(hv.w)};
                    u32x4 w; w.x = cvt_pk_bf16(v0[0], v0[1]); w.y = cvt_pk_bf16(v0[2], v0[3]); w.z = cvt_pk_bf16(v1[0], v1[1]); w.w = cvt_pk_bf16(v1[2], v1[3]);
                    *(u32x4*)(out + ro + bj * 128) = w;
                    u32x2 w8; w8.x = pk4_fp8(v0[0], v0[1], v0[2], v0[3]); w8.y = pk4_fp8(v1[0], v1[1], v1[2], v1[3]); *(u32x2*)(out8 + ro + bj * 128) = w8; } }
    }
};

constexpr float QSCALE = 0.08838834764831845f * 1.4426950408889634f;
struct EpiQKV {
    const float* rstd; const float* qn; const float* kn; bf16_t* q; bf16_t* k; bf16_t* v;
    __device__ __forceinline__ void operator()(const f32x4 (&acc)[2][2][4][2], const pg8::Unit& u, int wr, int wc, int fr, int fq, LAS unsigned char* lds) const {
        const int which = u.pn >> 3, colt = (u.pn & 7) * 256;
        bf16_t* dst = q + (size_t)which * ((WS_K - WS_Q) / 2);
        const int col0 = colt + wc * 32 + 8 * fq;
        LAS float* EX = (LAS float*)(lds + EX_OFF);
        const bool normed = which != 2;
        if (normed) {
#pragma unroll
            for (int ai = 0; ai < 2; ++ai)
#pragma unroll
                for (int m = 0; m < 4; ++m)
#pragma unroll
                    for (int bj = 0; bj < 2; ++bj) { const f32x4 v0 = acc[ai][bj][m][0], v1 = acc[ai][bj][m][1];
                        float s = (v0[0] * v0[0] + v0[1] * v0[1]) + (v0[2] * v0[2] + v0[3] * v0[3]) + (v1[0] * v1[0] + v1[1] * v1[1]) + (v1[2] * v1[2] + v1[3] * v1[3]);
                        s += __shfl_xor(s, 16); s += __shfl_xor(s, 32);
                        if (fq == 0) EX[((ai * 128 + wr * 64 + m * 16 + fr) * 2 + bj) * 4 + wc] = s; }
            asm volatile("s_waitcnt lgkmcnt(0)" ::: "memory"); __builtin_amdgcn_s_barrier(); asm volatile("" ::: "memory");
        }
        f32x4 g0 = (f32x4){1.f, 1.f, 1.f, 1.f}, g1 = g0;
        if (which == 0) { g0 = *(const f32x4*)(qn + wc * 32 + 8 * fq) * QSCALE; g1 = *(const f32x4*)(qn + wc * 32 + 8 * fq + 4) * QSCALE; }
        if (which == 1) { g0 = *(const f32x4*)(kn + wc * 32 + 8 * fq); g1 = *(const f32x4*)(kn + wc * 32 + 8 * fq + 4); }
#pragma unroll
        for (int ai = 0; ai < 2; ++ai)
#pragma unroll
            for (int m = 0; m < 4; ++m) { const int r = ai * 128 + wr * 64 + m * 16 + fr; const size_t ro = (size_t)(u.pm * 256 + r) * DM + col0;
                const float rs = rstd[u.pm * 256 + r];
#pragma unroll
                for (int bj = 0; bj < 2; ++bj) { float f = rs;
                    if (normed) { const f32x4 pp = *(const LAS f32x4*)(EX + (r * 2 + bj) * 4); const float tot = ((pp[0] + pp[1]) + (pp[2] + pp[3])) * rs * rs; f = rs / sqrtf(tot * (1.0f / HD) + EPS); }
                    const f32x4 v0 = acc[ai][bj][m][0] * f * g0, v1 = acc[ai][bj][m][1] * f * g1;
                    u32x4 w; w.x = cvt_pk_bf16(v0[0], v0[1]); w.y = cvt_pk_bf16(v0[2], v0[3]); w.z = cvt_pk_bf16(v1[0], v1[1]); w.w = cvt_pk_bf16(v1[2], v1[3]);
                    *(u32x4*)(dst + ro + bj * 128) = w; }
                asm volatile("" ::: "memory"); }
    }
};

typedef short v4i16_t __attribute__((ext_vector_type(4)));
__device__ __forceinline__ s16x4 vtr(const LAS char* p) { return __builtin_bit_cast(s16x4, __builtin_amdgcn_ds_read_tr16_b64_v4i16((LAS v4i16_t*)p)); }
__device__ __forceinline__ void attn_phase(Frame& F, const bf16_t* Q, const bf16_t* K, const bf16_t* V, bf16_t* O) {
    const int lane = F.lane, wid = F.wave, tid = F.tid, r32 = lane & 31, hi = lane >> 5;
    LAS char* lds = (LAS char*)F.lds;
    LAS unsigned* dflag = (LAS unsigned*)(F.lds + MISC_OFF + 64);
    unsigned ksrc[2], vsrc[2];
#pragma unroll
    for (int i = 0; i < 2; ++i) { const int p = i * 512 + tid, row = p >> 4, cp = p & 15; const int X = ((row & 3) << 2) | ((row >> 2) & 3);
        ksrc[i] = (unsigned)(row * (DM * 2) + ((cp ^ X) * 16)); vsrc[i] = (unsigned)(row * (DM * 2) + ((cp ^ ((row & 3) << 2)) * 16)); }
    const int Xr = ((r32 & 3) << 2) | ((r32 >> 2) & 3);
    const int kbase = 256 * r32 + 16 * (hi ^ Xr);
    const int g4 = lane >> 4, qq = (lane & 15) >> 2, pp = lane & 3;
    int vb[4];
#pragma unroll
    for (int db = 0; db < 4; ++db) vb[db] = 256 * (4 * (g4 >> 1) + qq) + 64 * (db ^ qq) + 32 * (g4 & 1) + 16 * (pp >> 1) + 8 * (pp & 1);
#define AT_STAGE(jt, buf) do { const char* _kt = kg + (size_t)(jt) * 64 * (DM * 2); const char* _vt = vg + (size_t)(jt) * 64 * (DM * 2); \
        _Pragma("unroll") for (int _i = 0; _i < 2; ++_i) __builtin_amdgcn_global_load_lds((const unsigned*)(_kt + ksrc[_i]), (LAS unsigned*)(lds + (buf) * 16384 + _i * 8192 + wid * 1024), 16, 0, 0); \
        _Pragma("unroll") for (int _i = 0; _i < 2; ++_i) __builtin_amdgcn_global_load_lds((const unsigned*)(_vt + vsrc[_i]), (LAS unsigned*)(lds + 32768 + (buf) * 16384 + _i * 8192 + wid * 1024), 16, 0, 0); } while (0)
    for (int it = 0;; ++it) {
        const int idx = it * F.G + F.vcu; if (idx >= BATCH * NH * (SEQ / 256)) break;
        const int bh = idx & 255, qb = idx >> 8, b = bh >> 4, h = bh & 15;
        const size_t rowbase = (size_t)b * SEQ;
        const int t0w = qb * 256 + wid * 32, t = t0w + r32;
        bf16x8 qf[8];
        { const bf16_t* qp = Q + (rowbase + t) * DM + h * HD + 8 * hi;
#pragma unroll
          for (int s = 0; s < 8; ++s) qf[s] = *(const bf16x8*)(qp + 16 * s); }
        f32x16 o[4];
#pragma unroll
        for (int db = 0; db < 4; ++db)
#pragma unroll
            for (int r = 0; r < 16; ++r) o[db][r] = 0.f;
        float C = 1.0f;
        const char* kg = (const char*)(K + rowbase * DM + h * HD); const char* vg = (const char*)(V + rowbase * DM + h * HD);
        const int jmax = 4 * qb + 3;
        __builtin_amdgcn_s_barrier();
        AT_STAGE(jmax, 0);
        for (int jt = jmax, n = 0; jt >= 0; --jt, ++n) {
            const int buf = n & 1;
            if (jt > 0) { AT_STAGE(jt - 1, buf ^ 1); asm volatile("s_waitcnt vmcnt(4)" ::: "memory"); }
            else asm volatile("s_waitcnt vmcnt(0)" ::: "memory");
            __builtin_amdgcn_s_barrier(); asm volatile("" ::: "memory");
            if (64 * jt <= t0w + 30) {
                const LAS char* kb = lds + buf * 16384; const LAS char* vbuf = lds + 32768 + buf * 16384;
                f32x16 p[2];
#pragma unroll
                for (int sub = 0; sub < 2; ++sub) {
#pragma unroll
                    for (int r = 0; r < 16; ++r) p[sub][r] = 0.f;
#pragma unroll
                    for (int s = 0; s < 8; ++s) { const bf16x8 kf = *(const LAS bf16x8*)(kb + sub * 8192 + (kbase ^ (32 * s))); p[sub] = __builtin_amdgcn_mfma_f32_32x32x16_bf16(kf, qf[s], p[sub], 0, 0, 0); } }
                const bool needmask = (64 * jt + 63 >= t0w);
                bf16x8 pf[4];
#pragma unroll
                for (int sub = 1; sub >= 0; --sub) {
                    float E[16], sfx[16], gt[4], pr[4], om[4];
#pragma unroll
                    for (int r = 0; r < 16; ++r) { float e = __builtin_amdgcn_exp2f(p[sub][r]);
                        if (needmask) { const int key = 64 * jt + 32 * sub + (r & 3) + 8 * (r >> 2) + 4 * hi; e = key < t ? e : 0.f; }
                        E[r] = e; }
#pragma unroll
                    for (int a = 0; a < 4; ++a) { const float s3 = 1.0f + E[4 * a + 3], s2 = (1.0f + E[4 * a + 2]) * s3, s1 = (1.0f + E[4 * a + 1]) * s2, s0 = (1.0f + E[4 * a]) * s1;
                        sfx[4 * a + 3] = s3; sfx[4 * a + 2] = s2; sfx[4 * a + 1] = s1; sfx[4 * a] = s0; gt[a] = s0; }
#pragma unroll
                    for (int a = 0; a < 4; ++a) { auto rr = __builtin_amdgcn_permlane32_swap(__float_as_uint(gt[a]), __float_as_uint(gt[a]), false, false);
                        const float x0 = __uint_as_float(rr[0]), x1 = __uint_as_float(rr[1]); pr[a] = x0 * x1; om[a] = hi ? 1.0f : x1; }
                    float R[4]; R[3] = C; R[2] = R[3] * pr[3]; R[1] = R[2] * pr[2]; R[0] = R[1] * pr[1]; C = R[0] * pr[0];
                    float A[16];
#pragma unroll
                    for (int a = 0; a < 4; ++a) { const float ap = R[a] * om[a];
#pragma unroll
                        for (int bb = 0; bb < 4; ++bb) A[4 * a + bb] = E[4 * a + bb] * __builtin_amdgcn_rcpf(sfx[4 * a + bb] * ap); }
#pragma unroll
                    for (int s2 = 0; s2 < 2; ++s2) { u32x4 w; w.x = cvt_pk_bf16(A[8 * s2 + 0], A[8 * s2 + 1]); w.y = cvt_pk_bf16(A[8 * s2 + 2], A[8 * s2 + 3]); w.z = cvt_pk_bf16(A[8 * s2 + 4], A[8 * s2 + 5]); w.w = cvt_pk_bf16(A[8 * s2 + 6], A[8 * s2 + 7]);
                        pf[sub * 2 + s2] = __builtin_bit_cast(bf16x8, w); }
                }
#pragma unroll
                for (int ks = 0; ks < 4; ++ks) { const int kb0 = 16 * ks;
#pragma unroll
                    for (int db = 0; db < 4; ++db) { const s16x4 v0 = vtr(vbuf + vb[db] + 256 * kb0), v1 = vtr(vbuf + vb[db] + 256 * (kb0 + 8));
                        const bf16x8 vf = __builtin_shufflevector(v0, v1, 0, 1, 2, 3, 4, 5, 6, 7);
                        o[db] = __builtin_amdgcn_mfma_f32_32x32x16_bf16(vf, pf[ks], o[db], 0, 0, 0); } }
            }
            { const unsigned wd = __all(C >= 4294967296.0f) ? 1u : 0u; if (lane == 0) dflag[wid] = wd; }
            asm volatile("s_waitcnt lgkmcnt(0)" ::: "memory"); __builtin_amdgcn_s_barrier(); asm volatile("" ::: "memory");
            if (jt > 0) { const u32x4 f0 = *(const LAS u32x4*)dflag, f1 = *(const LAS u32x4*)(dflag + 4);
                if ((f0.x & f0.y & f0.z & f0.w & f1.x & f1.y & f1.z & f1.w) != 0u) break; }
        }
        bf16_t* op = O + (rowbase + t) * DM + h * HD + 4 * hi;
#pragma unroll
        for (int db = 0; db < 4; ++db)
#pragma unroll
            for (int a = 0; a < 4; ++a) { u32x2 w; w.x = cvt_pk_bf16(o[db][4 * a], o[db][4 * a + 1]); w.y = cvt_pk_bf16(o[db][4 * a + 2], o[db][4 * a + 3]); *(u32x2*)(op + 32 * db + 8 * a) = w; }
    }
#undef AT_STAGE
    asm volatile("s_waitcnt vmcnt(0)" ::: "memory"); __builtin_amdgcn_s_barrier();
}

__device__ __forceinline__ void dump_bf16(Frame& F, const bf16_t* src, float* out) {
    const size_t n8 = (size_t)T * DM / 8;
    for (size_t i = (size_t)F.vcu * NTHR + F.tid; i < n8; i += (size_t)F.G * NTHR) {
        const u32x4 v = *(const u32x4*)(src + i * 8);
        f32x4 a = (f32x4){bflo(v.x), bfhi(v.x), bflo(v.y), bfhi(v.y)}, b = (f32x4){bflo(v.z), bfhi(v.z), bflo(v.w), bfhi(v.w)};
        *(f32x4*)(out + i * 8) = a; *(f32x4*)(out + i * 8 + 4) = b;
    }
}

constexpr int N_PHASES = 13;
__global__ void __launch_bounds__(NTHR, 2) fwd(Args args) {
    extern __shared__ __attribute__((aligned(16))) unsigned char lds_raw[];
    Frame F;
    F.lds = (LAS unsigned char*)lds_raw;
    F.tid = threadIdx.x; F.lane = F.tid & 63; F.wave = __builtin_amdgcn_readfirstlane(F.tid >> 6);
    F.G = gridDim.x; { const int bx = blockIdx.x; F.vcu = (F.G % 8 == 0) ? (bx % 8) * (F.G / 8) + bx / 8 : bx; }
    volatile LAS unsigned* MISC = (volatile LAS unsigned*)(F.lds + MISC_OFF);
    if (F.tid < 64) MISC[F.tid] = 0u;
    __syncthreads();
    unsigned* ctl = (unsigned*)(args.ws + WS_CTL);
    XcdBarrier bar; bar.bar = ctl + CW_BAR; bar.x = 0; bar.st = nullptr;
    if (N_LAUNCH_MODE == 1) bar = xcd_barrier_post(ctl + CW_BAR, MISC + 8);
    const int lo = args.ph_lo, hi = args.ph_hi;
#define IN(k) (lo <= (k) && (k) < hi)
#define SEAM(k) do { if (N_LAUNCH_MODE == 1 && IN(k) && IN((k) + 1)) xcd_barrier(bar); } while (0)
    bf16_t* pooled = (bf16_t*)(args.ws + WS_Q);
    bf16_t* h1 = (bf16_t*)(args.ws + WS_K);
    bf16_t* h2 = (bf16_t*)(args.ws + WS_HB);
    bf16_t* h3 = (bf16_t*)(args.ws + WS_HC);

    if (IN(0)) for (int rep = 0; rep < REP_P0; ++rep) { p0_weights(args, F); p0_pool(args, F, pooled); }
    SEAM(0);
    if (IN(1)) {
        SchedPlain S{(const char*)pooled, (const char*)(args.ws + WS_WPOOL), DM * 2, PGC * 2, T / 256, 8, F.G, F.vcu, 1};
        EpiPool E{args.x, h1, args.ws + WS_X8};
        pg8::gemm_phase<EpiPool, SchedPlain>(F.lds, PGC, S, E);
    }
    SEAM(1);
    if (IN(2)) router_phase(args, F, h1, 0);
    SEAM(2);
    if (IN(3)) {
        moe_build(args, F, 0, true);
        SchedMoe S{(const char*)(args.ws + WS_X8), (const char*)(args.ws + WS_WGU), DM, (LAS int*)(F.lds + UDESC_OFF), (LAS unsigned*)(F.lds + ROWTAB_OFF), 0, 0};
        EpiSwiGLU E{(const f32x4*)(args.ws + WS_META), args.ws + WS_HMOE, (LAS int*)(F.lds + UDESC_OFF)};
        pg8::gemm_phase<EpiSwiGLU, SchedMoe, true>(F.lds, DM, S, E);
    }
    SEAM(3);
    if (IN(4)) {
        moe_build(args, F, 0, false);
        SchedMoe S{(const char*)(args.ws + WS_HMOE), (const char*)(args.ws + WS_WD), FF, (LAS int*)(F.lds + UDESC_OFF), (LAS unsigned*)(F.lds + ROWTAB_OFF), 0, 1};
        EpiDown<false> E{(const int*)(args.ws + WS_LIST), h1, (void*)h2, (LAS int*)(F.lds + UDESC_OFF)};
        pg8::gemm_phase<EpiDown<false>, SchedMoe, true>(F.lds, 2 * FF, S, E);
    }
    SEAM(4);
#if STOP_AFTER == 1
    if (IN(12)) dump_bf16(F, h1, args.out);
#endif
#if STOP_AFTER == 2
    if (IN(12)) dump_bf16(F, h2, args.out);
#endif
#if STOP_AFTER >= 3
    bf16_t* qb_ = (bf16_t*)(args.ws + WS_Q); bf16_t* kb_ = (bf16_t*)(args.ws + WS_K); bf16_t* vb_ = (bf16_t*)(args.ws + WS_V);
    bf16_t* ob_ = (bf16_t*)args.out;
    float* rstd2 = (float*)(args.ws + WS_RSTD);
    if (IN(5)) rstd_phase(F, h2, rstd2);
    SEAM(5);
#ifndef SKIP_QKV
    if (IN(6)) {
        SchedPlain S{(const char*)h2, (const char*)(args.ws + WS_WQKV), DM * 2, DM * 2, T / 256, 24, F.G, F.vcu, 0};
        EpiQKV E{rstd2, args.q_norm, args.k_norm, qb_, kb_, vb_};
        pg8::gemm_phase<EpiQKV, SchedPlain>(F.lds, DM, S, E);
    }
#endif
    SEAM(6);
#ifndef SKIP_ATTN
    if (IN(7)) for (int rep = 0; rep < REP_ATTN; ++rep) attn_phase(F, qb_, kb_, vb_, ob_);
#endif
    SEAM(7);
    if (IN(8)) {
        SchedPlain S{(const char*)ob_, (const char*)(args.ws + WS_WO), DM * 2, DM * 2, T / 256, 8, F.G, F.vcu, 0};
        EpiRes E{h2, h3, args.ws + WS_X8};
        pg8::gemm_phase<EpiRes, SchedPlain>(F.lds, DM, S, E);
    }
    SEAM(8);
#endif
#if STOP_AFTER == 3
    if (IN(12)) dump_bf16(F, h3, args.out);
#endif
#if STOP_AFTER >= 4
    if (IN(9)) router_phase(args, F, h3, 1);
    SEAM(9);
    if (IN(10)) {
        moe_build(args, F, 1, true);
        SchedMoe S{(const char*)(args.ws + WS_X8), (const char*)(args.ws + WS_WGU), DM, (LAS int*)(F.lds + UDESC_OFF), (LAS unsigned*)(F.lds + ROWTAB_OFF), 1, 0};
        EpiSwiGLU E{(const f32x4*)(args.ws + WS_META), args.ws + WS_HMOE, (LAS int*)(F.lds + UDESC_OFF)};
        pg8::gemm_phase<EpiSwiGLU, SchedMoe, true>(F.lds, DM, S, E);
    }
    SEAM(10);
    if (IN(11)) {
        moe_build(args, F, 1, false);
        SchedMoe S{(const char*)(args.ws + WS_HMOE), (const char*)(args.ws + WS_WD), FF, (LAS int*)(F.lds + UDESC_OFF), (LAS unsigned*)(F.lds + ROWTAB_OFF), 1, 1};
        EpiDown<true> E{(const int*)(args.ws + WS_LIST), h3, (void*)args.out, (LAS int*)(F.lds + UDESC_OFF)};
        pg8::gemm_phase<EpiDown<true>, SchedMoe, true>(F.lds, 2 * FF, S, E);
    }
#endif
#undef IN
#undef SEAM
}

extern "C" void kernel_launch(void* const* d_in, const int* in_sizes, int n_in, void* d_out, int out_size, void* d_ws, size_t ws_size, hipStream_t stream) {
    static int grid = 0;
    if (grid == 0) {
        if (n_in != 18 || out_size != T * DM || ws_size < WS_END) { fprintf(stderr, "kernel_launch: unexpected sizes (n_in %d out %d ws %zu)\n", n_in, out_size, ws_size); grid = -1; return; }
        int dev = 0, cus = 0, per_cu = 0;
        if (hipGetDevice(&dev) != hipSuccess || hipDeviceGetAttribute(&cus, hipDeviceAttributeMultiprocessorCount, dev) != hipSuccess) { grid = -1; return; }
        if (hipFuncSetAttribute((const void*)fwd, hipFuncAttributeMaxDynamicSharedMemorySize, LDS_BYTES) != hipSuccess) { fprintf(stderr, "kernel_launch: hipFuncSetAttribute failed\n"); grid = -1; return; }
        if (hipOccupancyMaxActiveBlocksPerMultiprocessor(&per_cu, (const void*)fwd, NTHR, LDS_BYTES) != hipSuccess || per_cu < 1) fprintf(stderr, "kernel_launch: occupancy query says %d\n", per_cu);
        (void)hipGetLastError();
        grid = cus;
    }
    if (grid < 0) return;
    hipMemsetAsync((char*)d_ws + WS_CTL, 0, CTL_BYTES, stream);
    Args a{};
    a.x = (const float*)d_in[0]; a.norm_mix = (const float*)d_in[1]; a.norm_ffn = (const float*)d_in[2]; a.pool_w = (const float*)d_in[3]; a.pool_scale = (const float*)d_in[4];
    a.kv_norm = (const float*)d_in[5]; a.w_kv = (const float*)d_in[6]; a.k_norm = (const float*)d_in[7]; a.w_q = (const float*)d_in[8]; a.q_norm = (const float*)d_in[9]; a.w_o = (const float*)d_in[10];
    a.w_grp = (const float*)d_in[11]; a.b_grp = (const float*)d_in[12]; a.w_rt = (const float*)d_in[13]; a.b_rt = (const float*)d_in[14]; a.w_gate = (const float*)d_in[15]; a.w_up = (const float*)d_in[16]; a.w_down = (const float*)d_in[17];
    a.out = (float*)d_out; a.ws = (unsigned char*)d_ws;
    if (N_LAUNCH_MODE == 1) { a.ph_lo = 0; a.ph_hi = N_PHASES; hipLaunchKernelGGL(fwd, dim3(grid), dim3(NTHR), LDS_BYTES, stream, a); }
    else for (int p = 0; p < N_PHASES; ++p) { a.ph_lo = p; a.ph_hi = p + 1; hipLaunchKernelGGL(fwd, dim3(grid), dim3(NTHR), LDS_BYTES, stream, a); }
}
```

```cpp
#include <hip/hip_runtime.h>
#include <cstdio>
#include <cstdint>

#ifndef STOP_AFTER
#define STOP_AFTER 4
#endif
#ifndef REP_ATTN
#define REP_ATTN 1
#endif
#ifndef REP_QKV
#define REP_QKV 1
#endif
#ifndef REP_WO
#define REP_WO 1
#endif
#ifndef REP_POOLG
#define REP_POOLG 1
#endif
#ifndef KREP_QKV
#define KREP_QKV 1
#endif
#ifndef SKEW_TICKS
#define SKEW_TICKS 0
#endif
#ifndef REP_P0
#define REP_P0 1
#endif
#ifndef N_LAUNCH_MODE
#define N_LAUNCH_MODE 1
#endif

#define LAS __attribute__((address_space(3)))
#define GAS __attribute__((address_space(1)))
typedef unsigned short bf16_t;
typedef short bf16x8 __attribute__((ext_vector_type(8)));
typedef short s16x4 __attribute__((ext_vector_type(4)));
typedef float f32x2 __attribute__((ext_vector_type(2)));
typedef float f32x4 __attribute__((ext_vector_type(4)));
typedef float f32x16 __attribute__((ext_vector_type(16)));
typedef unsigned u32x2 __attribute__((ext_vector_type(2)));
typedef unsigned u32x4 __attribute__((ext_vector_type(4)));

constexpr int BATCH = 16, SEQ = 2048, DM = 2048, T = BATCH * SEQ, NH = 16, HD = 128;
constexpr int NGRP = 4, EPG = 4, NE = 16, FF = 512, NBKT = 24;
constexpr int PGC = 512;
constexpr float EPS = 1e-6f;
constexpr int MAXRT = 152;
constexpr int NWAVES = 8, NTHR = 512;

constexpr size_t MiB = 1u << 20;
constexpr size_t WS_CTL = 0, CTL_BYTES = 96 * 1024;
constexpr size_t WS_WPOOL = 1 * MiB;
constexpr size_t WS_WQKV = 3 * MiB;
constexpr size_t WS_WO = 27 * MiB;
constexpr size_t WS_WGU = 35 * MiB;
constexpr size_t WS_X8 = 99 * MiB;
constexpr size_t WS_WD = 163 * MiB;
constexpr size_t WS_WR = 227 * MiB;
constexpr size_t WS_RSTD = 228 * MiB;
constexpr size_t WS_RSCALE = WS_RSTD + 131072;
constexpr size_t WS_CSQKV = WS_RSTD + 262144;
constexpr size_t WS_CSWO = WS_RSTD + 294912;
constexpr size_t WS_LIST = 229 * MiB;
constexpr size_t WS_META = 232 * MiB;
constexpr size_t WS_HMOE = 244 * MiB;
constexpr size_t WS_HB = 320 * MiB;
constexpr size_t WS_HC = 448 * MiB;
constexpr size_t WS_Q = 576 * MiB;
constexpr size_t WS_K = 704 * MiB;
constexpr size_t WS_V = 832 * MiB;
constexpr size_t WS_A8 = 960 * MiB;
constexpr size_t WS_END = 1024 * MiB;
constexpr int CW_BAR = 4096;
constexpr int CW_VMAX = 8192;
constexpr int CW_CNT = 16384;

constexpr int RING_BYTES = 131072;
constexpr int EX_OFF = RING_BYTES;
constexpr int ROWTAB_OFF = EX_OFF + 8192;
constexpr int UDESC_OFF = ROWTAB_OFF + 8192;
constexpr int MISC_OFF = UDESC_OFF + 1024;
constexpr int LDS_BYTES = 151552;
static_assert(MISC_OFF + 256 <= LDS_BYTES, "lds map");
static_assert(WS_V - WS_K == WS_K - WS_Q, "q|k|v spacing");

__device__ __forceinline__ unsigned f2bf(float f) { unsigned u = __builtin_bit_cast(unsigned, f); return (u + 0x7fffu + ((u >> 16) & 1u)) >> 16; }
__device__ __forceinline__ unsigned pk2(float lo, float hi) { return f2bf(lo) | (f2bf(hi) << 16); }
__device__ __forceinline__ float bf2f(unsigned short b) { return __builtin_bit_cast(float, ((unsigned)b) << 16); }
__device__ __forceinline__ float bflo(unsigned w) { return __builtin_bit_cast(float, w << 16); }
__device__ __forceinline__ float bfhi(unsigned w) { return __builtin_bit_cast(float, w & 0xffff0000u); }
__device__ __forceinline__ unsigned cvt_pk_bf16(float lo, float hi) { unsigned r; asm volatile("v_cvt_pk_bf16_f32 %0, %1, %2" : "=v"(r) : "v"(lo), "v"(hi)); return r; }
__device__ __forceinline__ float add_xor16(float v) { auto r = __builtin_amdgcn_permlane16_swap(__float_as_uint(v), __float_as_uint(v), false, false); return __uint_as_float(r[0]) + __uint_as_float(r[1]); }
__device__ __forceinline__ float add_xor32(float v) { auto r = __builtin_amdgcn_permlane32_swap(__float_as_uint(v), __float_as_uint(v), false, false); return __uint_as_float(r[0]) + __uint_as_float(r[1]); }
template <int CTRL> __device__ __forceinline__ float dpp_f(float v) { return __uint_as_float((unsigned)__builtin_amdgcn_update_dpp(0, (int)__float_as_uint(v), CTRL, 0xf, 0xf, true)); }
__device__ __forceinline__ float max_xor16(float v) { auto r = __builtin_amdgcn_permlane16_swap(__float_as_uint(v), __float_as_uint(v), false, false); return fmaxf(__uint_as_float(r[0]), __uint_as_float(r[1])); }
__device__ __forceinline__ float max_xor32(float v) { auto r = __builtin_amdgcn_permlane32_swap(__float_as_uint(v), __float_as_uint(v), false, false); return fmaxf(__uint_as_float(r[0]), __uint_as_float(r[1])); }
__device__ __forceinline__ float wave_sum(float v) {
    v += dpp_f<0xB1>(v); v += dpp_f<0x4E>(v); v += dpp_f<0x141>(v); v += dpp_f<0x140>(v);
    return add_xor32(add_xor16(v));
}
__device__ __forceinline__ unsigned pk4_fp8(float a, float b, float c, float d) {
    a = __builtin_amdgcn_fmed3f(a, -448.f, 448.f); b = __builtin_amdgcn_fmed3f(b, -448.f, 448.f); c = __builtin_amdgcn_fmed3f(c, -448.f, 448.f); d = __builtin_amdgcn_fmed3f(d, -448.f, 448.f);
    int r = __builtin_amdgcn_cvt_pk_fp8_f32(a, b, 0, false); r = __builtin_amdgcn_cvt_pk_fp8_f32(c, d, r, true); return (unsigned)r; }
__device__ __forceinline__ unsigned pk4_i8(float a, float b, float c, float d) {
    const float M = 12582912.0f;
    const unsigned ta = __float_as_uint(__builtin_amdgcn_fmed3f(a, -127.f, 127.f) + M), tb = __float_as_uint(__builtin_amdgcn_fmed3f(b, -127.f, 127.f) + M);
    const unsigned tc = __float_as_uint(__builtin_amdgcn_fmed3f(c, -127.f, 127.f) + M), td = __float_as_uint(__builtin_amdgcn_fmed3f(d, -127.f, 127.f) + M);
    const unsigned p01 = __builtin_amdgcn_perm(tb, ta, 0x0c0c0400u), p23 = __builtin_amdgcn_perm(td, tc, 0x0c0c0400u);
    return __builtin_amdgcn_perm(p23, p01, 0x05040100u); }
__device__ __forceinline__ u32x4 widen8(u32x2 a, u32x2 b) {
    auto rx = __builtin_amdgcn_permlane16_swap(a.x, b.x, false, false); auto ry = __builtin_amdgcn_permlane16_swap(a.y, b.y, false, false);
    return (u32x4){rx[0], ry[0], rx[1], ry[1]}; }
#define LDS_WAIT() asm volatile("s_waitcnt lgkmcnt(0)" ::: "memory")
#define VM_WAIT() asm volatile("s_waitcnt vmcnt(0)" ::: "memory")

#define XB_TMO      128
#define XB_XCNT(j)  (256  + 64 * (j))
#define XB_XSUB(j)  (1280 + 64 * (j))
#define XB_XGEN(j)  (2304 + 64 * (j))
#define XB_TOP      3328
#define XB_TOPGEN   3392
#define XCD_BAR_WORDS 3456
#define XB_SPIN_CAP (1u << 18)
__device__ __forceinline__ unsigned xb_ld(unsigned* p)              { return __hip_atomic_load(p, __ATOMIC_RELAXED, __HIP_MEMORY_SCOPE_AGENT); }
__device__ __forceinline__ unsigned xb_add(unsigned* p, unsigned v) { return __hip_atomic_fetch_add(p, v, __ATOMIC_RELAXED, __HIP_MEMORY_SCOPE_AGENT); }
__device__ __forceinline__ unsigned xb_xcc_id() { return (unsigned)__builtin_amdgcn_s_getreg((3 << 11) | 20) & 0xFu; }
#define XB_SPIN(cond, bar) do { unsigned _sp = 0; while (cond) { __builtin_amdgcn_s_sleep(1); \
    if ((++_sp & 255u) == 0u) { if (xb_ld(&(bar)[XB_TMO])) break; if (_sp > XB_SPIN_CAP) { atomicAdd(&(bar)[XB_TMO], 1u); break; } } } } while (0)
struct XcdBarrier { unsigned* bar; unsigned x; volatile LAS unsigned* st; };
__device__ __forceinline__ XcdBarrier xcd_barrier_post(unsigned* bar, volatile LAS unsigned* st) {
    XcdBarrier b; b.bar = bar; b.x = xb_xcc_id(); b.st = st;
    if (threadIdx.x == 0) (void)xb_add(&bar[XB_XCNT(b.x)], 1u);
    return b;
}
__device__ __forceinline__ void xcd_barrier_complete(unsigned* bar, unsigned x, unsigned& nloc, unsigned& nx) {
    const unsigned G = gridDim.x * gridDim.y * gridDim.z;
    unsigned sum, cnt, mine, sp = 0u;
    for (;;) {
        sum = 0u; cnt = 0u; mine = 0u;
#pragma unroll
        for (unsigned j = 0; j < 16; ++j) { const unsigned c = xb_ld(&bar[XB_XCNT(j)]); sum += c; cnt += (c > 0u) ? 1u : 0u; mine = (j == x) ? c : mine; }
        if (sum == G) break;
        __builtin_amdgcn_s_sleep(1);
        if ((++sp & 255u) == 0u) { if (xb_ld(&bar[XB_TMO])) break; if (sp > XB_SPIN_CAP) { atomicAdd(&bar[XB_TMO], 1u); break; } }
    }
    nloc = mine > 0u ? mine : 1u; nx = cnt > 0u ? cnt : 1u;
}
__device__ __forceinline__ void xcd_barrier(const XcdBarrier& b) {
    asm volatile("s_waitcnt vmcnt(0)" ::: "memory");
    __syncthreads();
    if (threadIdx.x == 0) {
        unsigned* bar = b.bar;
        __builtin_amdgcn_s_waitcnt(0);
        unsigned nloc = b.st[0], nx = b.st[1];
        if (nloc == 0u) { xcd_barrier_complete(bar, b.x, nloc, nx); b.st[0] = nloc; b.st[1] = nx; }
        const unsigned old = xb_add(&bar[XB_XSUB(b.x)], 1u);
        const unsigned gen = old / nloc;
        if (old + 1u == (gen + 1u) * nloc) {
            __builtin_amdgcn_fence(__ATOMIC_RELEASE, "agent");
            asm volatile("s_waitcnt vmcnt(0)" ::: "memory");
            const unsigned og = xb_add(&bar[XB_TOP], 1u);
            const unsigned tg = og / nx;
            if (og + 1u == (tg + 1u) * nx) xb_add(&bar[XB_TOPGEN], 1u);
            else XB_SPIN(xb_ld(&bar[XB_TOPGEN]) == tg, bar);
            __builtin_amdgcn_fence(__ATOMIC_ACQUIRE, "agent");
            xb_add(&bar[XB_XGEN(b.x)], 1u);
            asm volatile("s_waitcnt vmcnt(0)" ::: "memory");
        } else {
            XB_SPIN(xb_ld(&bar[XB_XGEN(b.x)]) == gen, bar);
            __builtin_amdgcn_fence(__ATOMIC_ACQUIRE, "agent");
            asm volatile("s_waitcnt vmcnt(0)" ::: "memory");
        }
    }
    __syncthreads();
}

namespace pg8 {
constexpr int BM = 256, BK = 64, HALF = 128, HTB = HALF * BK * 2, STAGE_BYTES = 8 * HTB;
__host__ __device__ __forceinline__ int lds_byte(int r, int c) { const int st = (r >> 4) * 2 + (c >> 5), rr = r & 15, cc = c & 31, ob = rr * 64 + cc * 2; return st * 1024 + (ob ^ (((ob >> 9) & 1) << 5)); }
__host__ __device__ __forceinline__ void stage_rc(int b, int& R, int& C) { const int st = b / 1024, sb = b % 1024, swz = sb ^ (((sb >> 9) & 1) << 5); R = (st >> 1) * 16 + swz / 64; C = (st & 1) * 32 + (swz % 64) / 2; }
__host__ __device__ __forceinline__ int perm32(int rho) { const int n = rho >> 4, i = rho & 15; return 8 * (i >> 2) + 4 * n + (i & 3); }

struct Unit { int j, pm, pn, aux, h; };

typedef int v4i_t __attribute__((ext_vector_type(4)));
typedef int v8i_t __attribute__((ext_vector_type(8)));
template <class Epi, class Sched, int MODE = 0, int KREP = 1, bool HALFU = false>
__device__ __forceinline__ void gemm_phase(LAS unsigned char* lds, const int K, const Sched& S, const Epi& E) {
    const int tid = threadIdx.x, wid = __builtin_amdgcn_readfirstlane(tid >> 6), lane = tid & 63, wr = wid >> 2, wc = wid & 3, fr = lane & 15, fq = lane >> 4;
    constexpr bool FP8 = MODE == 1, I8 = MODE == 2;
    const int nt1 = (MODE != 0) ? K / 128 : K / BK, nt = nt1 * KREP;
    int Rl[2], Cl2[2]; unsigned voffB[2];
#pragma unroll
    for (int i = 0; i < 2; ++i) { int R, C; stage_rc(tid * 16 + i * 8192, R, C); Rl[i] = R; Cl2[i] = C * 2; const int Rb = (R & ~31) + perm32(R & 31); voffB[i] = (unsigned)Rb * S.ldb_bytes + (unsigned)C * 2u; }
    const size_t kstep = (size_t)(BK * 2);
    const size_t hstepB = (size_t)HALF * S.ldb_bytes;
    const unsigned ldsw = (unsigned)wid * 1024u;
    const int aoff = lds_byte(wr * 64 + fr, fq * 8), boff = lds_byte(wc * 32 + fr, fq * 8);
#define PG8_SA(b, h) (((b) * 2 + (h)) * HTB)
#define PG8_SB(b, h) ((4 + (b) * 2 + (h)) * HTB)
#define PG8_STAGEB(bufoff, gbase) do { _Pragma("unroll") for (int _i = 0; _i < 2; ++_i) \
        __builtin_amdgcn_global_load_lds((const unsigned*)((const char*)(gbase) + voffB[_i]), (LAS unsigned*)(lds + (bufoff) + ldsw + _i * 8192), 16, 0, 0); } while (0)
#define PG8_STAGEA(bufoff, offs, h, kb) do { _Pragma("unroll") for (int _i = 0; _i < 2; ++_i) \
        __builtin_amdgcn_global_load_lds((const unsigned*)(S.A + (kb) + (offs)[(h) * 2 + _i]), (LAS unsigned*)(lds + (bufoff) + ldsw + _i * 8192), 16, 0, 0); } while (0)
#define PG8_LDA(dst, b, h) do { _Pragma("unroll") for (int m = 0; m < 4; ++m) _Pragma("unroll") for (int k = 0; k < 2; ++k) dst[m][k] = *(const LAS bf16x8*)(lds + PG8_SA(b, h) + aoff + m * 2048 + k * 1024); } while (0)
#define PG8_LDB(dst, b, h) do { _Pragma("unroll") for (int n = 0; n < 2; ++n) _Pragma("unroll") for (int k = 0; k < 2; ++k) dst[n][k] = *(const LAS bf16x8*)(lds + PG8_SB(b, h) + boff + n * 2048 + k * 1024); } while (0)
#define PG8_CAT(x0, x1) __builtin_shufflevector(__builtin_bit_cast(v4i_t, x0), __builtin_bit_cast(v4i_t, x1), 0, 1, 2, 3, 4, 5, 6, 7)
#define PG8_MMA(ai, bj, At, Bt) do { __builtin_amdgcn_s_setprio(1); _Pragma("unroll") for (int m = 0; m < 4; ++m) _Pragma("unroll") for (int n = 0; n < 2; ++n) { \
        if constexpr (FP8) acc[ai][bj][m][n] = __builtin_amdgcn_mfma_scale_f32_16x16x128_f8f6f4(PG8_CAT(Bt[n][0], Bt[n][1]), PG8_CAT(At[m][0], At[m][1]), acc[ai][bj][m][n], 0, 0, 0, 0, 0, 0); \
        else if constexpr (I8) { _Pragma("unroll") for (int k = 0; k < 2; ++k) acc[ai][bj][m][n] = __builtin_bit_cast(f32x4, __builtin_amdgcn_mfma_i32_16x16x64_i8(__builtin_bit_cast(v4i_t, Bt[n][k]), __builtin_bit_cast(v4i_t, At[m][k]), __builtin_bit_cast(v4i_t, acc[ai][bj][m][n]), 0, 0, 0)); } \
        else { _Pragma("unroll") for (int k = 0; k < 2; ++k) acc[ai][bj][m][n] = __builtin_amdgcn_mfma_f32_16x16x32_bf16(Bt[n][k], At[m][k], acc[ai][bj][m][n], 0, 0, 0); } } __builtin_amdgcn_s_setprio(0); } while (0)
#define PG8_WAIT_V(n) asm volatile("s_waitcnt vmcnt(" #n ")" ::: "memory")
#define PG8_WAIT_K do { if constexpr (HALFU) PG8_WAIT_V(6); else PG8_WAIT_V(8); } while (0)
#define PG8_WAIT_L(n) asm volatile("s_waitcnt lgkmcnt(" #n ")" ::: "memory")
#define PG8_BAR __builtin_amdgcn_s_barrier()
#define PG8_SCHED __builtin_amdgcn_sched_barrier(0)
#define PG8_OFFS(dst, u) do { _Pragma("unroll") for (int _h = 0; _h < 2; ++_h) _Pragma("unroll") for (int _i = 0; _i < 2; ++_i) dst[_h * 2 + _i] = S.row_off(u, _h * HALF + Rl[_i]) + (unsigned)Cl2[_i]; } while (0)
#define PG8_KLOOP(HALFC) \
        for (int t = 0; t < nt; t += 2) { \
            const bool last = (t == nt - 2); \
            const int t1 = KREP > 1 ? (t + 1) % nt1 : t + 1, t2 = KREP > 1 ? (t + 2) % nt1 : t + 2, t3 = KREP > 1 ? (t + 3) % nt1 : t + 3; \
            const size_t a1 = (size_t)t1 * kstep; \
            const size_t a2 = last ? (size_t)0 : (size_t)t2 * kstep; const size_t a3 = a2 + kstep; \
            const char* b2 = last ? S.b_ptr(nxt, 0) : S.b_ptr(cur, t2); \
            const char* b3 = last ? S.b_ptr(nxt, 1) : S.b_ptr(cur, t3); \
 \
            PG8_LDB(B0, 0, 0); PG8_LDB(B1, 0, 1); PG8_SCHED; PG8_LDA(At, 0, 0); if constexpr (!(HALFC)) PG8_STAGEA(PG8_SA(1, 1), offC, 1, a1); \
            if (last && has_next) { PG8_OFFS(offC, nxt); } \
            PG8_WAIT_K; PG8_WAIT_L(0); PG8_BAR; PG8_MMA(0, 0, At, B0); PG8_MMA(0, 1, At, B1); PG8_BAR; PG8_SCHED; \
 \
            if constexpr (!(HALFC)) PG8_LDA(At, 0, 1); PG8_STAGEB(PG8_SB(0, 0), b2); PG8_STAGEB(PG8_SB(0, 1), b2 + hstepB); PG8_STAGEA(PG8_SA(0, 0), offC, 0, a2); \
            PG8_WAIT_K; PG8_WAIT_L(0); PG8_BAR; if constexpr (!(HALFC)) { PG8_MMA(1, 0, At, B0); PG8_MMA(1, 1, At, B1); } PG8_BAR; PG8_SCHED; \
 \
            PG8_LDB(B0, 1, 0); PG8_LDB(B1, 1, 1); PG8_SCHED; PG8_LDA(At, 1, 0); if constexpr (!(HALFC)) PG8_STAGEA(PG8_SA(0, 1), offC, 1, a2); \
            PG8_WAIT_K; PG8_WAIT_L(0); PG8_BAR; PG8_MMA(0, 0, At, B0); PG8_MMA(0, 1, At, B1); PG8_BAR; PG8_SCHED; \
 \
            if constexpr (!(HALFC)) PG8_LDA(At, 1, 1); PG8_STAGEB(PG8_SB(1, 0), b3); PG8_STAGEB(PG8_SB(1, 1), b3 + hstepB); PG8_STAGEA(PG8_SA(1, 0), offC, 0, a3); \
            PG8_WAIT_K; PG8_WAIT_L(0); PG8_BAR; if constexpr (!(HALFC)) { PG8_MMA(1, 0, At, B0); PG8_MMA(1, 1, At, B1); } PG8_BAR; PG8_SCHED; \
            if constexpr (Epi::HAS_PRE) { if (t == 0) E.pre_store(pre_, lds); } \
        }
    Unit cur, nxt; int ui = 0;
    if (!S.next(0, cur)) return;
    if (SKEW_TICKS > 0) { const unsigned long long t0 = __builtin_amdgcn_s_memrealtime(), dl = (unsigned long long)((blockIdx.x >> 3) & 7) * SKEW_TICKS; while (__builtin_amdgcn_s_memrealtime() - t0 < dl) __builtin_amdgcn_s_sleep(8); }
    f32x4 acc[2][2][4][2];
#pragma unroll
    for (int a = 0; a < 2; ++a)
#pragma unroll
        for (int b = 0; b < 2; ++b)
#pragma unroll
            for (int m = 0; m < 4; ++m)
#pragma unroll
                for (int n = 0; n < 2; ++n) acc[a][b][m][n] = (f32x4){0.f, 0.f, 0.f, 0.f};
    bf16x8 At[4][2], B0[2][2], B1[2][2];
    unsigned offC[4];
    PG8_OFFS(offC, cur);
    const char* cB0 = S.b_ptr(cur, 0); const char* cB1 = S.b_ptr(cur, 1);
    PG8_STAGEB(PG8_SB(0, 0), cB0); PG8_STAGEB(PG8_SB(0, 1), cB0 + hstepB); PG8_STAGEA(PG8_SA(0, 0), offC, 0, 0); if constexpr (!HALFU) PG8_STAGEA(PG8_SA(0, 1), offC, 1, 0);
    if (wr == 1) PG8_BAR;
    if constexpr (HALFU) PG8_WAIT_V(0); else PG8_WAIT_V(2);
    PG8_BAR;
    PG8_STAGEB(PG8_SB(1, 0), cB1); PG8_STAGEA(PG8_SA(1, 0), offC, 0, kstep); PG8_STAGEB(PG8_SB(1, 1), cB1 + hstepB);
    PG8_WAIT_V(6); PG8_BAR;
    for (;;) {
        const bool has_next = S.next(ui + 1, nxt);
        if (!has_next) nxt = cur;
        typename Epi::Pre pre_ = E.pre_load(cur);
        PG8_KLOOP(HALFU)
        if (wr == 0) PG8_BAR;
        if constexpr (KREP > 1) {
#pragma unroll
            for (int a = 0; a < 2; ++a)
#pragma unroll
                for (int b = 0; b < 2; ++b)
#pragma unroll
                    for (int m = 0; m < 4; ++m)
#pragma unroll
                        for (int n = 0; n < 2; ++n) acc[a][b][m][n] = acc[a][b][m][n] * (1.0f / KREP); }
        E(acc, cur, wr, wc, fr, fq, lds);
        if (!has_next) break;
#pragma unroll
        for (int a = 0; a < 2; ++a)
#pragma unroll
            for (int b = 0; b < 2; ++b)
#pragma unroll
                for (int m = 0; m < 4; ++m)
#pragma unroll
                    for (int n = 0; n < 2; ++n) acc[a][b][m][n] = (f32x4){0.f, 0.f, 0.f, 0.f};
        cur = nxt; ++ui;
        if (wr == 1) PG8_BAR;
    }
    PG8_WAIT_V(0);
    PG8_BAR;
#undef PG8_SA
#undef PG8_SB
#undef PG8_STAGEA
#undef PG8_STAGEB
#undef PG8_LDA
#undef PG8_LDB
#undef PG8_MMA
#undef PG8_CAT
#undef PG8_WAIT_V
#undef PG8_WAIT_L
#undef PG8_WAIT_K
#undef PG8_BAR
#undef PG8_SCHED
#undef PG8_OFFS
#undef PG8_KLOOP
}
}

struct Args {
    const float* x; const float* norm_mix; const float* norm_ffn; const float* pool_w; const float* pool_scale; const float* kv_norm; const float* w_kv; const float* k_norm;
    const float* w_q; const float* q_norm; const float* w_o; const float* w_grp; const float* b_grp; const float* w_rt; const float* b_rt; const float* w_gate; const float* w_up; const float* w_down;
    float* out; unsigned char* ws; int ph_lo, ph_hi;
};
struct Frame {
    LAS unsigned char* lds; int tid, lane, wave, vcu, G;
};

template <bool OUT8> __device__ __forceinline__ void transpose_item(const float* W, int ldw, const float* gk, const float* gn, void* WTv, int ldk, int k0, int n0, int drow0, LAS float* scr, int lane, float scale = 1.f) {
    float v[32];
    const float* src = W + (size_t)(k0 + (lane >> 5)) * ldw + n0 + (lane & 31);
#pragma unroll
    for (int i = 0; i < 32; ++i) v[i] = __builtin_nontemporal_load(src + (size_t)(2 * i) * ldw);
    const int c = lane & 7;
    f32x4 ga = (f32x4){1.f, 1.f, 1.f, 1.f}, gb = ga;
    if (gk) { ga = *(const f32x4*)(gk + k0 + 8 * c); gb = *(const f32x4*)(gk + k0 + 8 * c + 4); }
#pragma unroll
    for (int i = 0; i < 32; ++i) scr[(2 * i + (lane >> 5)) * 33 + (lane & 31)] = v[i];
    LDS_WAIT(); asm volatile("" ::: "memory");
#pragma unroll
    for (int j = 0; j < 4; ++j) { const int n = (lane >> 3) + 8 * j; const LAS float* s = scr + (8 * c) * 33 + n; const float g = (gn ? gn[n0 + n] : 1.f) * scale;
        if constexpr (OUT8) { u32x2 o; o.x = pk4_fp8(s[0 * 33] * ga[0] * g, s[1 * 33] * ga[1] * g, s[2 * 33] * ga[2] * g, s[3 * 33] * ga[3] * g); o.y = pk4_fp8(s[4 * 33] * gb[0] * g, s[5 * 33] * gb[1] * g, s[6 * 33] * gb[2] * g, s[7 * 33] * gb[3] * g);
            __builtin_nontemporal_store(o, (u32x2*)((unsigned char*)WTv + (size_t)(drow0 + n) * ldk + k0 + 8 * c)); }
        else { u32x4 o; o.x = pk2(s[0 * 33] * ga[0] * g, s[1 * 33] * ga[1] * g); o.y = pk2(s[2 * 33] * ga[2] * g, s[3 * 33] * ga[3] * g); o.z = pk2(s[4 * 33] * gb[0] * g, s[5 * 33] * gb[1] * g); o.w = pk2(s[6 * 33] * gb[2] * g, s[7 * 33] * gb[3] * g);
            __builtin_nontemporal_store(o, (u32x4*)((bf16_t*)WTv + (size_t)(drow0 + n) * ldk + k0 + 8 * c)); } }
    LDS_WAIT(); asm volatile("" ::: "memory");
}


__device__ __forceinline__ void strip_item_i8(const float* W, int ldw, const float* gk, unsigned char* WT, float* cscale, int n0, int drow0, LAS float* scr, LAS float* smax, int lane, int wave) {
    const float* src = W + (size_t)(lane >> 5) * ldw + n0 + (lane & 31);
    const int kb0 = wave * 4;
    float amax = 0.f;
    unsigned pk[4][16];
#pragma unroll
    for (int q = 0; q < 4; ++q) { const int kb = kb0 + q;
        float v[32];
#pragma unroll
        for (int i = 0; i < 32; ++i) v[i] = __builtin_nontemporal_load(src + (size_t)(64 * kb + 2 * i) * ldw);
#pragma unroll
        for (int i = 0; i < 32; ++i) { const float g = gk ? gk[64 * kb + 2 * i + (lane >> 5)] : 1.f; v[i] *= g; amax = fmaxf(amax, fabsf(v[i])); }
#pragma unroll
        for (int i = 0; i < 16; ++i) pk[q][i] = cvt_pk_bf16(v[2 * i], v[2 * i + 1]);
    }
    amax = fmaxf(amax, __shfl_xor(amax, 32));
    if (lane < 32) smax[wave * 32 + lane] = amax;
    __syncthreads();
    if (lane < 32) { float m = 0.f;
#pragma unroll
        for (int w = 0; w < NWAVES; ++w) m = fmaxf(m, smax[w * 32 + lane]);
        scr[64 * 33 + lane] = m > 0.f ? 127.0f / m : 0.f; if (wave == 0) cscale[drow0 + lane] = m * (1.0f / 127.0f); }
    const int c = lane & 7;
#pragma unroll
    for (int q = 0; q < 4; ++q) { const int kb = kb0 + q;
#pragma unroll
        for (int i = 0; i < 16; ++i) { scr[(4 * i + (lane >> 5)) * 33 + (lane & 31)] = __builtin_bit_cast(float, pk[q][i] << 16); scr[(4 * i + 2 + (lane >> 5)) * 33 + (lane & 31)] = __builtin_bit_cast(float, pk[q][i] & 0xffff0000u); }
        LDS_WAIT(); asm volatile("" ::: "memory");
#pragma unroll
        for (int j = 0; j < 4; ++j) { const int n = (lane >> 3) + 8 * j; const LAS float* s = scr + (8 * c) * 33 + n; const float qs = scr[64 * 33 + n];
            u32x2 o; o.x = pk4_i8(s[0 * 33] * qs, s[1 * 33] * qs, s[2 * 33] * qs, s[3 * 33] * qs); o.y = pk4_i8(s[4 * 33] * qs, s[5 * 33] * qs, s[6 * 33] * qs, s[7 * 33] * qs);
            *(u32x2*)(WT + (size_t)(drow0 + n) * DM + 64 * kb + 8 * c) = o; }
        LDS_WAIT(); asm volatile("" ::: "memory");
    }
    __syncthreads();
}

__device__ __forceinline__ void conv_gu_item(const Args& a, int layer, int idx, LAS float* scr, int lane) {
    const int which = idx >> 13, e = (idx >> 9) & 15, rr = idx & 511, kb = rr >> 4, nb = rr & 15, le = layer * NE + e;
    const int f0 = 32 * nb, drow0 = (f0 >> 7) * 256 + which * 128 + (f0 & 127);
    transpose_item<true>((which ? a.w_up : a.w_gate) + (size_t)le * DM * FF, FF, a.norm_ffn + layer * DM, nullptr, a.ws + WS_WGU + (size_t)le * 1024 * DM, DM, 64 * kb, f0, drow0, scr, lane, 64.f);
}
__device__ __forceinline__ void conv_down_item(const Args& a, int layer, int idx, LAS float* scr, int lane) {
    const int e = idx >> 9, rr = idx & 511, kb = rr >> 6, nb = rr & 63, le = layer * NE + e;
    transpose_item<true>(a.w_down + (size_t)le * FF * DM, DM, nullptr, nullptr, a.ws + WS_WD + (size_t)le * DM * FF, FF, 64 * kb, 32 * nb, 32 * nb, scr, lane, 32.f);
}
constexpr int N_GU_ITEMS = 16384, N_DOWN_ITEMS = 8192;
constexpr int Q_GU3 = 10, Q_GU4 = 4, Q_DN4 = 24;
struct FillPlan { int gu3, gu4, dn4, nidle, rank, st3, st4; };
__device__ __forceinline__ FillPlan fill_plan(int units, int G, int vcu) { FillPlan p; const int rem = units % G; p.nidle = rem == 0 ? G : G - rem; p.rank = rem == 0 ? vcu : vcu - rem;
    const long cap = (long)p.nidle * NWAVES; const long g3 = cap * Q_GU3, g4 = g3 + cap * Q_GU4, d4 = cap * Q_DN4;
    p.gu3 = g3 < N_GU_ITEMS ? (int)g3 : N_GU_ITEMS; p.gu4 = g4 < N_GU_ITEMS ? (int)g4 : N_GU_ITEMS; p.dn4 = d4 < N_DOWN_ITEMS ? (int)d4 : N_DOWN_ITEMS;
    p.st3 = p.nidle < 256 ? p.nidle : 256; { const int e = p.st3 + 2 * p.nidle; p.st4 = e < 256 ? e : 256; } return p; }
template <bool DOWN> __device__ __forceinline__ void fill_range(const Args& a, Frame& F, const FillPlan& p, int lo, int hi) {
    if (p.rank < 0) return;
    const int nw = p.nidle * NWAVES; LAS float* scr = (LAS float*)(F.lds + F.wave * 16384);
    for (int idx = lo + p.rank * NWAVES + F.wave; idx < hi; idx += nw) { if (DOWN) conv_down_item(a, 1, idx, scr, F.lane); else conv_gu_item(a, 1, idx, scr, F.lane); }
}
template <bool DOWN> __device__ __forceinline__ void fill_tail(const Args& a, Frame& F, int lo) {
    const int nitems = DOWN ? N_DOWN_ITEMS : N_GU_ITEMS; LAS float* scr = (LAS float*)(F.lds + F.wave * 16384);
    for (int idx = lo + F.vcu * NWAVES + F.wave; idx < nitems; idx += F.G * NWAVES) { if (DOWN) conv_down_item(a, 1, idx, scr, F.lane); else conv_gu_item(a, 1, idx, scr, F.lane); }
}
__device__ __forceinline__ int moe_units_l0(const Args& a) {
    const unsigned* cnt = (const unsigned*)(a.ws + WS_CTL) + CW_CNT; const int lane = threadIdx.x & 63;
    int r = lane < NBKT ? (((int)__hip_atomic_load(cnt + lane * 64, __ATOMIC_RELAXED, __HIP_MEMORY_SCOPE_AGENT) + 255) >> 8) : 0;
#pragma unroll
    for (int o = 1; o < 64; o <<= 1) r += __shfl_xor(r, o);
    return 8 * __builtin_amdgcn_readfirstlane(r);
}
constexpr int N_STRIPS = 256;
__device__ __forceinline__ void do_strip(const Args& a, Frame& F, int st) {
    LAS float* scr = (LAS float*)(F.lds + F.wave * 16384); LAS float* smax = (LAS float*)(F.lds + 8 * 16384);
    if (st < 64) strip_item_i8(a.w_q, DM, a.norm_mix + DM, a.ws + WS_WQKV, (float*)(a.ws + WS_CSQKV), 32 * st, 32 * st, scr, smax, F.lane, F.wave);
    else if (st < 192) strip_item_i8(a.w_kv, 2 * DM, a.kv_norm, a.ws + WS_WQKV, (float*)(a.ws + WS_CSQKV), 32 * (st - 64), DM + 32 * (st - 64), scr, smax, F.lane, F.wave);
    else strip_item_i8(a.w_o, DM, nullptr, a.ws + WS_WO, (float*)(a.ws + WS_CSWO), 32 * (st - 192), 32 * (st - 192), scr, smax, F.lane, F.wave);
}
__device__ __forceinline__ void p0_weights(const Args& a, Frame& F) {
    LAS float* scr = (LAS float*)(F.lds + F.wave * 16384);
    const int gw = F.vcu * NWAVES + F.wave, NGW = F.G * NWAVES;
    bf16_t* Wpool = (bf16_t*)(a.ws + WS_WPOOL);
    constexpr int I_POOL = 4 * 8 * 16, NITEMS = I_POOL + N_GU_ITEMS + N_DOWN_ITEMS;
    for (int it = gw; it < NITEMS; it += NGW) {
        int r = it;
        if (r < I_POOL) { const int g = r / 128, rr = r % 128, kb = rr / 16, nb = rr % 16;
            transpose_item<false>(a.pool_w + (size_t)g * PGC * PGC, PGC, a.norm_mix + g * PGC, a.pool_scale + g * PGC, Wpool + (size_t)g * PGC * PGC, PGC, 64 * kb, 32 * nb, 32 * nb, scr, F.lane); continue; } r -= I_POOL;
        if (r < N_GU_ITEMS) { conv_gu_item(a, 0, r, scr, F.lane); continue; } r -= N_GU_ITEMS;
        conv_down_item(a, 0, r, scr, F.lane);
    }
    bf16_t* Wr = (bf16_t*)(a.ws + WS_WR);
    for (int idx = (F.vcu * NTHR + F.tid); idx < 2 * 32 * DM; idx += F.G * NTHR) {
        const int l = idx / (32 * DM), rr = (idx / DM) % 32, k = idx % DM; float v = 0.f;
        if (rr < 16) v = a.w_rt[(((size_t)l * NGRP + (rr >> 2)) * DM + k) * EPG + (rr & 3)];
        else if (rr < 20) v = a.w_grp[((size_t)l * DM + k) * NGRP + (rr - 16)];
        v *= a.norm_ffn[l * DM + k];
        const unsigned hi = f2bf(v); const float rem = v - __builtin_bit_cast(float, hi << 16);
        Wr[idx] = (bf16_t)hi; Wr[2 * 32 * DM + idx] = (bf16_t)f2bf(rem);
    }
}

template <int W> __device__ __forceinline__ void pool_batch(const float* xb, int t0, int rb, int c0, int tid, int lane, int wave, LAS float* rs, LAS float* part,
                                                            f32x4 (&cv)[16], const f32x4 (&hist)[16], f32x4& S, bf16_t* prow) {
    constexpr int NB = 16;
#pragma unroll
    for (int i = 0; i < NB; ++i) cv[i] = *(const f32x4*)(xb + (size_t)(t0 + rb + i) * DM + c0);
    float q[NB];
#pragma unroll
    for (int i = 0; i < NB; ++i) q[i] = (cv[i].x * cv[i].x + cv[i].y * cv[i].y) + (cv[i].z * cv[i].z + cv[i].w * cv[i].w);
#pragma unroll
    for (int i = 0; i < NB; ++i) q[i] = wave_sum(q[i]);
    if (lane == 0) {
#pragma unroll
        for (int i = 0; i < NB; ++i) part[wave * NB + i] = q[i]; }
    __syncthreads();
    if (tid < NB) { float ss = 0.f;
#pragma unroll
        for (int wv = 0; wv < NWAVES; ++wv) ss += part[wv * NB + tid];
        rs[16 + rb + tid] = 1.0f / sqrtf(ss * (1.0f / DM) + EPS); }
    __syncthreads();
#pragma unroll
    for (int i = 0; i < NB; ++i) { const int r = rb + i, t = t0 + r;
        cv[i] = cv[i] * rs[r + 16];
        S += cv[i];
        const float inv = 1.0f / (float)((t + 1 < W) ? (t + 1) : W);
        const f32x4 p = S * inv - cv[i];
        u32x2 o; o.x = pk2(p.x, p.y); o.y = pk2(p.z, p.w);
        *(u32x2*)(prow + (size_t)r * DM) = o;
        if (i - W + 1 >= 0) S -= cv[i - W + 1 >= 0 ? i - W + 1 : 0]; else S -= hist[NB + i - W + 1 < NB ? NB + i - W + 1 : 0]; }
}
template <int W> __device__ __forceinline__ void pool_unit(const float* xb, int t0, int c0, int tid, int lane, int wave, LAS float* rs, LAS float* part, bf16_t* prow) {
    f32x4 A[16], B[16]; f32x4 S = (f32x4){0.f, 0.f, 0.f, 0.f};
#pragma unroll
    for (int r = 0; r < 16; ++r) { B[r] = (f32x4){0.f, 0.f, 0.f, 0.f};
        if (16 - r < W) { int t = t0 - (16 - r); t = t < 0 ? 0 : t; B[r] = *(const f32x4*)(xb + (size_t)t * DM + c0) * rs[r]; S += B[r]; } }
#pragma unroll 1
    for (int rb = 0; rb < 128; rb += 32) {
        pool_batch<W>(xb, t0, rb, c0, tid, lane, wave, rs, part, A, B, S, prow);
        pool_batch<W>(xb, t0, rb + 16, c0, tid, lane, wave, rs, part, B, A, S, prow);
    }
}
__device__ __forceinline__ void p0_pool(const Args& a, Frame& F, bf16_t* pooled) {
    constexpr int TC = 128;
    LAS float* rs = (LAS float*)(F.lds);
    LAS float* part = (LAS float*)(F.lds + 1024);
    const int c0 = F.tid * 4, gi = c0 / PGC;
    for (int u = F.vcu; u < T / TC; u += F.G) {
        const int b = u / (SEQ / TC), t0 = (u % (SEQ / TC)) * TC;
        const float* xb = a.x + (size_t)b * SEQ * DM;
        __syncthreads();
        { const int rg = F.wave * 2 - 16;
          f32x4 v[2][8];
#pragma unroll
          for (int q = 0; q < 2; ++q) { int t = t0 + rg + q; t = t < 0 ? 0 : t; const f32x4* xr = (const f32x4*)(xb + (size_t)t * DM) + F.lane;
#pragma unroll
              for (int j = 0; j < 8; ++j) v[q][j] = xr[64 * j]; }
#pragma unroll
          for (int q = 0; q < 2; ++q) { const int r = rg + q, t = t0 + r; float ss = 0.f;
#pragma unroll
              for (int j = 0; j < 8; ++j) ss += (v[q][j].x * v[q][j].x + v[q][j].y * v[q][j].y) + (v[q][j].z * v[q][j].z + v[q][j].w * v[q][j].w);
              ss = wave_sum(ss);
              if (F.lane == 0) rs[r + 16] = (t >= 0) ? 1.0f / sqrtf(ss * (1.0f / DM) + EPS) : 0.f; } }
        __syncthreads();
        bf16_t* prow = pooled + ((size_t)b * SEQ + t0) * DM + c0;
        if (gi == 0) pool_unit<2>(xb, t0, c0, F.tid, F.lane, F.wave, rs, part, prow);
        else if (gi == 1) pool_unit<4>(xb, t0, c0, F.tid, F.lane, F.wave, rs, part, prow);
        else if (gi == 2) pool_unit<8>(xb, t0, c0, F.tid, F.lane, F.wave, rs, part, prow);
        else pool_unit<16>(xb, t0, c0, F.tid, F.lane, F.wave, rs, part, prow);
    }
    __syncthreads();
}

struct SchedPlain {
    const char* A; const char* B; unsigned lda_bytes, ldb_bytes; int nM, nN, G, vcu; int pool; int rep;
    __device__ __forceinline__ bool next(int i, pg8::Unit& u) const {
        if (G == 256 && (nM & 3) == 0 && (nN & 7) == 0 && ((nM >> 2) * (nN >> 3)) % 8 == 0) {
            const int SN = nN >> 3, nS = (nM >> 2) * SN; int s = i * 8 + (vcu >> 5); if (s >= rep * nS) return false; s %= nS;
            const int c = vcu & 31; u.j = i; u.pm = (s / SN) * 4 + (c >> 3); u.pn = (s % SN) * 8 + (c & 7); u.aux = 0; u.h = 0; return true; }
        int L = i * G + vcu; if (L >= rep * nM * nN) return false; L %= nM * nN; u.j = i; u.pm = L / nN; u.pn = L % nN; u.aux = 0; u.h = 0; return true; }
    __device__ __forceinline__ unsigned row_off(const pg8::Unit& u, int r) const { return (unsigned)(u.pm * 256 + r) * lda_bytes + (pool ? (unsigned)(u.pn >> 1) * (PGC * 2) : 0u); }
    __device__ __forceinline__ const char* b_ptr(const pg8::Unit& u, int kt) const { return B + (size_t)u.pn * 256 * ldb_bytes + (size_t)kt * 128; }
};

struct EpiPool {
    static constexpr bool HAS_PRE = false; struct Pre {}; __device__ __forceinline__ Pre pre_load(const pg8::Unit&) const { return Pre{}; } __device__ __forceinline__ void pre_store(const Pre&, LAS unsigned char*) const {}
    const float* x; bf16_t* out; unsigned char* out8;
    __device__ __forceinline__ void operator()(const f32x4 (&acc)[2][2][4][2], const pg8::Unit& u, int wr, int wc, int fr, int fq, LAS unsigned char*) const {
        const int row0 = u.pm * 256 + wr * 64 + fr, col0 = u.pn * 256 + wc * 32 + 8 * fq;
#pragma unroll
        for (int ai = 0; ai < 2; ++ai)
#pragma unroll
            for (int mp = 0; mp < 2; ++mp) {
                f32x4 xv[2][2][2];
#pragma unroll
                for (int mm = 0; mm < 2; ++mm) { const size_t ro = (size_t)(row0 + ai * 128 + (mp * 2 + mm) * 16) * DM + col0;
#pragma unroll
                    for (int bj = 0; bj < 2; ++bj) { xv[mm][bj][0] = *(const f32x4*)(x + ro + bj * 128); xv[mm][bj][1] = *(const f32x4*)(x + ro + bj * 128 + 4); } }
                asm volatile("" ::: "memory");
                u32x2 w8[2][2];
#pragma unroll
                for (int mm = 0; mm < 2; ++mm) { const int m = mp * 2 + mm; const size_t ro = (size_t)(row0 + ai * 128 + m * 16) * DM + col0;
#pragma unroll
                    for (int bj = 0; bj < 2; ++bj) { const f32x4 v0 = acc[ai][bj][m][0] + xv[mm][bj][0], v1 = acc[ai][bj][m][1] + xv[mm][bj][1];
                        u32x4 w; w.x = cvt_pk_bf16(v0[0], v0[1]); w.y = cvt_pk_bf16(v0[2], v0[3]); w.z = cvt_pk_bf16(v1[0], v1[1]); w.w = cvt_pk_bf16(v1[2], v1[3]);
                        *(u32x4*)(out + ro + bj * 128) = w;
                        w8[mm][bj].x = pk4_fp8(v0[0], v0[1], v0[2], v0[3]); w8[mm][bj].y = pk4_fp8(v1[0], v1[1], v1[2], v1[3]); } }
                { const size_t roq = (size_t)(row0 + ai * 128 + (mp * 2 + (fq & 1)) * 16) * DM + col0 - ((fq & 1) ? 8 : 0);
#pragma unroll
                  for (int bj = 0; bj < 2; ++bj) *(u32x4*)(out8 + roq + bj * 128) = widen8(w8[0][bj], w8[1][bj]); }
                asm volatile("" ::: "memory"); }
    }
};


__device__ __forceinline__ void bucket_experts(int b, int& ge_lo, int& ge_hi) { const int g = b / 6, p = b % 6; const int el = p < 3 ? 0 : (p < 5 ? 1 : 2), eh = p < 3 ? p + 1 : (p < 5 ? p - 1 : 3); ge_lo = g * 4 + el; ge_hi = g * 4 + eh; }
__device__ __forceinline__ void router_phase(const Args& a, Frame& F, const bf16_t* h, int layer) {
    const char* Wh = (const char*)((const bf16_t*)(a.ws + WS_WR) + (size_t)layer * 32 * DM); const char* Wl = Wh + (size_t)2 * 32 * DM * 2;
    unsigned* cnt = (unsigned*)(a.ws + WS_CTL) + CW_CNT + layer * NBKT * 64;
    int* list = (int*)(a.ws + WS_LIST); f32x4* meta = (f32x4*)(a.ws + WS_META);
    LAS char* lds = (LAS char*)F.lds;
    LAS float* lg = (LAS float*)(F.lds + 98304 + F.wave * 2048);
    LAS unsigned* bc = (LAS unsigned*)(F.lds + 98304 + 16384);
    const int tk = F.lane & 15, q = F.lane >> 4, wid = F.wave;
    unsigned wsrc[4];
#pragma unroll
    for (int i = 0; i < 4; ++i) { const int p = i * 512 + F.tid, row = (p >> 5) & 31, cp = p & 31; wsrc[i] = (unsigned)(row * (DM * 2) + ((cp ^ (row & 15)) * 16)); }
#define RT_STAGE(kc, buf) do { _Pragma("unroll") for (int _i = 0; _i < 4; ++_i) __builtin_amdgcn_global_load_lds((const unsigned*)((_i < 2 ? Wh : Wl) + (size_t)(kc) * 512 + wsrc[_i]), (LAS unsigned*)(lds + (buf) * 32768 + _i * 8192 + wid * 1024), 16, 0, 0); } while (0)
    const int aoffA = tk * 512, aoffB = (16 + tk) * 512;
    for (int bt = F.vcu; bt < T / 128; bt += F.G) {
        const int tok0 = bt * 128 + wid * 16;
        __syncthreads();
        if (F.tid < 64) bc[F.tid] = 0u;
        f32x4 c0 = {0.f, 0.f, 0.f, 0.f}, c1 = c0, css = c0;
        const bf16_t* hp = h + (size_t)(tok0 + tk) * DM + 8 * q;
        bf16x8 hf[8];
        bf16x8 hn[8], hnn[8];
        RT_STAGE(0, 0);
#pragma unroll
        for (int s = 0; s < 8; ++s) hf[s] = *(const bf16x8*)(hp + 32 * s);
        RT_STAGE(1, 1);
#pragma unroll
        for (int s = 0; s < 8; ++s) hn[s] = *(const bf16x8*)(hp + 256 + 32 * s);
        for (int kc = 0; kc < 8; ++kc) {
            if (kc < 7) asm volatile("s_waitcnt vmcnt(12)" ::: "memory"); else asm volatile("s_waitcnt vmcnt(0)" ::: "memory");
            __builtin_amdgcn_s_barrier(); asm volatile("" ::: "memory");
            if (kc < 6) { RT_STAGE(kc + 2, (kc + 2) % 3);
#pragma unroll
                for (int s = 0; s < 8; ++s) hnn[s] = *(const bf16x8*)(hp + 256 * (kc + 2) + 32 * s); }
            const LAS char* wb = lds + (kc % 3) * 32768;
#pragma unroll
            for (int s = 0; s < 8; ++s) { const int co = ((4 * s + q) ^ tk) * 16;
                const bf16x8 a0 = *(const LAS bf16x8*)(wb + aoffA + co), a1 = *(const LAS bf16x8*)(wb + aoffB + co), a0l = *(const LAS bf16x8*)(wb + 16384 + aoffA + co), a1l = *(const LAS bf16x8*)(wb + 16384 + aoffB + co);
                c0 = __builtin_amdgcn_mfma_f32_16x16x32_bf16(a0, hf[s], c0, 0, 0, 0); c0 = __builtin_amdgcn_mfma_f32_16x16x32_bf16(a0l, hf[s], c0, 0, 0, 0);
                c1 = __builtin_amdgcn_mfma_f32_16x16x32_bf16(a1, hf[s], c1, 0, 0, 0); c1 = __builtin_amdgcn_mfma_f32_16x16x32_bf16(a1l, hf[s], c1, 0, 0, 0);
                css = __builtin_amdgcn_mfma_f32_16x16x32_bf16(hf[s], hf[s], css, 0, 0, 0); }
            asm volatile("s_waitcnt lgkmcnt(0)" ::: "memory");
#pragma unroll
            for (int s = 0; s < 8; ++s) { hf[s] = hn[s]; hn[s] = hnn[s]; }
        }
#pragma unroll
        for (int r = 0; r < 4; ++r) lg[tk * 24 + 4 * q + r] = c0[r];
        if (q == 0) {
#pragma unroll
            for (int r = 0; r < 4; ++r) lg[tk * 24 + 16 + r] = c1[r]; }
        if (q == (tk >> 2)) { const int rr = tk & 3; lg[384 + tk] = rr == 0 ? css[0] : (rr == 1 ? css[1] : (rr == 2 ? css[2] : css[3])); }
        LDS_WAIT(); asm volatile("" ::: "memory");
        int b = 0; unsigned lpos = 0; float rstd = 0.f, wlo = 0.f, whi = 0.f;
        if (F.lane < 16) {
            rstd = 1.0f / sqrtf(lg[384 + tk] * (1.0f / DM) + EPS);
            float gl[4], el[4];
#pragma unroll
            for (int g = 0; g < 4; ++g) gl[g] = lg[tk * 24 + 16 + g] * rstd + a.b_grp[layer * NGRP + g];
            int gs = 0; float gm = gl[0];
#pragma unroll
            for (int g = 1; g < 4; ++g) if (gl[g] > gm) { gm = gl[g]; gs = g; }
            float den = 0.f;
#pragma unroll
            for (int g = 0; g < 4; ++g) den += __expf(gl[g] - gm);
            const float gwt = 1.0f / den;
#pragma unroll
            for (int e = 0; e < 4; ++e) el[e] = lg[tk * 24 + gs * 4 + e] * rstd + a.b_rt[(layer * NGRP + gs) * EPG + e];
            int i1 = 0; float v1 = el[0];
#pragma unroll
            for (int e = 1; e < 4; ++e) if (el[e] > v1) { v1 = el[e]; i1 = e; }
            int i2 = -1; float v2 = -3.0e38f;
#pragma unroll
            for (int e = 0; e < 4; ++e) if (e != i1 && el[e] > v2) { v2 = el[e]; i2 = e; }
            const float w1 = gwt / (1.0f + __expf(v2 - v1)), w2 = gwt - w1;
            const int elo = i1 < i2 ? i1 : i2, ehi = i1 < i2 ? i2 : i1; wlo = i1 < i2 ? w1 : w2; whi = i1 < i2 ? w2 : w1;
            const int pidx = elo == 0 ? ehi - 1 : (elo == 1 ? ehi + 1 : 5);
            b = gs * 6 + pidx;
            lpos = __hip_atomic_fetch_add(bc + b, 1u, __ATOMIC_RELAXED, __HIP_MEMORY_SCOPE_WORKGROUP);
        }
        __syncthreads();
        if (F.tid < NBKT) { const unsigned n = bc[F.tid]; bc[32 + F.tid] = n ? __hip_atomic_fetch_add(cnt + F.tid * 64, n, __ATOMIC_RELAXED, __HIP_MEMORY_SCOPE_AGENT) : 0u; }
        __syncthreads();
        if (F.lane < 16) { const unsigned pos = bc[32 + b] + lpos;
            list[(size_t)b * T + pos] = tok0 + tk;
            meta[(size_t)b * T + pos] = (f32x4){rstd, wlo, whi, 0.f}; }
    }
#undef RT_STAGE
    asm volatile("s_waitcnt vmcnt(0)" ::: "memory"); __syncthreads();
}

constexpr int MAXU = 8;
struct MoeTab { LAS int* ud; LAS unsigned* rowtab; };
__device__ __forceinline__ void moe_build(const Args& a, Frame& F, int layer, int gather) {
    LAS int* ud = (LAS int*)(F.lds + UDESC_OFF); LAS int* tb = ud + MAXU * 8;
    LAS unsigned* rowtab = (LAS unsigned*)(F.lds + ROWTAB_OFF);
    const unsigned* cnt = (const unsigned*)(a.ws + WS_CTL) + CW_CNT + layer * NBKT * 64;
    const int* list = (const int*)(a.ws + WS_LIST);
    __syncthreads();
    if (F.tid < NBKT) tb[32 + F.tid] = (int)__hip_atomic_load(cnt + F.tid * 64, __ATOMIC_RELAXED, __HIP_MEMORY_SCOPE_AGENT);
    __syncthreads();
    if (F.tid == 0) { int base = 0; for (int b = 0; b < NBKT; ++b) { tb[b] = base; base += (tb[32 + b] + 255) >> 8; } tb[NBKT] = base; }
    __syncthreads();
    if (F.tid < MAXU) { const int i = F.tid, R = tb[NBKT]; int L = i * F.G + F.vcu; int v = 0, rt = 0, pn = 0, b = 0, ti = 0, nv = 0, hf = 0;
        { const int nf = (8 * R) / F.G, extra = 8 * R - nf * F.G; if (layer == 1 && i == nf && extra > 0 && 2 * extra <= F.G) { if (F.vcu < 2 * extra) { L = nf * F.G + (F.vcu >> 1); hf = 1 + (F.vcu & 1); } else L = 8 * R; } }
        if (L < 8 * R) { v = 1; rt = L >> 3; pn = L & 7; while (tb[b + 1] <= rt) ++b; ti = rt - tb[b]; nv = tb[32 + b] - 256 * ti; if (nv > 256) nv = 256; }
        ud[i * 8 + 0] = rt; ud[i * 8 + 1] = pn; ud[i * 8 + 2] = b; ud[i * 8 + 3] = ti; ud[i * 8 + 4] = nv; ud[i * 8 + 5] = v; ud[i * 8 + 6] = hf;
        if (i == 0) { const int nf = (8 * R) / F.G, extra = 8 * R - nf * F.G; tb[60] = (layer == 1 && extra > 0 && 2 * extra <= F.G && F.vcu < 2 * extra && nf < MAXU) ? nf : -1; } }
    __syncthreads();
    if (gather) for (int e = F.tid; e < MAXU * 256; e += NTHR) { const int i = e >> 8, r = e & 255; unsigned off = 0;
        if (ud[i * 8 + 5]) { const int b = ud[i * 8 + 2], ti = ud[i * 8 + 3], nv = ud[i * 8 + 4]; const int rr = r < nv ? r : nv - 1; off = (unsigned)list[(size_t)b * T + 256 * ti + rr] * (gather == 1 ? (unsigned)DM : 1u); }
        rowtab[e] = off; }
    VM_WAIT(); __syncthreads();
}
__device__ __forceinline__ int rfl(int v) { return __builtin_amdgcn_readfirstlane(v); }
struct SchedMoe {
    const char* A; const char* W; unsigned ldb_bytes; LAS int* ud; LAS unsigned* rowtab; int layer; int down; int halfpass;
    __device__ __forceinline__ bool next(int i, pg8::Unit& u) const { if (halfpass) { if (i > 0) return false; i = rfl(ud[MAXU * 8 + 60]); if (i < 0) return false; } else { if (i >= MAXU) return false; if (rfl(ud[i * 8 + 6]) != 0) return false; }
        if (!rfl(ud[i * 8 + 5])) return false; u.j = i; u.pm = rfl(ud[i * 8 + 0]); u.pn = rfl(ud[i * 8 + 1]); u.aux = rfl(ud[i * 8 + 2]); u.h = rfl(ud[i * 8 + 6]); return true; }
    __device__ __forceinline__ unsigned row_off(const pg8::Unit& u, int r) const { r ^= (u.h == 2 ? 128 : 0); return down ? (unsigned)(u.pm * 256 + r) * (unsigned)(2 * FF) : rowtab[u.j * 256 + r]; }
    __device__ __forceinline__ const char* b_ptr(const pg8::Unit& u, int kt) const {
        int gl, gh; bucket_experts(u.aux, gl, gh);
        if (!down) { const int ge = u.pn < 4 ? gl : gh; return W + ((size_t)(layer * NE + ge) * 1024 + (size_t)(u.pn & 3) * 256) * (size_t)DM + (size_t)kt * 128; }
        const int ge = kt < 4 ? gl : gh; return W + ((size_t)(layer * NE + ge) * DM + (size_t)u.pn * 256) * (size_t)FF + (size_t)(kt & 3) * 128;
    }
};
struct EpiSwiGLU {
    const f32x4* meta; unsigned char* H; LAS int* ud;
    static constexpr bool HAS_PRE = true; struct Pre { float a, b; };
    __device__ __forceinline__ Pre pre_load(const pg8::Unit& u) const { Pre p{0.f, 0.f}; const int t = threadIdx.x;
        if (t < 256) { const float* mp = (const float*)(meta + (size_t)u.aux * T + 256 * rfl(ud[u.j * 8 + 3]) + t); p.a = mp[0]; p.b = mp[1 + (u.pn >> 2)]; } return p; }
    __device__ __forceinline__ void pre_store(const Pre& p, LAS unsigned char* lds) const { const int t = threadIdx.x; if (t < 256) { LAS float* tb = (LAS float*)(lds + EX_OFF); tb[2 * t] = p.a; tb[2 * t + 1] = p.b; } }
    __device__ __forceinline__ void operator()(const f32x4 (&acc)[2][2][4][2], const pg8::Unit& u, int wr, int wc, int fr_, int fq, LAS unsigned char* lds) const {
        int fr = fr_;
        const int hi = u.pn >> 2; const LAS float* tb = (const LAS float*)(lds + EX_OFF);
        const int hcol = hi * 512 + (u.pn & 3) * 128 + wc * 32 + 8 * fq;
        const int rx = u.h == 2 ? 128 : 0, nai = u.h ? 1 : 2;
        asm volatile("" : "+v"(fr));
        float rsv[2][4], wv[2][4];
#pragma unroll
        for (int ai = 0; ai < 2; ++ai)
#pragma unroll
            for (int m = 0; m < 4; ++m) { const int r = (ai * 128 + wr * 64 + m * 16 + fr) ^ rx; rsv[ai][m] = tb[2 * r]; wv[ai][m] = tb[2 * r + 1]; }
        asm volatile("" ::: "memory");
        u32x2 pkv[2][4];
#pragma unroll
        for (int ai = 0; ai < 2; ++ai)
#pragma unroll
            for (int m = 0; m < 4; ++m) { if (ai >= nai) continue; const float rstd = rsv[ai][m] * (1.0f / 64.0f), w = wv[ai][m] * 8.0f;
                const float c1 = -rstd * 1.4426950408889634f, kr = rstd * rstd * w;
                f32x4 ov[2];
#pragma unroll
                for (int n = 0; n < 2; ++n) { const f32x4 ga = acc[ai][0][m][n], ua = acc[ai][1][m][n]; const f32x4 x = ga * c1;
                    f32x4 d; d[0] = __builtin_amdgcn_exp2f(x[0]); d[1] = __builtin_amdgcn_exp2f(x[1]); d[2] = __builtin_amdgcn_exp2f(x[2]); d[3] = __builtin_amdgcn_exp2f(x[3]);
                    d = d + 1.0f;
                    f32x4 r; r[0] = __builtin_amdgcn_rcpf(d[0]); r[1] = __builtin_amdgcn_rcpf(d[1]); r[2] = __builtin_amdgcn_rcpf(d[2]); r[3] = __builtin_amdgcn_rcpf(d[3]);
                    ov[n] = ((ga * ua) * kr) * r; }
                pkv[ai][m].x = pk4_fp8(ov[0][0], ov[0][1], ov[0][2], ov[0][3]); pkv[ai][m].y = pk4_fp8(ov[1][0], ov[1][1], ov[1][2], ov[1][3]); }
#pragma unroll
        for (int ai = 0; ai < 2; ++ai)
#pragma unroll
            for (int mp = 0; mp < 2; ++mp) { if (ai >= nai) continue; const int r = (ai * 128 + wr * 64 + (2 * mp + (fq & 1)) * 16 + fr) ^ rx;
                *(u32x4*)(H + (size_t)(u.pm * 256 + r) * (2 * FF) + hcol - ((fq & 1) ? 8 : 0)) = widen8(pkv[ai][2 * mp], pkv[ai][2 * mp + 1]); }
    }
};
template <bool OUT_F32> struct EpiDown {
    static constexpr bool HAS_PRE = false; struct Pre {}; __device__ __forceinline__ Pre pre_load(const pg8::Unit&) const { return Pre{}; } __device__ __forceinline__ void pre_store(const Pre&, LAS unsigned char*) const {}
    const LAS unsigned* rowtab; const bf16_t* hin; void* out; LAS int* ud;
    __device__ __forceinline__ void operator()(const f32x4 (&acc)[2][2][4][2], const pg8::Unit& u, int wr, int wc, int fr_, int fq, LAS unsigned char*) const {
        int fr = fr_;
        const int nv = rfl(ud[u.j * 8 + 4]);
        const int col0 = u.pn * 256 + wc * 32 + 8 * fq;
        const int rx = u.h == 2 ? 128 : 0, nai = u.h ? 1 : 2;
        asm volatile("" : "+v"(fr));
        int tok[2][4];
#pragma unroll
        for (int ai = 0; ai < 2; ++ai)
#pragma unroll
            for (int m = 0; m < 4; ++m) { const int r = (ai * 128 + wr * 64 + m * 16 + fr) ^ rx; tok[ai][m] = (int)(rowtab[u.j * 256 + r] >> 11); }
#pragma unroll
        for (int ai = 0; ai < 2; ++ai) if (ai < nai) {
            u32x4 hv[4][2];
#pragma unroll
            for (int m = 0; m < 4; ++m) { const size_t ro = (size_t)tok[ai][m] * DM + col0;
#pragma unroll
                for (int bj = 0; bj < 2; ++bj) hv[m][bj] = *(const u32x4*)(hin + ro + bj * 128); }
            asm volatile("" ::: "memory");
#pragma unroll
            for (int m = 0; m < 4; ++m) { const int r = (ai * 128 + wr * 64 + m * 16 + fr) ^ rx; const size_t ro = (size_t)tok[ai][m] * DM + col0;
                if (r < nv) {
#pragma unroll
                    for (int bj = 0; bj < 2; ++bj) { const u32x4 h4 = hv[m][bj];
                        const f32x4 v0 = acc[ai][bj][m][0] * (1.0f / 256.0f) + (f32x4){bflo(h4.x), bfhi(h4.x), bflo(h4.y), bfhi(h4.y)}, v1 = acc[ai][bj][m][1] * (1.0f / 256.0f) + (f32x4){bflo(h4.z), bfhi(h4.z), bflo(h4.w), bfhi(h4.w)};
                        if (OUT_F32) { float* o = (float*)out + ro + bj * 128; __builtin_nontemporal_store(v0, (f32x4*)o); __builtin_nontemporal_store(v1, (f32x4*)(o + 4)); }
                        else { u32x4 w; w.x = cvt_pk_bf16(v0[0], v0[1]); w.y = cvt_pk_bf16(v0[2], v0[3]); w.z = cvt_pk_bf16(v1[0], v1[1]); w.w = cvt_pk_bf16(v1[2], v1[3]); *(u32x4*)((bf16_t*)out + ro + bj * 128) = w; } } } }
            asm volatile("" ::: "memory"); }
    }
};


typedef __bf16 bf2_t __attribute__((ext_vector_type(2)));
typedef unsigned short us2_t __attribute__((ext_vector_type(2)));
__device__ __forceinline__ float wave_max(float v) {
    v = fmaxf(v, dpp_f<0xB1>(v)); v = fmaxf(v, dpp_f<0x4E>(v)); v = fmaxf(v, dpp_f<0x141>(v)); v = fmaxf(v, dpp_f<0x140>(v));
    return max_xor32(max_xor16(v));
}
__device__ __forceinline__ void rowpass_phase(Frame& F, const bf16_t* h, float* rstd, float* rscale, unsigned char* a8) {
    const int gw = F.vcu * NWAVES + F.wave, NGW = F.G * NWAVES;
    constexpr int RB = 4;
    for (int row0 = gw * RB; row0 < T; row0 += NGW * RB) {
        u32x4 v[RB][4];
#pragma unroll
        for (int q = 0; q < RB; ++q) { const u32x4* p = (const u32x4*)(h + (size_t)(row0 + q) * DM) + F.lane;
#pragma unroll
            for (int j = 0; j < 4; ++j) v[q][j] = p[64 * j]; }
#pragma unroll
        for (int q = 0; q < RB; ++q) { float ss = 0.f, am = 0.f;
            us2_t mx = (us2_t){0, 0};
#pragma unroll
            for (int j = 0; j < 4; ++j) {
#pragma unroll
                for (int e = 0; e < 4; ++e) { const unsigned w = v[q][j][e]; ss = __builtin_amdgcn_fdot2_f32_bf16(__builtin_bit_cast(bf2_t, w), __builtin_bit_cast(bf2_t, w), ss, false);
                    mx = __builtin_elementwise_max(mx, __builtin_bit_cast(us2_t, w & 0x7fff7fffu)); } }
            { const unsigned mw = __builtin_bit_cast(unsigned, mx); am = fmaxf(bflo(mw), bfhi(mw)); }
            ss = wave_sum(ss); am = wave_max(am);
            const float qs = am > 0.f ? 127.0f / am : 0.f; const int row = row0 + q;
            if (F.lane == 0) { rstd[row] = 1.0f / sqrtf(ss * (1.0f / DM) + EPS); rscale[row] = am * (1.0f / 127.0f); }
            u32x2* o = (u32x2*)(a8 + (size_t)row * DM) + F.lane;
#pragma unroll
            for (int j = 0; j < 4; ++j) { u32x2 w; w.x = pk4_i8(bflo(v[q][j].x) * qs, bfhi(v[q][j].x) * qs, bflo(v[q][j].y) * qs, bfhi(v[q][j].y) * qs); w.y = pk4_i8(bflo(v[q][j].z) * qs, bfhi(v[q][j].z) * qs, bflo(v[q][j].w) * qs, bfhi(v[q][j].w) * qs); o[64 * j] = w; } }
    }
}

struct EpiRes {
    static constexpr bool HAS_PRE = false; struct Pre {}; __device__ __forceinline__ Pre pre_load(const pg8::Unit&) const { return Pre{}; } __device__ __forceinline__ void pre_store(const Pre&, LAS unsigned char*) const {}
    const bf16_t* hin; bf16_t* out; unsigned char* out8; const float* cscale; float os;
    __device__ __forceinline__ void operator()(const f32x4 (&acc)[2][2][4][2], const pg8::Unit& u, int wr, int wc, int fr, int fq, LAS unsigned char*) const {
        const int row0 = u.pm * 256 + wr * 64 + fr, col0 = u.pn * 256 + wc * 32 + 8 * fq;
        f32x4 cs[2][2];
#pragma unroll
        for (int bj = 0; bj < 2; ++bj) { cs[bj][0] = *(const f32x4*)(cscale + col0 + bj * 128) * os; cs[bj][1] = *(const f32x4*)(cscale + col0 + bj * 128 + 4) * os; }
#pragma unroll
        for (int ai = 0; ai < 2; ++ai) {
            u32x4 hv[4][2]; u32x2 w8[4][2];
#pragma unroll
            for (int m = 0; m < 4; ++m) { const size_t ro = (size_t)(row0 + ai * 128 + m * 16) * DM + col0;
#pragma unroll
                for (int bj = 0; bj < 2; ++bj) hv[m][bj] = *(const u32x4*)(hin + ro + bj * 128); }
            asm volatile("" ::: "memory");
#pragma unroll
            for (int m = 0; m < 4; ++m) { const size_t ro = (size_t)(row0 + ai * 128 + m * 16) * DM + col0;
#pragma unroll
                for (int bj = 0; bj < 2; ++bj) { const u32x4 h4 = hv[m][bj];
                    const f32x4 a0 = __builtin_convertvector(__builtin_bit_cast(pg8::v4i_t, acc[ai][bj][m][0]), f32x4), a1 = __builtin_convertvector(__builtin_bit_cast(pg8::v4i_t, acc[ai][bj][m][1]), f32x4);
                    const f32x4 v0 = a0 * cs[bj][0] + (f32x4){bflo(h4.x), bfhi(h4.x), bflo(h4.y), bfhi(h4.y)}, v1 = a1 * cs[bj][1] + (f32x4){bflo(h4.z), bfhi(h4.z), bflo(h4.w), bfhi(h4.w)};
                    u32x4 w; w.x = cvt_pk_bf16(v0[0], v0[1]); w.y = cvt_pk_bf16(v0[2], v0[3]); w.z = cvt_pk_bf16(v1[0], v1[1]); w.w = cvt_pk_bf16(v1[2], v1[3]);
                    *(u32x4*)(out + ro + bj * 128) = w;
                    w8[m][bj].x = pk4_fp8(v0[0], v0[1], v0[2], v0[3]); w8[m][bj].y = pk4_fp8(v1[0], v1[1], v1[2], v1[3]); } }
#pragma unroll
            for (int mp = 0; mp < 2; ++mp) { const size_t roq = (size_t)(row0 + ai * 128 + (mp * 2 + (fq & 1)) * 16) * DM + col0 - ((fq & 1) ? 8 : 0);
#pragma unroll
                for (int bj = 0; bj < 2; ++bj) *(u32x4*)(out8 + roq + bj * 128) = widen8(w8[2 * mp][bj], w8[2 * mp + 1][bj]); }
            asm volatile("" ::: "memory"); }
    }
};


constexpr float QSCALE = 0.08838834764831845f * 1.4426950408889634f;
struct EpiQKV {
    const float* rstd; const float* rscale; const float* cscale; const float* qn; const float* kn; bf16_t* q; unsigned* vmaxw;
    static constexpr bool HAS_PRE = false; struct Pre {}; __device__ __forceinline__ Pre pre_load(const pg8::Unit&) const { return Pre{}; } __device__ __forceinline__ void pre_store(const Pre&, LAS unsigned char*) const {}
    __device__ __forceinline__ void operator()(const f32x4 (&acc)[2][2][4][2], const pg8::Unit& u, int wr, int wc, int fr_, int fq_, LAS unsigned char* lds) const {
        int fr = fr_, fq = fq_; asm volatile("" : "+v"(fr), "+v"(fq));
        const int which = u.pn >> 3, colt = (u.pn & 7) * 256;
        bf16_t* dst = q + (size_t)which * ((WS_K - WS_Q) / 2);
        const int col0 = colt + wc * 32 + 8 * fq;
        LAS float* EX = (LAS float*)(lds + EX_OFF);
        const bool normed = which != 2;
        float rsv[2][4];
#pragma unroll
        for (int ai = 0; ai < 2; ++ai)
#pragma unroll
            for (int m = 0; m < 4; ++m) { const int gr = u.pm * 256 + ai * 128 + wr * 64 + m * 16 + fr; rsv[ai][m] = rstd[gr] * rscale[gr]; }
        f32x4 cs[2][2];
#pragma unroll
        for (int bj = 0; bj < 2; ++bj) { cs[bj][0] = *(const f32x4*)(cscale + u.pn * 256 + wc * 32 + 8 * fq + bj * 128); cs[bj][1] = *(const f32x4*)(cscale + u.pn * 256 + wc * 32 + 8 * fq + bj * 128 + 4); }
        f32x4 g0 = (f32x4){1.f, 1.f, 1.f, 1.f}, g1 = g0;
        if (which == 0) { g0 = *(const f32x4*)(qn + wc * 32 + 8 * fq) * QSCALE; g1 = *(const f32x4*)(qn + wc * 32 + 8 * fq + 4) * QSCALE; }
        if (which == 1) { g0 = *(const f32x4*)(kn + wc * 32 + 8 * fq); g1 = *(const f32x4*)(kn + wc * 32 + 8 * fq + 4); }
#define QKV_CVT(ai, bj, m, n) __builtin_convertvector(__builtin_bit_cast(pg8::v4i_t, acc[ai][bj][m][n]), f32x4)
        f32x4 (&A)[2][2][4][2] = const_cast<f32x4 (&)[2][2][4][2]>(acc);
#pragma unroll
        for (int ai = 0; ai < 2; ++ai)
#pragma unroll
            for (int m = 0; m < 4; ++m)
#pragma unroll
                for (int bj = 0; bj < 2; ++bj) { const f32x4 c0 = QKV_CVT(ai, bj, m, 0) * cs[bj][0], c1 = QKV_CVT(ai, bj, m, 1) * cs[bj][1]; A[ai][bj][m][0] = c0; A[ai][bj][m][1] = c1; }
        if (normed) {
#pragma unroll
            for (int ai = 0; ai < 2; ++ai)
#pragma unroll
                for (int m = 0; m < 4; ++m)
#pragma unroll
                    for (int bj = 0; bj < 2; ++bj) { const f32x4 v0 = A[ai][bj][m][0], v1 = A[ai][bj][m][1];
                        const f32x4 sq = v0 * v0 + v1 * v1; float s = (sq[0] + sq[1]) + (sq[2] + sq[3]);
                        s = add_xor32(add_xor16(s));
                        if (fq == 0) EX[((ai * 128 + wr * 64 + m * 16 + fr) * 2 + bj) * 4 + wc] = s; }
            asm volatile("s_waitcnt lgkmcnt(0)" ::: "memory"); __builtin_amdgcn_s_barrier(); asm volatile("" ::: "memory");
        }
#pragma unroll
        for (int bj = 0; bj < 2; ++bj) { cs[bj][0] = g0; cs[bj][1] = g1; }
        float vmx = 0.f;
#define QKV_PASS2(NORMED) _Pragma("unroll") for (int ai = 0; ai < 2; ++ai) _Pragma("unroll") for (int m = 0; m < 4; ++m) { const int r = ai * 128 + wr * 64 + m * 16 + fr; const size_t ro = (size_t)(u.pm * 256 + r) * DM + col0; \
                const float rs = rsv[ai][m]; \
                _Pragma("unroll") for (int bj = 0; bj < 2; ++bj) { float f = rs; \
                    if (NORMED) { const f32x4 pp = *(const LAS f32x4*)(EX + (r * 2 + bj) * 4); const float tot = ((pp[0] + pp[1]) + (pp[2] + pp[3])) * rs * rs; f = rs * __builtin_amdgcn_rsqf(tot * (1.0f / HD) + EPS); } \
                    const f32x4 v0 = A[ai][bj][m][0] * (cs[bj][0] * f), v1 = A[ai][bj][m][1] * (cs[bj][1] * f); \
                    if (!(NORMED)) { const f32x4 a0 = __builtin_elementwise_abs(v0), a1 = __builtin_elementwise_abs(v1); const f32x4 mx = __builtin_elementwise_max(a0, a1); vmx = fmaxf(vmx, fmaxf(fmaxf(mx[0], mx[1]), fmaxf(mx[2], mx[3]))); } \
                    u32x4 w; w.x = cvt_pk_bf16(v0[0], v0[1]); w.y = cvt_pk_bf16(v0[2], v0[3]); w.z = cvt_pk_bf16(v1[0], v1[1]); w.w = cvt_pk_bf16(v1[2], v1[3]); \
                    __builtin_nontemporal_store(w, (u32x4*)(dst + ro + bj * 128)); } }
        if (normed) { QKV_PASS2(true) } else { QKV_PASS2(false) }
#undef QKV_PASS2
#undef QKV_CVT
        if (!normed) { vmx = wave_max(vmx); if ((threadIdx.x & 63) == 0) __hip_atomic_fetch_max(vmaxw, __float_as_uint(vmx), __ATOMIC_RELAXED, __HIP_MEMORY_SCOPE_AGENT); }
    }
};


typedef short v4i16_t __attribute__((ext_vector_type(4)));
__device__ __forceinline__ s16x4 vtr(const LAS char* p) { return __builtin_bit_cast(s16x4, __builtin_amdgcn_ds_read_tr16_b64_v4i16((LAS v4i16_t*)p)); }
__device__ __forceinline__ unsigned lds_addr(const LAS void* p) { return (unsigned)(unsigned long long)p; }
__device__ __forceinline__ bf16x8 lds_rd128(unsigned a) { bf16x8 v; asm volatile("ds_read_b128 %0, %1" : "=v"(v) : "v"(a) : "memory"); return v; }
__device__ __forceinline__ s16x4 lds_rdtr64(unsigned a) { s16x4 v; asm volatile("ds_read_b64_tr_b16 %0, %1" : "=v"(v) : "v"(a) : "memory"); return v; }
__device__ __forceinline__ void lds_wr32(unsigned a, unsigned v) { asm volatile("ds_write_b32 %0, %1" :: "v"(a), "v"(v) : "memory"); }
__device__ __forceinline__ void attn_phase(Frame& F, const bf16_t* Q, const bf16_t* K, const bf16_t* V, unsigned char* O, const unsigned* vmaxw) {
    const int lane = F.lane, wid = F.wave, tid = F.tid, r32 = lane & 31, hi = lane >> 5;
    LAS char* lds = (LAS char*)F.lds;
    const float vmaxf = __uint_as_float(__hip_atomic_load(vmaxw, __ATOMIC_RELAXED, __HIP_MEMORY_SCOPE_AGENT)); const float oqs = vmaxf > 0.f ? 127.0f / vmaxf : 0.f;
    LAS unsigned* dflag = (LAS unsigned*)(F.lds + MISC_OFF + 64);
    unsigned ksrc, vsrc;
    { const int row = tid >> 4, cp = tid & 15; const int X = ((row & 3) << 2) | ((row >> 2) & 3);
      ksrc = (unsigned)(row * (DM * 2) + ((cp ^ X) * 16)); vsrc = (unsigned)(row * (DM * 2) + ((cp ^ ((row & 3) << 2)) * 16)); }
    const int Xr = ((r32 & 3) << 2) | ((r32 >> 2) & 3);
    const int kbase = 256 * r32 + 16 * (hi ^ Xr);
    const int g4 = lane >> 4, qq = (lane & 15) >> 2, pp = lane & 3;
    int vb[4];
#pragma unroll
    for (int db = 0; db < 4; ++db) vb[db] = 256 * (4 * (g4 >> 1) + qq) + 64 * (db ^ qq) + 32 * (g4 & 1) + 16 * (pp >> 1) + 8 * (pp & 1);
#define AT_STAGE(j) do { const int _j = (j); const char* _kt = kg + (size_t)_j * 32 * (DM * 2); const char* _vt = vg + (size_t)_j * 32 * (DM * 2); LAS char* _d = lds + (_j % 9) * 16384 + wid * 1024; \
        __builtin_amdgcn_global_load_lds((const unsigned*)(_kt + ksrc), (LAS unsigned*)(_d), 16, 0, 0); \
        __builtin_amdgcn_global_load_lds((const unsigned*)(_vt + vsrc), (LAS unsigned*)(_d + 8192), 16, 0, 0); } while (0)
#define AT_UNIT(idx_) do {   \
        const int _i = (idx_); qb = _i & 7; h = (_i >> 3) & 15; b = (BATCH - 1) - (_i >> 7); rowbase = (size_t)b * SEQ; t0w = qb * 256 + wid * 32; \
        kg = (const char*)(K + rowbase * DM + h * HD); vg = (const char*)(V + rowbase * DM + h * HD); } while (0)
#define AT_LOADQ() do { const bf16_t* _qp = Q + (rowbase + t0w + r32) * DM + h * HD + 8 * hi; _Pragma("unroll") for (int s = 0; s < 8; ++s) qf[s] = *(const bf16x8*)(_qp + 16 * s); } while (0)
    constexpr int NUNITS = BATCH * NH * (SEQ / 256);
    int it = 0, idx = F.vcu;
    if (idx >= REP_ATTN * NUNITS) return;
    int qb, b, h, t0w; size_t rowbase; const char* kg; const char* vg;
    bf16x8 qf[8];
    AT_UNIT(idx % NUNITS);
    __builtin_amdgcn_s_barrier();
#pragma unroll 1
    for (int w = 0; w < 8; ++w) AT_STAGE(8 * qb + w);
    AT_LOADQ();
    bool first = true;
    for (;;) {
        const int t = t0w + r32;
        f32x16 o[4];
#pragma unroll
        for (int db = 0; db < 4; ++db)
#pragma unroll
            for (int r = 0; r < 16; ++r) o[db][r] = 0.f;
        float C = 1.0f; bool wdone = false;
        for (int n = 0;; ++n) {
            const int j = 8 * qb + wid - n;
            if (n == 0 && !first) asm volatile("s_waitcnt vmcnt(4)" ::: "memory"); else asm volatile("s_waitcnt vmcnt(0)" ::: "memory");
            __builtin_amdgcn_s_barrier(); asm volatile("" ::: "memory");
            if (n > 0) { const LAS unsigned* df = dflag + ((n - 1) & 1) * 8; const u32x4 f0 = *(const LAS u32x4*)df, f1 = *(const LAS u32x4*)(df + 4);
                if ((f0.x & f0.y & f0.z & f0.w & f1.x & f1.y & f1.z & f1.w) != 0u) break; }
            asm volatile("" : "+v"(qf[0]), "+v"(qf[1]), "+v"(qf[2]), "+v"(qf[3]), "+v"(qf[4]), "+v"(qf[5]), "+v"(qf[6]), "+v"(qf[7]));
            if (8 * qb - n - 1 >= 0) AT_STAGE(8 * qb - n - 1);
            if (j >= 0 && !wdone) {
                const unsigned kba = lds_addr(lds + (j % 9) * 16384);
                bf16x8 kf[8];
                f32x16 p;
#pragma unroll
                for (int r = 0; r < 16; ++r) p[r] = 0.f;
#pragma unroll
                for (int s = 0; s < 8; ++s) kf[s] = lds_rd128(kba + (unsigned)(kbase ^ (32 * s)));
                asm volatile("s_waitcnt lgkmcnt(4)" : "+v"(kf[0]), "+v"(kf[1]), "+v"(kf[2]), "+v"(kf[3]) :: "memory");
#pragma unroll
                for (int s = 0; s < 4; ++s) p = __builtin_amdgcn_mfma_f32_32x32x16_bf16(kf[s], qf[s], p, 0, 0, 0);
                asm volatile("s_waitcnt lgkmcnt(0)" : "+v"(kf[4]), "+v"(kf[5]), "+v"(kf[6]), "+v"(kf[7]) :: "memory");
#pragma unroll
                for (int s = 4; s < 8; ++s) p = __builtin_amdgcn_mfma_f32_32x32x16_bf16(kf[s], qf[s], p, 0, 0, 0);
                s16x4 vt[2][4][2];
#pragma unroll
                for (int db = 0; db < 4; ++db) { vt[0][db][0] = lds_rdtr64(kba + 8192u + (unsigned)(vb[db])); vt[0][db][1] = lds_rdtr64(kba + 8192u + (unsigned)(vb[db] + 256 * 8)); }
                const bool needmask = (32 * j + 31 >= t0w);
                bf16x8 pf[2];
                {
                    float E[16], on[16], gt[4], pr[4], om[4];
                    const int mlim = t - 32 * j - 4 * hi;
#pragma unroll
                    for (int r = 0; r < 16; ++r) { float e = __builtin_amdgcn_exp2f(p[r]);
                        if (needmask) e = ((r & 3) + 8 * (r >> 2) < mlim) ? e : 0.f;
                        E[r] = e; }
#pragma unroll
                    for (int a = 0; a < 4; ++a) {
#pragma unroll
                        for (int bb = 0; bb < 4; ++bb) on[4 * a + bb] = 1.0f + E[4 * a + bb];
                        gt[a] = ((on[4 * a + 3] * on[4 * a + 2]) * on[4 * a + 1]) * on[4 * a]; }
#pragma unroll
                    for (int a = 0; a < 4; ++a) { auto rr = __builtin_amdgcn_permlane32_swap(__float_as_uint(gt[a]), __float_as_uint(gt[a]), false, false);
                        const float x0 = __uint_as_float(rr[0]), x1 = __uint_as_float(rr[1]); pr[a] = x0 * x1; om[a] = hi ? 1.0f : x1; }
                    float R[4]; R[3] = C; R[2] = R[3] * pr[3]; R[1] = R[2] * pr[2]; R[0] = R[1] * pr[1]; C = R[0] * pr[0];
                    float A[16];
#pragma unroll
                    for (int a = 0; a < 4; ++a) { const float ap = R[a] * om[a];
                        const float i0 = __builtin_amdgcn_rcpf(gt[a] * ap), i1 = i0 * on[4 * a], i2 = i1 * on[4 * a + 1], i3 = i2 * on[4 * a + 2];
                        A[4 * a] = E[4 * a] * i0; A[4 * a + 1] = E[4 * a + 1] * i1; A[4 * a + 2] = E[4 * a + 2] * i2; A[4 * a + 3] = E[4 * a + 3] * i3; }
#pragma unroll
                    for (int s2 = 0; s2 < 2; ++s2) { u32x4 w; w.x = cvt_pk_bf16(A[8 * s2 + 0], A[8 * s2 + 1]); w.y = cvt_pk_bf16(A[8 * s2 + 2], A[8 * s2 + 3]); w.z = cvt_pk_bf16(A[8 * s2 + 4], A[8 * s2 + 5]); w.w = cvt_pk_bf16(A[8 * s2 + 6], A[8 * s2 + 7]);
                        pf[s2] = __builtin_bit_cast(bf16x8, w); }
                }
                asm volatile("s_waitcnt lgkmcnt(0)" : "+v"(vt[0][0][0]), "+v"(vt[0][0][1]), "+v"(vt[0][1][0]), "+v"(vt[0][1][1]), "+v"(vt[0][2][0]), "+v"(vt[0][2][1]), "+v"(vt[0][3][0]), "+v"(vt[0][3][1]) :: "memory");
#pragma unroll
                for (int db = 0; db < 4; ++db) { vt[1][db][0] = lds_rdtr64(kba + 8192u + (unsigned)(vb[db] + 256 * 16)); vt[1][db][1] = lds_rdtr64(kba + 8192u + (unsigned)(vb[db] + 256 * 24)); }
#pragma unroll
                for (int db = 0; db < 4; ++db) { const bf16x8 vf = __builtin_shufflevector(vt[0][db][0], vt[0][db][1], 0, 1, 2, 3, 4, 5, 6, 7); o[db] = __builtin_amdgcn_mfma_f32_32x32x16_bf16(vf, pf[0], o[db], 0, 0, 0); }
                asm volatile("s_waitcnt lgkmcnt(0)" : "+v"(vt[1][0][0]), "+v"(vt[1][0][1]), "+v"(vt[1][1][0]), "+v"(vt[1][1][1]), "+v"(vt[1][2][0]), "+v"(vt[1][2][1]), "+v"(vt[1][3][0]), "+v"(vt[1][3][1]) :: "memory");
#pragma unroll
                for (int db = 0; db < 4; ++db) { const bf16x8 vf = __builtin_shufflevector(vt[1][db][0], vt[1][db][1], 0, 1, 2, 3, 4, 5, 6, 7); o[db] = __builtin_amdgcn_mfma_f32_32x32x16_bf16(vf, pf[1], o[db], 0, 0, 0); }
            }
            wdone = (j <= 0) || __all(C >= 4294967296.0f);
            { const unsigned wd = wdone ? 1u : 0u; if (lane == 0) lds_wr32(lds_addr((const LAS void*)(dflag + (n & 1) * 8 + wid)), wd); }
            asm volatile("s_waitcnt lgkmcnt(0)" ::: "memory");
        }
        const size_t orow = (rowbase + t0w) * DM + h * HD;
        ++it; idx = it * F.G + F.vcu;
        const bool has_next = idx < REP_ATTN * NUNITS;
        int pslot = 8;
        if (has_next) { AT_UNIT(idx % NUNITS);
#pragma unroll 1
            for (int w = 0; w < 8; ++w) AT_STAGE(8 * qb + w);
            AT_LOADQ(); pslot = (8 * qb + 8) % 9; }
        { LAS char* st = lds + pslot * 16384 + wid * 2048;
#pragma unroll
          for (int ps = 0; ps < 2; ++ps) {
#pragma unroll
              for (int dd = 0; dd < 2; ++dd) { const int db = 2 * ps + dd;
#pragma unroll
                  for (int a = 0; a < 4; ++a) *(LAS unsigned*)(st + r32 * 64 + ((32 * dd + 8 * a + 4 * hi) ^ ((r32 & 3) << 4))) = pk4_i8(o[db][4 * a] * oqs, o[db][4 * a + 1] * oqs, o[db][4 * a + 2] * oqs, o[db][4 * a + 3] * oqs); }
              asm volatile("s_waitcnt lgkmcnt(0)" ::: "memory");
#pragma unroll
              for (int k2 = 0; k2 < 2; ++k2) { const int row = 16 * k2 + (lane >> 2), ch = lane & 3;
                  const u32x4 v = *(const LAS u32x4*)(st + row * 64 + ((16 * ch) ^ ((row & 3) << 4)));
                  *(u32x4*)(O + orow + (size_t)row * DM + 64 * ps + 16 * ch) = v; }
              asm volatile("s_waitcnt lgkmcnt(0)" ::: "memory"); } }
        if (!has_next) break;
        first = false;
    }
#undef AT_STAGE
#undef AT_UNIT
#undef AT_LOADQ
    asm volatile("s_waitcnt vmcnt(0)" ::: "memory"); __builtin_amdgcn_s_barrier();
}

__device__ __forceinline__ void dump_bf16(Frame& F, const bf16_t* src, float* out) {
    const size_t n8 = (size_t)T * DM / 8;
    for (size_t i = (size_t)F.vcu * NTHR + F.tid; i < n8; i += (size_t)F.G * NTHR) {
        const u32x4 v = *(const u32x4*)(src + i * 8);
        f32x4 a = (f32x4){bflo(v.x), bfhi(v.x), bflo(v.y), bfhi(v.y)}, b = (f32x4){bflo(v.z), bfhi(v.z), bflo(v.w), bfhi(v.w)};
        *(f32x4*)(out + i * 8) = a; *(f32x4*)(out + i * 8 + 4) = b;
    }
}

constexpr int N_PHASES = 13;
__global__ void __launch_bounds__(NTHR, 2) fwd(Args args) {
    extern __shared__ __attribute__((aligned(16))) unsigned char lds_raw[];
    Frame F;
    F.lds = (LAS unsigned char*)lds_raw;
    F.tid = threadIdx.x; F.lane = F.tid & 63; F.wave = __builtin_amdgcn_readfirstlane(F.tid >> 6);
    F.G = gridDim.x; { const int bx = blockIdx.x; F.vcu = (F.G % 8 == 0) ? (bx % 8) * (F.G / 8) + bx / 8 : bx; }
    volatile LAS unsigned* MISC = (volatile LAS unsigned*)(F.lds + MISC_OFF);
    if (F.tid < 64) MISC[F.tid] = 0u;
    __syncthreads();
    unsigned* ctl = (unsigned*)(args.ws + WS_CTL);
    XcdBarrier bar; bar.bar = ctl + CW_BAR; bar.x = 0; bar.st = nullptr;
    if (N_LAUNCH_MODE == 1) bar = xcd_barrier_post(ctl + CW_BAR, MISC + 8);
    const int lo = args.ph_lo, hi = args.ph_hi;
#define IN(k) (lo <= (k) && (k) < hi)
#define SEAM(k) do { if (N_LAUNCH_MODE == 1 && IN(k) && IN((k) + 1)) xcd_barrier(bar); } while (0)
    bf16_t* pooled = (bf16_t*)(args.ws + WS_Q);
    bf16_t* h1 = (bf16_t*)(args.ws + WS_K);
    bf16_t* h2 = (bf16_t*)(args.ws + WS_HB);
    bf16_t* h3 = (bf16_t*)(args.ws + WS_HC);

    if (IN(0)) for (int rep = 0; rep < REP_P0; ++rep) { p0_weights(args, F); p0_pool(args, F, pooled); }
    SEAM(0);
    if (IN(1)) {
        SchedPlain S{(const char*)pooled, (const char*)(args.ws + WS_WPOOL), DM * 2, PGC * 2, T / 256, 8, F.G, F.vcu, 1, REP_POOLG};
        EpiPool E{args.x, h1, args.ws + WS_X8};
        pg8::gemm_phase<EpiPool, SchedPlain>(F.lds, PGC, S, E);
    }
    SEAM(1);
    if (IN(2)) router_phase(args, F, h1, 0);
    SEAM(2);
    if (IN(3)) {
        moe_build(args, F, 0, 1);
        SchedMoe S{(const char*)(args.ws + WS_X8), (const char*)(args.ws + WS_WGU), DM, (LAS int*)(F.lds + UDESC_OFF), (LAS unsigned*)(F.lds + ROWTAB_OFF), 0, 0};
        EpiSwiGLU E{(const f32x4*)(args.ws + WS_META), args.ws + WS_HMOE, (LAS int*)(F.lds + UDESC_OFF)};
        pg8::gemm_phase<EpiSwiGLU, SchedMoe, 1>(F.lds, DM, S, E);
        { SchedMoe S2 = S; S2.halfpass = 1; pg8::gemm_phase<EpiSwiGLU, SchedMoe, 1, 1, true>(F.lds, DM, S2, E); }
        __syncthreads(); { const FillPlan fp = fill_plan(moe_units_l0(args), F.G, F.vcu); fill_range<false>(args, F, fp, 0, fp.gu3);
            if (fp.rank >= 0) { __syncthreads(); if (fp.rank < fp.st3) do_strip(args, F, fp.rank); } }
    }
    SEAM(3);
    if (IN(4)) {
        SchedMoe S{(const char*)(args.ws + WS_HMOE), (const char*)(args.ws + WS_WD), FF, (LAS int*)(F.lds + UDESC_OFF), (LAS unsigned*)(F.lds + ROWTAB_OFF), 0, 1};
        EpiDown<false> E{(const LAS unsigned*)(F.lds + ROWTAB_OFF), h1, (void*)h2, (LAS int*)(F.lds + UDESC_OFF)};
        pg8::gemm_phase<EpiDown<false>, SchedMoe, 1>(F.lds, 2 * FF, S, E);
        { SchedMoe S2 = S; S2.halfpass = 1; pg8::gemm_phase<EpiDown<false>, SchedMoe, 1, 1, true>(F.lds, 2 * FF, S2, E); }
        __syncthreads(); { const FillPlan fp = fill_plan(moe_units_l0(args), F.G, F.vcu); fill_range<false>(args, F, fp, fp.gu3, fp.gu4); fill_range<true>(args, F, fp, 0, fp.dn4);
            if (fp.rank >= 0) { __syncthreads(); for (int st = fp.st3 + fp.rank; st < fp.st4; st += fp.nidle) do_strip(args, F, st); } }
    }
    SEAM(4);
#if STOP_AFTER == 1
    if (IN(12)) dump_bf16(F, h1, args.out);
#endif
#if STOP_AFTER == 2
    if (IN(12)) dump_bf16(F, h2, args.out);
#endif
#if STOP_AFTER >= 3
    bf16_t* qb_ = (bf16_t*)(args.ws + WS_Q); bf16_t* kb_ = (bf16_t*)(args.ws + WS_K); bf16_t* vb_ = (bf16_t*)(args.ws + WS_V);
    unsigned char* ob_ = (unsigned char*)args.out;
    float* rstd2 = (float*)(args.ws + WS_RSTD); float* rscale2 = (float*)(args.ws + WS_RSCALE);
    unsigned* vmaxw = (unsigned*)(args.ws + WS_CTL) + CW_VMAX;
    if (IN(5)) { rowpass_phase(F, h2, rstd2, rscale2, args.ws + WS_A8); const FillPlan fp = fill_plan(moe_units_l0(args), F.G, F.vcu); fill_tail<false>(args, F, fp.gu4); fill_tail<true>(args, F, fp.dn4);
        __syncthreads(); for (int st = fp.st4 + F.vcu; st < N_STRIPS; st += F.G) do_strip(args, F, st); }
    SEAM(5);
    if (IN(6)) {
        SchedPlain S{(const char*)(args.ws + WS_A8), (const char*)(args.ws + WS_WQKV), DM, DM, T / 256, 24, F.G, F.vcu, 0, REP_QKV};
        EpiQKV E{rstd2, rscale2, (const float*)(args.ws + WS_CSQKV), args.q_norm, args.k_norm, qb_, vmaxw};
        pg8::gemm_phase<EpiQKV, SchedPlain, 2, KREP_QKV>(F.lds, DM, S, E);
    }
    SEAM(6);
    if (IN(7)) attn_phase(F, qb_, kb_, vb_, ob_, vmaxw);
    SEAM(7);
    if (IN(8)) {
        SchedPlain S{(const char*)ob_, (const char*)(args.ws + WS_WO), DM, DM, T / 256, 8, F.G, F.vcu, 0, REP_WO};
        EpiRes E{h2, h3, args.ws + WS_X8, (const float*)(args.ws + WS_CSWO), __uint_as_float(__hip_atomic_load(vmaxw, __ATOMIC_RELAXED, __HIP_MEMORY_SCOPE_AGENT)) * (1.0f / 127.0f)};
        pg8::gemm_phase<EpiRes, SchedPlain, 2>(F.lds, DM, S, E);
    }
    SEAM(8);
#endif
#if STOP_AFTER == 3
    if (IN(12)) dump_bf16(F, h3, args.out);
#endif
#if STOP_AFTER >= 4
    if (IN(9)) router_phase(args, F, h3, 1);
    SEAM(9);
    if (IN(10)) {
        moe_build(args, F, 1, 1);
        SchedMoe S{(const char*)(args.ws + WS_X8), (const char*)(args.ws + WS_WGU), DM, (LAS int*)(F.lds + UDESC_OFF), (LAS unsigned*)(F.lds + ROWTAB_OFF), 1, 0};
        EpiSwiGLU E{(const f32x4*)(args.ws + WS_META), args.ws + WS_HMOE, (LAS int*)(F.lds + UDESC_OFF)};
        pg8::gemm_phase<EpiSwiGLU, SchedMoe, 1>(F.lds, DM, S, E);
        { SchedMoe S2 = S; S2.halfpass = 1; pg8::gemm_phase<EpiSwiGLU, SchedMoe, 1, 1, true>(F.lds, DM, S2, E); }
    }
    SEAM(10);
    if (IN(11)) {
        SchedMoe S{(const char*)(args.ws + WS_HMOE), (const char*)(args.ws + WS_WD), FF, (LAS int*)(F.lds + UDESC_OFF), (LAS unsigned*)(F.lds + ROWTAB_OFF), 1, 1};
        EpiDown<true> E{(const LAS unsigned*)(F.lds + ROWTAB_OFF), h3, (void*)args.out, (LAS int*)(F.lds + UDESC_OFF)};
        pg8::gemm_phase<EpiDown<true>, SchedMoe, 1>(F.lds, 2 * FF, S, E);
        { SchedMoe S2 = S; S2.halfpass = 1; pg8::gemm_phase<EpiDown<true>, SchedMoe, 1, 1, true>(F.lds, 2 * FF, S2, E); }
    }
#endif
#undef IN
#undef SEAM
}

extern "C" void kernel_launch(void* const* d_in, const int* in_sizes, int n_in, void* d_out, int out_size, void* d_ws, size_t ws_size, hipStream_t stream) {
    static int grid = 0;
    if (grid == 0) {
        if (n_in != 18 || out_size != T * DM || ws_size < WS_END) { fprintf(stderr, "kernel_launch: unexpected sizes (n_in %d out %d ws %zu)\n", n_in, out_size, ws_size); grid = -1; return; }
        int dev = 0, cus = 0, per_cu = 0;
        if (hipGetDevice(&dev) != hipSuccess || hipDeviceGetAttribute(&cus, hipDeviceAttributeMultiprocessorCount, dev) != hipSuccess) { grid = -1; return; }
        if (hipFuncSetAttribute((const void*)fwd, hipFuncAttributeMaxDynamicSharedMemorySize, LDS_BYTES) != hipSuccess) { fprintf(stderr, "kernel_launch: hipFuncSetAttribute failed\n"); grid = -1; return; }
        if (hipOccupancyMaxActiveBlocksPerMultiprocessor(&per_cu, (const void*)fwd, NTHR, LDS_BYTES) != hipSuccess || per_cu < 1) fprintf(stderr, "kernel_launch: occupancy query says %d\n", per_cu);
        (void)hipGetLastError();
        grid = cus;
    }
    if (grid < 0) return;
    hipMemsetAsync((char*)d_ws + WS_CTL, 0, CTL_BYTES, stream);
    Args a{};
    a.x = (const float*)d_in[0]; a.norm_mix = (const float*)d_in[1]; a.norm_ffn = (const float*)d_in[2]; a.pool_w = (const float*)d_in[3]; a.pool_scale = (const float*)d_in[4];
    a.kv_norm = (const float*)d_in[5]; a.w_kv = (const float*)d_in[6]; a.k_norm = (const float*)d_in[7]; a.w_q = (const float*)d_in[8]; a.q_norm = (const float*)d_in[9]; a.w_o = (const float*)d_in[10];
    a.w_grp = (const float*)d_in[11]; a.b_grp = (const float*)d_in[12]; a.w_rt = (const float*)d_in[13]; a.b_rt = (const float*)d_in[14]; a.w_gate = (const float*)d_in[15]; a.w_up = (const float*)d_in[16]; a.w_down = (const float*)d_in[17];
    a.out = (float*)d_out; a.ws = (unsigned char*)d_ws;
    if (N_LAUNCH_MODE == 1) { a.ph_lo = 0; a.ph_hi = N_PHASES; hipLaunchKernelGGL(fwd, dim3(grid), dim3(NTHR), LDS_BYTES, stream, a); }
    else for (int p = 0; p < N_PHASES; ++p) { a.ph_lo = p; a.ph_hi = p + 1; hipLaunchKernelGGL(fwd, dim3(grid), dim3(NTHR), LDS_BYTES, stream, a); }
}
```

```cpp
#include <hip/hip_runtime.h>
#include <cstdio>
#include <cstdint>

#ifndef STOP_AFTER
#define STOP_AFTER 4
#endif
#ifndef REP_ATTN
#define REP_ATTN 1
#endif
#ifndef REP_QKV
#define REP_QKV 1
#endif
#ifndef REP_WO
#define REP_WO 1
#endif
#ifndef REP_POOLG
#define REP_POOLG 1
#endif
#ifndef KREP_QKV
#define KREP_QKV 1
#endif
#ifndef SKEW_TICKS
#define SKEW_TICKS 0
#endif
#ifndef REP_P0
#define REP_P0 1
#endif
#ifndef N_LAUNCH_MODE
#define N_LAUNCH_MODE 1
#endif

#define LAS __attribute__((address_space(3)))
#define GAS __attribute__((address_space(1)))
typedef unsigned short bf16_t;
typedef short bf16x8 __attribute__((ext_vector_type(8)));
typedef short s16x4 __attribute__((ext_vector_type(4)));
typedef float f32x2 __attribute__((ext_vector_type(2)));
typedef float f32x4 __attribute__((ext_vector_type(4)));
typedef float f32x16 __attribute__((ext_vector_type(16)));
typedef unsigned u32x2 __attribute__((ext_vector_type(2)));
typedef unsigned u32x4 __attribute__((ext_vector_type(4)));

constexpr int BATCH = 16, SEQ = 2048, DM = 2048, T = BATCH * SEQ, NH = 16, HD = 128;
constexpr int NGRP = 4, EPG = 4, NE = 16, FF = 512, NBKT = 24;
constexpr int PGC = 512;
constexpr float EPS = 1e-6f;
constexpr int MAXRT = 152;
constexpr int NWAVES = 8, NTHR = 512;

constexpr size_t MiB = 1u << 20;
constexpr size_t WS_CTL = 0, CTL_BYTES = 96 * 1024;
constexpr size_t WS_WPOOL = 1 * MiB;
constexpr size_t WS_WQKV = 3 * MiB;
constexpr size_t WS_WO = 27 * MiB;
constexpr size_t WS_WGU = 35 * MiB;
constexpr size_t WS_X8 = 99 * MiB;
constexpr size_t WS_WD = 163 * MiB;
constexpr size_t WS_WR = 227 * MiB;
constexpr size_t WS_RSTD = 228 * MiB;
constexpr size_t WS_RSCALE = WS_RSTD + 131072;
constexpr size_t WS_CSQKV = WS_RSTD + 262144;
constexpr size_t WS_CSWO = WS_RSTD + 294912;
constexpr size_t WS_LIST = 229 * MiB;
constexpr size_t WS_META = 232 * MiB;
constexpr size_t WS_HMOE = 244 * MiB;
constexpr size_t WS_HB = 320 * MiB;
constexpr size_t WS_HC = 448 * MiB;
constexpr size_t WS_Q = 576 * MiB;
constexpr size_t WS_K = 704 * MiB;
constexpr size_t WS_V = 832 * MiB;
constexpr size_t WS_A8 = 960 * MiB;
constexpr size_t WS_END = 1024 * MiB;
constexpr int CW_BAR = 4096;
constexpr int CW_VMAX = 8192;
constexpr int CW_CNT = 16384;

constexpr int RING_BYTES = 131072;
constexpr int EX_OFF = RING_BYTES;
constexpr int ROWTAB_OFF = EX_OFF + 8192;
constexpr int UDESC_OFF = ROWTAB_OFF + 8192;
constexpr int MISC_OFF = UDESC_OFF + 1024;
constexpr int LDS_BYTES = 151552;
static_assert(MISC_OFF + 256 <= LDS_BYTES, "lds map");
static_assert(WS_V - WS_K == WS_K - WS_Q, "q|k|v spacing");

__device__ __forceinline__ unsigned f2bf(float f) { unsigned u = __builtin_bit_cast(unsigned, f); return (u + 0x7fffu + ((u >> 16) & 1u)) >> 16; }
__device__ __forceinline__ unsigned pk2(float lo, float hi) { return f2bf(lo) | (f2bf(hi) << 16); }
__device__ __forceinline__ float bf2f(unsigned short b) { return __builtin_bit_cast(float, ((unsigned)b) << 16); }
__device__ __forceinline__ float bflo(unsigned w) { return __builtin_bit_cast(float, w << 16); }
__device__ __forceinline__ float bfhi(unsigned w) { return __builtin_bit_cast(float, w & 0xffff0000u); }
__device__ __forceinline__ unsigned cvt_pk_bf16(float lo, float hi) { unsigned r; asm volatile("v_cvt_pk_bf16_f32 %0, %1, %2" : "=v"(r) : "v"(lo), "v"(hi)); return r; }
__device__ __forceinline__ float add_xor16(float v) { auto r = __builtin_amdgcn_permlane16_swap(__float_as_uint(v), __float_as_uint(v), false, false); return __uint_as_float(r[0]) + __uint_as_float(r[1]); }
__device__ __forceinline__ float add_xor32(float v) { auto r = __builtin_amdgcn_permlane32_swap(__float_as_uint(v), __float_as_uint(v), false, false); return __uint_as_float(r[0]) + __uint_as_float(r[1]); }
template <int CTRL> __device__ __forceinline__ float dpp_f(float v) { return __uint_as_float((unsigned)__builtin_amdgcn_update_dpp(0, (int)__float_as_uint(v), CTRL, 0xf, 0xf, true)); }
__device__ __forceinline__ float max_xor16(float v) { auto r = __builtin_amdgcn_permlane16_swap(__float_as_uint(v), __float_as_uint(v), false, false); return fmaxf(__uint_as_float(r[0]), __uint_as_float(r[1])); }
__device__ __forceinline__ float max_xor32(float v) { auto r = __builtin_amdgcn_permlane32_swap(__float_as_uint(v), __float_as_uint(v), false, false); return fmaxf(__uint_as_float(r[0]), __uint_as_float(r[1])); }
__device__ __forceinline__ float wave_sum(float v) {
    v += dpp_f<0xB1>(v); v += dpp_f<0x4E>(v); v += dpp_f<0x141>(v); v += dpp_f<0x140>(v);
    return add_xor32(add_xor16(v));
}
__device__ __forceinline__ unsigned pk4_fp8(float a, float b, float c, float d) {
    a = __builtin_amdgcn_fmed3f(a, -448.f, 448.f); b = __builtin_amdgcn_fmed3f(b, -448.f, 448.f); c = __builtin_amdgcn_fmed3f(c, -448.f, 448.f); d = __builtin_amdgcn_fmed3f(d, -448.f, 448.f);
    int r = __builtin_amdgcn_cvt_pk_fp8_f32(a, b, 0, false); r = __builtin_amdgcn_cvt_pk_fp8_f32(c, d, r, true); return (unsigned)r; }
__device__ __forceinline__ unsigned pk4_i8(float a, float b, float c, float d) {
    const float M = 12582912.0f;
    const unsigned ta = __float_as_uint(__builtin_amdgcn_fmed3f(a, -127.f, 127.f) + M), tb = __float_as_uint(__builtin_amdgcn_fmed3f(b, -127.f, 127.f) + M);
    const unsigned tc = __float_as_uint(__builtin_amdgcn_fmed3f(c, -127.f, 127.f) + M), td = __float_as_uint(__builtin_amdgcn_fmed3f(d, -127.f, 127.f) + M);
    const unsigned p01 = __builtin_amdgcn_perm(tb, ta, 0x0c0c0400u), p23 = __builtin_amdgcn_perm(td, tc, 0x0c0c0400u);
    return __builtin_amdgcn_perm(p23, p01, 0x05040100u); }
#define LDS_WAIT() asm volatile("s_waitcnt lgkmcnt(0)" ::: "memory")
#define VM_WAIT() asm volatile("s_waitcnt vmcnt(0)" ::: "memory")

#define XB_TMO      128
#define XB_XCNT(j)  (256  + 64 * (j))
#define XB_XSUB(j)  (1280 + 64 * (j))
#define XB_XGEN(j)  (2304 + 64 * (j))
#define XB_TOP      3328
#define XB_TOPGEN   3392
#define XCD_BAR_WORDS 3456
#define XB_SPIN_CAP (1u << 18)
__device__ __forceinline__ unsigned xb_ld(unsigned* p)              { return __hip_atomic_load(p, __ATOMIC_RELAXED, __HIP_MEMORY_SCOPE_AGENT); }
__device__ __forceinline__ unsigned xb_add(unsigned* p, unsigned v) { return __hip_atomic_fetch_add(p, v, __ATOMIC_RELAXED, __HIP_MEMORY_SCOPE_AGENT); }
__device__ __forceinline__ unsigned xb_xcc_id() { return (unsigned)__builtin_amdgcn_s_getreg((3 << 11) | 20) & 0xFu; }
#define XB_SPIN(cond, bar) do { unsigned _sp = 0; while (cond) { __builtin_amdgcn_s_sleep(1); \
    if ((++_sp & 255u) == 0u) { if (xb_ld(&(bar)[XB_TMO])) break; if (_sp > XB_SPIN_CAP) { atomicAdd(&(bar)[XB_TMO], 1u); break; } } } } while (0)
struct XcdBarrier { unsigned* bar; unsigned x; volatile LAS unsigned* st; };
__device__ __forceinline__ XcdBarrier xcd_barrier_post(unsigned* bar, volatile LAS unsigned* st) {
    XcdBarrier b; b.bar = bar; b.x = xb_xcc_id(); b.st = st;
    if (threadIdx.x == 0) (void)xb_add(&bar[XB_XCNT(b.x)], 1u);
    return b;
}
__device__ __forceinline__ void xcd_barrier_complete(unsigned* bar, unsigned x, unsigned& nloc, unsigned& nx) {
    const unsigned G = gridDim.x * gridDim.y * gridDim.z;
    unsigned sum, cnt, mine, sp = 0u;
    for (;;) {
        sum = 0u; cnt = 0u; mine = 0u;
#pragma unroll
        for (unsigned j = 0; j < 16; ++j) { const unsigned c = xb_ld(&bar[XB_XCNT(j)]); sum += c; cnt += (c > 0u) ? 1u : 0u; mine = (j == x) ? c : mine; }
        if (sum == G) break;
        __builtin_amdgcn_s_sleep(1);
        if ((++sp & 255u) == 0u) { if (xb_ld(&bar[XB_TMO])) break; if (sp > XB_SPIN_CAP) { atomicAdd(&bar[XB_TMO], 1u); break; } }
    }
    nloc = mine > 0u ? mine : 1u; nx = cnt > 0u ? cnt : 1u;
}
__device__ __forceinline__ void xcd_barrier(const XcdBarrier& b) {
    asm volatile("s_waitcnt vmcnt(0)" ::: "memory");
    __syncthreads();
    if (threadIdx.x == 0) {
        unsigned* bar = b.bar;
        __builtin_amdgcn_s_waitcnt(0);
        unsigned nloc = b.st[0], nx = b.st[1];
        if (nloc == 0u) { xcd_barrier_complete(bar, b.x, nloc, nx); b.st[0] = nloc; b.st[1] = nx; }
        const unsigned old = xb_add(&bar[XB_XSUB(b.x)], 1u);
        const unsigned gen = old / nloc;
        if (old + 1u == (gen + 1u) * nloc) {
            __builtin_amdgcn_fence(__ATOMIC_RELEASE, "agent");
            asm volatile("s_waitcnt vmcnt(0)" ::: "memory");
            const unsigned og = xb_add(&bar[XB_TOP], 1u);
            const unsigned tg = og / nx;
            if (og + 1u == (tg + 1u) * nx) xb_add(&bar[XB_TOPGEN], 1u);
            else XB_SPIN(xb_ld(&bar[XB_TOPGEN]) == tg, bar);
            __builtin_amdgcn_fence(__ATOMIC_ACQUIRE, "agent");
            xb_add(&bar[XB_XGEN(b.x)], 1u);
            asm volatile("s_waitcnt vmcnt(0)" ::: "memory");
        } else {
            XB_SPIN(xb_ld(&bar[XB_XGEN(b.x)]) == gen, bar);
            __builtin_amdgcn_fence(__ATOMIC_ACQUIRE, "agent");
            asm volatile("s_waitcnt vmcnt(0)" ::: "memory");
        }
    }
    __syncthreads();
}

namespace pg8 {
constexpr int BM = 256, BK = 64, HALF = 128, HTB = HALF * BK * 2, STAGE_BYTES = 8 * HTB;
__host__ __device__ __forceinline__ int lds_byte(int r, int c) { const int st = (r >> 4) * 2 + (c >> 5), rr = r & 15, cc = c & 31, ob = rr * 64 + cc * 2; return st * 1024 + (ob ^ (((ob >> 9) & 1) << 5)); }
__host__ __device__ __forceinline__ void stage_rc(int b, int& R, int& C) { const int st = b / 1024, sb = b % 1024, swz = sb ^ (((sb >> 9) & 1) << 5); R = (st >> 1) * 16 + swz / 64; C = (st & 1) * 32 + (swz % 64) / 2; }
__host__ __device__ __forceinline__ int perm32(int rho) { const int n = rho >> 4, i = rho & 15; return 8 * (i >> 2) + 4 * n + (i & 3); }

struct Unit { int j, pm, pn, aux, h; };

typedef int v4i_t __attribute__((ext_vector_type(4)));
typedef int v8i_t __attribute__((ext_vector_type(8)));
template <class Epi, class Sched, int MODE = 0, int KREP = 1, bool HALFU = false>
__device__ __forceinline__ void gemm_phase(LAS unsigned char* lds, const int K, const Sched& S, const Epi& E) {
    const int tid = threadIdx.x, wid = __builtin_amdgcn_readfirstlane(tid >> 6), lane = tid & 63, wr = wid >> 2, wc = wid & 3, fr = lane & 15, fq = lane >> 4;
    constexpr bool FP8 = MODE == 1, I8 = MODE == 2;
    const int nt1 = (MODE != 0) ? K / 128 : K / BK, nt = nt1 * KREP;
    int Rl[2], Cl2[2]; unsigned voffB[2];
#pragma unroll
    for (int i = 0; i < 2; ++i) { int R, C; stage_rc(tid * 16 + i * 8192, R, C); Rl[i] = R; Cl2[i] = C * 2; const int Rb = (R & ~31) + perm32(R & 31); voffB[i] = (unsigned)Rb * S.ldb_bytes + (unsigned)C * 2u; }
    const size_t kstep = (size_t)(BK * 2);
    const size_t hstepB = (size_t)HALF * S.ldb_bytes;
    const unsigned ldsw = (unsigned)wid * 1024u;
    const int aoff = lds_byte(wr * 64 + fr, fq * 8), boff = lds_byte(wc * 32 + fr, fq * 8);
#define PG8_SA(b, h) (((b) * 2 + (h)) * HTB)
#define PG8_SB(b, h) ((4 + (b) * 2 + (h)) * HTB)
#define PG8_STAGEB(bufoff, gbase) do { _Pragma("unroll") for (int _i = 0; _i < 2; ++_i) \
        __builtin_amdgcn_global_load_lds((const unsigned*)((const char*)(gbase) + voffB[_i]), (LAS unsigned*)(lds + (bufoff) + ldsw + _i * 8192), 16, 0, 0); } while (0)
#define PG8_STAGEA(bufoff, offs, h, kb) do { _Pragma("unroll") for (int _i = 0; _i < 2; ++_i) \
        __builtin_amdgcn_global_load_lds((const unsigned*)(S.A + (kb) + (offs)[(h) * 2 + _i]), (LAS unsigned*)(lds + (bufoff) + ldsw + _i * 8192), 16, 0, 0); } while (0)
#define PG8_LDA(dst, b, h) do { _Pragma("unroll") for (int m = 0; m < 4; ++m) _Pragma("unroll") for (int k = 0; k < 2; ++k) dst[m][k] = *(const LAS bf16x8*)(lds + PG8_SA(b, h) + aoff + m * 2048 + k * 1024); } while (0)
#define PG8_LDB(dst, b, h) do { _Pragma("unroll") for (int n = 0; n < 2; ++n) _Pragma("unroll") for (int k = 0; k < 2; ++k) dst[n][k] = *(const LAS bf16x8*)(lds + PG8_SB(b, h) + boff + n * 2048 + k * 1024); } while (0)
#define PG8_CAT(x0, x1) __builtin_shufflevector(__builtin_bit_cast(v4i_t, x0), __builtin_bit_cast(v4i_t, x1), 0, 1, 2, 3, 4, 5, 6, 7)
#define PG8_MMA(ai, bj, At, Bt) do { __builtin_amdgcn_s_setprio(1); _Pragma("unroll") for (int m = 0; m < 4; ++m) _Pragma("unroll") for (int n = 0; n < 2; ++n) { \
        if constexpr (FP8) acc[ai][bj][m][n] = __builtin_amdgcn_mfma_scale_f32_16x16x128_f8f6f4(PG8_CAT(Bt[n][0], Bt[n][1]), PG8_CAT(At[m][0], At[m][1]), acc[ai][bj][m][n], 0, 0, 0, 0, 0, 0); \
        else if constexpr (I8) { _Pragma("unroll") for (int k = 0; k < 2; ++k) acc[ai][bj][m][n] = __builtin_bit_cast(f32x4, __builtin_amdgcn_mfma_i32_16x16x64_i8(__builtin_bit_cast(v4i_t, Bt[n][k]), __builtin_bit_cast(v4i_t, At[m][k]), __builtin_bit_cast(v4i_t, acc[ai][bj][m][n]), 0, 0, 0)); } \
        else { _Pragma("unroll") for (int k = 0; k < 2; ++k) acc[ai][bj][m][n] = __builtin_amdgcn_mfma_f32_16x16x32_bf16(Bt[n][k], At[m][k], acc[ai][bj][m][n], 0, 0, 0); } } __builtin_amdgcn_s_setprio(0); } while (0)
#define PG8_WAIT_V(n) asm volatile("s_waitcnt vmcnt(" #n ")" ::: "memory")
#define PG8_WAIT_K do { if constexpr (HALFU) PG8_WAIT_V(6); else PG8_WAIT_V(8); } while (0)
#define PG8_WAIT_L(n) asm volatile("s_waitcnt lgkmcnt(" #n ")" ::: "memory")
#define PG8_BAR __builtin_amdgcn_s_barrier()
#define PG8_SCHED __builtin_amdgcn_sched_barrier(0)
#define PG8_OFFS(dst, u) do { _Pragma("unroll") for (int _h = 0; _h < 2; ++_h) _Pragma("unroll") for (int _i = 0; _i < 2; ++_i) dst[_h * 2 + _i] = S.row_off(u, _h * HALF + Rl[_i]) + (unsigned)Cl2[_i]; } while (0)
#define PG8_KLOOP(HALFC) \
        for (int t = 0; t < nt; t += 2) { \
            const bool last = (t == nt - 2); \
            const int t1 = KREP > 1 ? (t + 1) % nt1 : t + 1, t2 = KREP > 1 ? (t + 2) % nt1 : t + 2, t3 = KREP > 1 ? (t + 3) % nt1 : t + 3; \
            const size_t a1 = (size_t)t1 * kstep; \
            const size_t a2 = last ? (size_t)0 : (size_t)t2 * kstep; const size_t a3 = a2 + kstep; \
            const char* b2 = last ? S.b_ptr(nxt, 0) : S.b_ptr(cur, t2); \
            const char* b3 = last ? S.b_ptr(nxt, 1) : S.b_ptr(cur, t3); \
 \
            PG8_LDB(B0, 0, 0); PG8_LDB(B1, 0, 1); PG8_SCHED; PG8_LDA(At, 0, 0); if constexpr (!(HALFC)) PG8_STAGEA(PG8_SA(1, 1), offC, 1, a1); \
            if (last && has_next) { PG8_OFFS(offC, nxt); } \
            PG8_WAIT_K; PG8_WAIT_L(0); PG8_BAR; PG8_MMA(0, 0, At, B0); PG8_MMA(0, 1, At, B1); PG8_BAR; PG8_SCHED; \
 \
            if constexpr (!(HALFC)) PG8_LDA(At, 0, 1); PG8_STAGEB(PG8_SB(0, 0), b2); PG8_STAGEB(PG8_SB(0, 1), b2 + hstepB); PG8_STAGEA(PG8_SA(0, 0), offC, 0, a2); \
            PG8_WAIT_K; PG8_WAIT_L(0); PG8_BAR; if constexpr (!(HALFC)) { PG8_MMA(1, 0, At, B0); PG8_MMA(1, 1, At, B1); } PG8_BAR; PG8_SCHED; \
 \
            PG8_LDB(B0, 1, 0); PG8_LDB(B1, 1, 1); PG8_SCHED; PG8_LDA(At, 1, 0); if constexpr (!(HALFC)) PG8_STAGEA(PG8_SA(0, 1), offC, 1, a2); \
            PG8_WAIT_K; PG8_WAIT_L(0); PG8_BAR; PG8_MMA(0, 0, At, B0); PG8_MMA(0, 1, At, B1); PG8_BAR; PG8_SCHED; \
 \
            if constexpr (!(HALFC)) PG8_LDA(At, 1, 1); PG8_STAGEB(PG8_SB(1, 0), b3); PG8_STAGEB(PG8_SB(1, 1), b3 + hstepB); PG8_STAGEA(PG8_SA(1, 0), offC, 0, a3); \
            PG8_WAIT_K; PG8_WAIT_L(0); PG8_BAR; if constexpr (!(HALFC)) { PG8_MMA(1, 0, At, B0); PG8_MMA(1, 1, At, B1); } PG8_BAR; PG8_SCHED; \
            if constexpr (Epi::HAS_PRE) { if (t == 0) E.pre_store(pre_, lds); } \
        }
    Unit cur, nxt; int ui = 0;
    if (!S.next(0, cur)) return;
    if (SKEW_TICKS > 0) { const unsigned long long t0 = __builtin_amdgcn_s_memrealtime(), dl = (unsigned long long)((blockIdx.x >> 3) & 7) * SKEW_TICKS; while (__builtin_amdgcn_s_memrealtime() - t0 < dl) __builtin_amdgcn_s_sleep(8); }
    f32x4 acc[2][2][4][2];
#pragma unroll
    for (int a = 0; a < 2; ++a)
#pragma unroll
        for (int b = 0; b < 2; ++b)
#pragma unroll
            for (int m = 0; m < 4; ++m)
#pragma unroll
                for (int n = 0; n < 2; ++n) acc[a][b][m][n] = (f32x4){0.f, 0.f, 0.f, 0.f};
    bf16x8 At[4][2], B0[2][2], B1[2][2];
    unsigned offC[4];
    PG8_OFFS(offC, cur);
    const char* cB0 = S.b_ptr(cur, 0); const char* cB1 = S.b_ptr(cur, 1);
    PG8_STAGEB(PG8_SB(0, 0), cB0); PG8_STAGEB(PG8_SB(0, 1), cB0 + hstepB); PG8_STAGEA(PG8_SA(0, 0), offC, 0, 0); if constexpr (!HALFU) PG8_STAGEA(PG8_SA(0, 1), offC, 1, 0);
    if (wr == 1) PG8_BAR;
    if constexpr (HALFU) PG8_WAIT_V(0); else PG8_WAIT_V(2);
    PG8_BAR;
    PG8_STAGEB(PG8_SB(1, 0), cB1); PG8_STAGEA(PG8_SA(1, 0), offC, 0, kstep); PG8_STAGEB(PG8_SB(1, 1), cB1 + hstepB);
    PG8_WAIT_V(6); PG8_BAR;
    for (;;) {
        const bool has_next = S.next(ui + 1, nxt);
        if (!has_next) nxt = cur;
        typename Epi::Pre pre_ = E.pre_load(cur);
        PG8_KLOOP(HALFU)
        if (wr == 0) PG8_BAR;
        if constexpr (KREP > 1) {
#pragma unroll
            for (int a = 0; a < 2; ++a)
#pragma unroll
                for (int b = 0; b < 2; ++b)
#pragma unroll
                    for (int m = 0; m < 4; ++m)
#pragma unroll
                        for (int n = 0; n < 2; ++n) acc[a][b][m][n] = acc[a][b][m][n] * (1.0f / KREP); }
        E(acc, cur, wr, wc, fr, fq, lds);
        if (!has_next) break;
#pragma unroll
        for (int a = 0; a < 2; ++a)
#pragma unroll
            for (int b = 0; b < 2; ++b)
#pragma unroll
                for (int m = 0; m < 4; ++m)
#pragma unroll
                    for (int n = 0; n < 2; ++n) acc[a][b][m][n] = (f32x4){0.f, 0.f, 0.f, 0.f};
        cur = nxt; ++ui;
        if (wr == 1) PG8_BAR;
    }
    PG8_WAIT_V(0);
    PG8_BAR;
#undef PG8_SA
#undef PG8_SB
#undef PG8_STAGEA
#undef PG8_STAGEB
#undef PG8_LDA
#undef PG8_LDB
#undef PG8_MMA
#undef PG8_CAT
#undef PG8_WAIT_V
#undef PG8_WAIT_L
#undef PG8_WAIT_K
#undef PG8_BAR
#undef PG8_SCHED
#undef PG8_OFFS
#undef PG8_KLOOP
}
}

struct Args {
    const float* x; const float* norm_mix; const float* norm_ffn; const float* pool_w; const float* pool_scale; const float* kv_norm; const float* w_kv; const float* k_norm;
    const float* w_q; const float* q_norm; const float* w_o; const float* w_grp; const float* b_grp; const float* w_rt; const float* b_rt; const float* w_gate; const float* w_up; const float* w_down;
    float* out; unsigned char* ws; int ph_lo, ph_hi;
};
struct Frame {
    LAS unsigned char* lds; int tid, lane, wave, vcu, G;
};

template <bool OUT8> __device__ __forceinline__ void transpose_item(const float* W, int ldw, const float* gk, const float* gn, void* WTv, int ldk, int k0, int n0, int drow0, LAS float* scr, int lane, float scale = 1.f) {
    float v[32];
    const float* src = W + (size_t)(k0 + (lane >> 5)) * ldw + n0 + (lane & 31);
#pragma unroll
    for (int i = 0; i < 32; ++i) v[i] = __builtin_nontemporal_load(src + (size_t)(2 * i) * ldw);
    const int c = lane & 7;
    f32x4 ga = (f32x4){1.f, 1.f, 1.f, 1.f}, gb = ga;
    if (gk) { ga = *(const f32x4*)(gk + k0 + 8 * c); gb = *(const f32x4*)(gk + k0 + 8 * c + 4); }
#pragma unroll
    for (int i = 0; i < 32; ++i) scr[(2 * i + (lane >> 5)) * 33 + (lane & 31)] = v[i];
    LDS_WAIT(); asm volatile("" ::: "memory");
#pragma unroll
    for (int j = 0; j < 4; ++j) { const int n = (lane >> 3) + 8 * j; const LAS float* s = scr + (8 * c) * 33 + n; const float g = (gn ? gn[n0 + n] : 1.f) * scale;
        if constexpr (OUT8) { u32x2 o; o.x = pk4_fp8(s[0 * 33] * ga[0] * g, s[1 * 33] * ga[1] * g, s[2 * 33] * ga[2] * g, s[3 * 33] * ga[3] * g); o.y = pk4_fp8(s[4 * 33] * gb[0] * g, s[5 * 33] * gb[1] * g, s[6 * 33] * gb[2] * g, s[7 * 33] * gb[3] * g);
            __builtin_nontemporal_store(o, (u32x2*)((unsigned char*)WTv + (size_t)(drow0 + n) * ldk + k0 + 8 * c)); }
        else { u32x4 o; o.x = pk2(s[0 * 33] * ga[0] * g, s[1 * 33] * ga[1] * g); o.y = pk2(s[2 * 33] * ga[2] * g, s[3 * 33] * ga[3] * g); o.z = pk2(s[4 * 33] * gb[0] * g, s[5 * 33] * gb[1] * g); o.w = pk2(s[6 * 33] * gb[2] * g, s[7 * 33] * gb[3] * g);
            __builtin_nontemporal_store(o, (u32x4*)((bf16_t*)WTv + (size_t)(drow0 + n) * ldk + k0 + 8 * c)); } }
    LDS_WAIT(); asm volatile("" ::: "memory");
}


__device__ __forceinline__ void strip_item_i8(const float* W, int ldw, const float* gk, unsigned char* WT, float* cscale, int n0, int drow0, LAS float* scr, LAS float* smax, int lane, int wave) {
    const float* src = W + (size_t)(lane >> 5) * ldw + n0 + (lane & 31);
    const int kb0 = wave * 4;
    float amax = 0.f;
    unsigned pk[4][16];
#pragma unroll
    for (int q = 0; q < 4; ++q) { const int kb = kb0 + q;
        float v[32];
#pragma unroll
        for (int i = 0; i < 32; ++i) v[i] = __builtin_nontemporal_load(src + (size_t)(64 * kb + 2 * i) * ldw);
#pragma unroll
        for (int i = 0; i < 32; ++i) { const float g = gk ? gk[64 * kb + 2 * i + (lane >> 5)] : 1.f; v[i] *= g; amax = fmaxf(amax, fabsf(v[i])); }
#pragma unroll
        for (int i = 0; i < 16; ++i) pk[q][i] = cvt_pk_bf16(v[2 * i], v[2 * i + 1]);
    }
    amax = fmaxf(amax, __shfl_xor(amax, 32));
    if (lane < 32) smax[wave * 32 + lane] = amax;
    __syncthreads();
    if (lane < 32) { float m = 0.f;
#pragma unroll
        for (int w = 0; w < NWAVES; ++w) m = fmaxf(m, smax[w * 32 + lane]);
        scr[64 * 33 + lane] = m > 0.f ? 127.0f / m : 0.f; if (wave == 0) cscale[drow0 + lane] = m * (1.0f / 127.0f); }
    const int c = lane & 7;
#pragma unroll
    for (int q = 0; q < 4; ++q) { const int kb = kb0 + q;
#pragma unroll
        for (int i = 0; i < 16; ++i) { scr[(4 * i + (lane >> 5)) * 33 + (lane & 31)] = __builtin_bit_cast(float, pk[q][i] << 16); scr[(4 * i + 2 + (lane >> 5)) * 33 + (lane & 31)] = __builtin_bit_cast(float, pk[q][i] & 0xffff0000u); }
        LDS_WAIT(); asm volatile("" ::: "memory");
#pragma unroll
        for (int j = 0; j < 4; ++j) { const int n = (lane >> 3) + 8 * j; const LAS float* s = scr + (8 * c) * 33 + n; const float qs = scr[64 * 33 + n];
            u32x2 o; o.x = pk4_i8(s[0 * 33] * qs, s[1 * 33] * qs, s[2 * 33] * qs, s[3 * 33] * qs); o.y = pk4_i8(s[4 * 33] * qs, s[5 * 33] * qs, s[6 * 33] * qs, s[7 * 33] * qs);
            *(u32x2*)(WT + (size_t)(drow0 + n) * DM + 64 * kb + 8 * c) = o; }
        LDS_WAIT(); asm volatile("" ::: "memory");
    }
    __syncthreads();
}

__device__ __forceinline__ void conv_gu_item(const Args& a, int layer, int idx, LAS float* scr, int lane) {
    const int which = idx >> 13, e = (idx >> 9) & 15, rr = idx & 511, kb = rr >> 4, nb = rr & 15, le = layer * NE + e;
    const int f0 = 32 * nb, drow0 = (f0 >> 7) * 256 + which * 128 + (f0 & 127);
    transpose_item<true>((which ? a.w_up : a.w_gate) + (size_t)le * DM * FF, FF, a.norm_ffn + layer * DM, nullptr, a.ws + WS_WGU + (size_t)le * 1024 * DM, DM, 64 * kb, f0, drow0, scr, lane, 64.f);
}
__device__ __forceinline__ void conv_down_item(const Args& a, int layer, int idx, LAS float* scr, int lane) {
    const int e = idx >> 9, rr = idx & 511, kb = rr >> 6, nb = rr & 63, le = layer * NE + e;
    transpose_item<true>(a.w_down + (size_t)le * FF * DM, DM, nullptr, nullptr, a.ws + WS_WD + (size_t)le * DM * FF, FF, 64 * kb, 32 * nb, 32 * nb, scr, lane, 32.f);
}
constexpr int N_GU_ITEMS = 16384, N_DOWN_ITEMS = 8192;
constexpr int Q_GU3 = 10, Q_GU4 = 4, Q_DN4 = 24;
struct FillPlan { int gu3, gu4, dn4, nidle, rank, st3, st4; };
__device__ __forceinline__ FillPlan fill_plan(int units, int G, int vcu) { FillPlan p; const int rem = units % G; p.nidle = rem == 0 ? G : G - rem; p.rank = rem == 0 ? vcu : vcu - rem;
    const long cap = (long)p.nidle * NWAVES; const long g3 = cap * Q_GU3, g4 = g3 + cap * Q_GU4, d4 = cap * Q_DN4;
    p.gu3 = g3 < N_GU_ITEMS ? (int)g3 : N_GU_ITEMS; p.gu4 = g4 < N_GU_ITEMS ? (int)g4 : N_GU_ITEMS; p.dn4 = d4 < N_DOWN_ITEMS ? (int)d4 : N_DOWN_ITEMS;
    p.st3 = p.nidle < 256 ? p.nidle : 256; { const int e = p.st3 + 2 * p.nidle; p.st4 = e < 256 ? e : 256; } return p; }
template <bool DOWN> __device__ __forceinline__ void fill_range(const Args& a, Frame& F, const FillPlan& p, int lo, int hi) {
    if (p.rank < 0) return;
    const int nw = p.nidle * NWAVES; LAS float* scr = (LAS float*)(F.lds + F.wave * 16384);
    for (int idx = lo + p.rank * NWAVES + F.wave; idx < hi; idx += nw) { if (DOWN) conv_down_item(a, 1, idx, scr, F.lane); else conv_gu_item(a, 1, idx, scr, F.lane); }
}
template <bool DOWN> __device__ __forceinline__ void fill_tail(const Args& a, Frame& F, int lo) {
    const int nitems = DOWN ? N_DOWN_ITEMS : N_GU_ITEMS; LAS float* scr = (LAS float*)(F.lds + F.wave * 16384);
    for (int idx = lo + F.vcu * NWAVES + F.wave; idx < nitems; idx += F.G * NWAVES) { if (DOWN) conv_down_item(a, 1, idx, scr, F.lane); else conv_gu_item(a, 1, idx, scr, F.lane); }
}
__device__ __forceinline__ int moe_units_l0(const Args& a) {
    const unsigned* cnt = (const unsigned*)(a.ws + WS_CTL) + CW_CNT; const int lane = threadIdx.x & 63;
    int r = lane < NBKT ? (((int)__hip_atomic_load(cnt + lane * 64, __ATOMIC_RELAXED, __HIP_MEMORY_SCOPE_AGENT) + 255) >> 8) : 0;
#pragma unroll
    for (int o = 1; o < 64; o <<= 1) r += __shfl_xor(r, o);
    return 8 * __builtin_amdgcn_readfirstlane(r);
}
constexpr int N_STRIPS = 256;
__device__ __forceinline__ void do_strip(const Args& a, Frame& F, int st) {
    LAS float* scr = (LAS float*)(F.lds + F.wave * 16384); LAS float* smax = (LAS float*)(F.lds + 8 * 16384);
    if (st < 64) strip_item_i8(a.w_q, DM, a.norm_mix + DM, a.ws + WS_WQKV, (float*)(a.ws + WS_CSQKV), 32 * st, 32 * st, scr, smax, F.lane, F.wave);
    else if (st < 192) strip_item_i8(a.w_kv, 2 * DM, a.kv_norm, a.ws + WS_WQKV, (float*)(a.ws + WS_CSQKV), 32 * (st - 64), DM + 32 * (st - 64), scr, smax, F.lane, F.wave);
    else strip_item_i8(a.w_o, DM, nullptr, a.ws + WS_WO, (float*)(a.ws + WS_CSWO), 32 * (st - 192), 32 * (st - 192), scr, smax, F.lane, F.wave);
}
__device__ __forceinline__ void p0_weights(const Args& a, Frame& F) {
    LAS float* scr = (LAS float*)(F.lds + F.wave * 16384);
    const int gw = F.vcu * NWAVES + F.wave, NGW = F.G * NWAVES;
    bf16_t* Wpool = (bf16_t*)(a.ws + WS_WPOOL);
    constexpr int I_POOL = 4 * 8 * 16, NITEMS = I_POOL + N_GU_ITEMS + N_DOWN_ITEMS;
    for (int it = gw; it < NITEMS; it += NGW) {
        int r = it;
        if (r < I_POOL) { const int g = r / 128, rr = r % 128, kb = rr / 16, nb = rr % 16;
            transpose_item<false>(a.pool_w + (size_t)g * PGC * PGC, PGC, a.norm_mix + g * PGC, a.pool_scale + g * PGC, Wpool + (size_t)g * PGC * PGC, PGC, 64 * kb, 32 * nb, 32 * nb, scr, F.lane); continue; } r -= I_POOL;
        if (r < N_GU_ITEMS) { conv_gu_item(a, 0, r, scr, F.lane); continue; } r -= N_GU_ITEMS;
        conv_down_item(a, 0, r, scr, F.lane);
    }
    bf16_t* Wr = (bf16_t*)(a.ws + WS_WR);
    for (int idx = (F.vcu * NTHR + F.tid); idx < 2 * 32 * DM; idx += F.G * NTHR) {
        const int l = idx / (32 * DM), rr = (idx / DM) % 32, k = idx % DM; float v = 0.f;
        if (rr < 16) v = a.w_rt[(((size_t)l * NGRP + (rr >> 2)) * DM + k) * EPG + (rr & 3)];
        else if (rr < 20) v = a.w_grp[((size_t)l * DM + k) * NGRP + (rr - 16)];
        v *= a.norm_ffn[l * DM + k];
        const unsigned hi = f2bf(v); const float rem = v - __builtin_bit_cast(float, hi << 16);
        Wr[idx] = (bf16_t)hi; Wr[2 * 32 * DM + idx] = (bf16_t)f2bf(rem);
    }
}

template <int W> __device__ __forceinline__ void pool_batch(const float* xb, int t0, int rb, int c0, int tid, int lane, int wave, LAS float* rs, LAS float* part,
                                                            f32x4 (&cv)[16], const f32x4 (&hist)[16], f32x4& S, bf16_t* prow) {
    constexpr int NB = 16;
#pragma unroll
    for (int i = 0; i < NB; ++i) cv[i] = __builtin_nontemporal_load((const f32x4*)(xb + (size_t)(t0 + rb + i) * DM + c0));
    bf16_t* xrow = prow + ((long)WS_HB - (long)WS_Q) / 2;
    float q[NB];
#pragma unroll
    for (int i = 0; i < NB; ++i) q[i] = (cv[i].x * cv[i].x + cv[i].y * cv[i].y) + (cv[i].z * cv[i].z + cv[i].w * cv[i].w);
#pragma unroll
    for (int i = 0; i < NB; ++i) q[i] = wave_sum(q[i]);
    if (lane == 0) {
#pragma unroll
        for (int i = 0; i < NB; ++i) part[wave * NB + i] = q[i]; }
    __syncthreads();
    if (tid < NB) { float ss = 0.f;
#pragma unroll
        for (int wv = 0; wv < NWAVES; ++wv) ss += part[wv * NB + tid];
        rs[16 + rb + tid] = 1.0f / sqrtf(ss * (1.0f / DM) + EPS); }
    __syncthreads();
#pragma unroll
    for (int i = 0; i < NB; ++i) { const int r = rb + i, t = t0 + r;
        { u32x2 xo; xo.x = cvt_pk_bf16(cv[i].x, cv[i].y); xo.y = cvt_pk_bf16(cv[i].z, cv[i].w); *(u32x2*)(xrow + (size_t)r * DM) = xo; }
        cv[i] = cv[i] * rs[r + 16];
        S += cv[i];
        const float inv = 1.0f / (float)((t + 1 < W) ? (t + 1) : W);
        const f32x4 p = S * inv - cv[i];
        u32x2 o; o.x = pk2(p.x, p.y); o.y = pk2(p.z, p.w);
        *(u32x2*)(prow + (size_t)r * DM) = o;
        if (i - W + 1 >= 0) S -= cv[i - W + 1 >= 0 ? i - W + 1 : 0]; else S -= hist[NB + i - W + 1 < NB ? NB + i - W + 1 : 0]; }
}
template <int W> __device__ __forceinline__ void pool_unit(const float* xb, int t0, int c0, int tid, int lane, int wave, LAS float* rs, LAS float* part, bf16_t* prow) {
    f32x4 A[16], B[16]; f32x4 S = (f32x4){0.f, 0.f, 0.f, 0.f};
#pragma unroll
    for (int r = 0; r < 16; ++r) { B[r] = (f32x4){0.f, 0.f, 0.f, 0.f};
        if (16 - r < W) { int t = t0 - (16 - r); t = t < 0 ? 0 : t; B[r] = *(const f32x4*)(xb + (size_t)t * DM + c0) * rs[r]; S += B[r]; } }
#pragma unroll 1
    for (int rb = 0; rb < 128; rb += 32) {
        pool_batch<W>(xb, t0, rb, c0, tid, lane, wave, rs, part, A, B, S, prow);
        pool_batch<W>(xb, t0, rb + 16, c0, tid, lane, wave, rs, part, B, A, S, prow);
    }
}
__device__ __forceinline__ void p0_pool(const Args& a, Frame& F, bf16_t* pooled) {
    constexpr int TC = 128;
    LAS float* rs = (LAS float*)(F.lds);
    LAS float* part = (LAS float*)(F.lds + 1024);
    const int c0 = F.tid * 4, gi = c0 / PGC;
    for (int u = F.vcu; u < T / TC; u += F.G) {
        const int b = u / (SEQ / TC), t0 = (u % (SEQ / TC)) * TC;
        const float* xb = a.x + (size_t)b * SEQ * DM;
        __syncthreads();
        { const int rg = F.wave * 2 - 16;
          f32x4 v[2][8];
#pragma unroll
          for (int q = 0; q < 2; ++q) { int t = t0 + rg + q; t = t < 0 ? 0 : t; const f32x4* xr = (const f32x4*)(xb + (size_t)t * DM) + F.lane;
#pragma unroll
              for (int j = 0; j < 8; ++j) v[q][j] = xr[64 * j]; }
#pragma unroll
          for (int q = 0; q < 2; ++q) { const int r = rg + q, t = t0 + r; float ss = 0.f;
#pragma unroll
              for (int j = 0; j < 8; ++j) ss += (v[q][j].x * v[q][j].x + v[q][j].y * v[q][j].y) + (v[q][j].z * v[q][j].z + v[q][j].w * v[q][j].w);
              ss = wave_sum(ss);
              if (F.lane == 0) rs[r + 16] = (t >= 0) ? 1.0f / sqrtf(ss * (1.0f / DM) + EPS) : 0.f; } }
        __syncthreads();
        bf16_t* prow = pooled + ((size_t)b * SEQ + t0) * DM + c0;
        if (gi == 0) pool_unit<2>(xb, t0, c0, F.tid, F.lane, F.wave, rs, part, prow);
        else if (gi == 1) pool_unit<4>(xb, t0, c0, F.tid, F.lane, F.wave, rs, part, prow);
        else if (gi == 2) pool_unit<8>(xb, t0, c0, F.tid, F.lane, F.wave, rs, part, prow);
        else pool_unit<16>(xb, t0, c0, F.tid, F.lane, F.wave, rs, part, prow);
    }
    __syncthreads();
}

struct SchedPlain {
    const char* A; const char* B; unsigned lda_bytes, ldb_bytes; int nM, nN, G, vcu; int pool; int rep;
    __device__ __forceinline__ bool next(int i, pg8::Unit& u) const {
        if (G == 256 && (nM & 3) == 0 && (nN & 7) == 0 && ((nM >> 2) * (nN >> 3)) % 8 == 0) {
            const int SN = nN >> 3, nS = (nM >> 2) * SN; int s = i * 8 + (vcu >> 5); if (s >= rep * nS) return false; s %= nS;
            const int c = vcu & 31; u.j = i; u.pm = (s / SN) * 4 + (c >> 3); u.pn = (s % SN) * 8 + (c & 7); u.aux = 0; u.h = 0; return true; }
        int L = i * G + vcu; if (L >= rep * nM * nN) return false; L %= nM * nN; u.j = i; u.pm = L / nN; u.pn = L % nN; u.aux = 0; u.h = 0; return true; }
    __device__ __forceinline__ unsigned row_off(const pg8::Unit& u, int r) const { return (unsigned)(u.pm * 256 + r) * lda_bytes + (pool ? (unsigned)(u.pn >> 1) * (PGC * 2) : 0u); }
    __device__ __forceinline__ const char* b_ptr(const pg8::Unit& u, int kt) const { return B + (size_t)u.pn * 256 * ldb_bytes + (size_t)kt * 128; }
};

struct EpiPool {
    static constexpr bool HAS_PRE = false; struct Pre {}; __device__ __forceinline__ Pre pre_load(const pg8::Unit&) const { return Pre{}; } __device__ __forceinline__ void pre_store(const Pre&, LAS unsigned char*) const {}
    const bf16_t* xc; bf16_t* out; unsigned char* out8;
    __device__ __forceinline__ void operator()(const f32x4 (&acc)[2][2][4][2], const pg8::Unit& u, int wr, int wc, int fr, int fq, LAS unsigned char*) const {
        const int row0 = u.pm * 256 + wr * 64 + fr, col0 = u.pn * 256 + wc * 32 + 8 * fq;
#pragma unroll
        for (int ai = 0; ai < 2; ++ai)
#pragma unroll
            for (int mp = 0; mp < 2; ++mp) {
                u32x4 xv[2][2];
#pragma unroll
                for (int mm = 0; mm < 2; ++mm) { const size_t ro = (size_t)(row0 + ai * 128 + (mp * 2 + mm) * 16) * DM + col0;
#pragma unroll
                    for (int bj = 0; bj < 2; ++bj) xv[mm][bj] = *(const u32x4*)(xc + ro + bj * 128); }
                asm volatile("" ::: "memory");
#pragma unroll
                for (int mm = 0; mm < 2; ++mm) { const int m = mp * 2 + mm; const size_t ro = (size_t)(row0 + ai * 128 + m * 16) * DM + col0;
#pragma unroll
                    for (int bj = 0; bj < 2; ++bj) { const u32x4 h4 = xv[mm][bj];
                        const f32x4 v0 = acc[ai][bj][m][0] + (f32x4){bflo(h4.x), bfhi(h4.x), bflo(h4.y), bfhi(h4.y)}, v1 = acc[ai][bj][m][1] + (f32x4){bflo(h4.z), bfhi(h4.z), bflo(h4.w), bfhi(h4.w)};
                        u32x4 w; w.x = cvt_pk_bf16(v0[0], v0[1]); w.y = cvt_pk_bf16(v0[2], v0[3]); w.z = cvt_pk_bf16(v1[0], v1[1]); w.w = cvt_pk_bf16(v1[2], v1[3]);
                        *(u32x4*)(out + ro + bj * 128) = w;
                        u32x2 w8; w8.x = pk4_fp8(v0[0], v0[1], v0[2], v0[3]); w8.y = pk4_fp8(v1[0], v1[1], v1[2], v1[3]); *(u32x2*)(out8 + ro + bj * 128) = w8; } }
                asm volatile("" ::: "memory"); }
    }
};


__device__ __forceinline__ void bucket_experts(int b, int& ge_lo, int& ge_hi) { const int g = b / 6, p = b % 6; const int el = p < 3 ? 0 : (p < 5 ? 1 : 2), eh = p < 3 ? p + 1 : (p < 5 ? p - 1 : 3); ge_lo = g * 4 + el; ge_hi = g * 4 + eh; }
__device__ __forceinline__ void router_phase(const Args& a, Frame& F, const bf16_t* h, int layer) {
    const char* Wh = (const char*)((const bf16_t*)(a.ws + WS_WR) + (size_t)layer * 32 * DM); const char* Wl = Wh + (size_t)2 * 32 * DM * 2;
    unsigned* cnt = (unsigned*)(a.ws + WS_CTL) + CW_CNT + layer * NBKT * 64;
    int* list = (int*)(a.ws + WS_LIST); f32x4* meta = (f32x4*)(a.ws + WS_META);
    LAS char* lds = (LAS char*)F.lds;
    LAS float* lg = (LAS float*)(F.lds + 98304 + F.wave * 2048);
    LAS unsigned* bc = (LAS unsigned*)(F.lds + 98304 + 16384);
    const int tk = F.lane & 15, q = F.lane >> 4, wid = F.wave;
    unsigned wsrc[4];
#pragma unroll
    for (int i = 0; i < 4; ++i) { const int p = i * 512 + F.tid, row = (p >> 5) & 31, cp = p & 31; wsrc[i] = (unsigned)(row * (DM * 2) + ((cp ^ (row & 15)) * 16)); }
#define RT_STAGE(kc, buf) do { _Pragma("unroll") for (int _i = 0; _i < 4; ++_i) __builtin_amdgcn_global_load_lds((const unsigned*)((_i < 2 ? Wh : Wl) + (size_t)(kc) * 512 + wsrc[_i]), (LAS unsigned*)(lds + (buf) * 32768 + _i * 8192 + wid * 1024), 16, 0, 0); } while (0)
    const int aoffA = tk * 512, aoffB = (16 + tk) * 512;
    for (int bt = F.vcu; bt < T / 128; bt += F.G) {
        const int tok0 = bt * 128 + wid * 16;
        __syncthreads();
        if (F.tid < 64) bc[F.tid] = 0u;
        f32x4 c0 = {0.f, 0.f, 0.f, 0.f}, c1 = c0, css = c0;
        const bf16_t* hp = h + (size_t)(tok0 + tk) * DM + 8 * q;
        bf16x8 hf[8];
        bf16x8 hn[8], hnn[8];
        RT_STAGE(0, 0);
#pragma unroll
        for (int s = 0; s < 8; ++s) hf[s] = *(const bf16x8*)(hp + 32 * s);
        RT_STAGE(1, 1);
#pragma unroll
        for (int s = 0; s < 8; ++s) hn[s] = *(const bf16x8*)(hp + 256 + 32 * s);
        for (int kc = 0; kc < 8; ++kc) {
            if (kc < 7) asm volatile("s_waitcnt vmcnt(12)" ::: "memory"); else asm volatile("s_waitcnt vmcnt(0)" ::: "memory");
            __builtin_amdgcn_s_barrier(); asm volatile("" ::: "memory");
            if (kc < 6) { RT_STAGE(kc + 2, (kc + 2) % 3);
#pragma unroll
                for (int s = 0; s < 8; ++s) hnn[s] = *(const bf16x8*)(hp + 256 * (kc + 2) + 32 * s); }
            const LAS char* wb = lds + (kc % 3) * 32768;
#pragma unroll
            for (int s = 0; s < 8; ++s) { const int co = ((4 * s + q) ^ tk) * 16;
                const bf16x8 a0 = *(const LAS bf16x8*)(wb + aoffA + co), a1 = *(const LAS bf16x8*)(wb + aoffB + co), a0l = *(const LAS bf16x8*)(wb + 16384 + aoffA + co), a1l = *(const LAS bf16x8*)(wb + 16384 + aoffB + co);
                c0 = __builtin_amdgcn_mfma_f32_16x16x32_bf16(a0, hf[s], c0, 0, 0, 0); c0 = __builtin_amdgcn_mfma_f32_16x16x32_bf16(a0l, hf[s], c0, 0, 0, 0);
                c1 = __builtin_amdgcn_mfma_f32_16x16x32_bf16(a1, hf[s], c1, 0, 0, 0); c1 = __builtin_amdgcn_mfma_f32_16x16x32_bf16(a1l, hf[s], c1, 0, 0, 0);
                css = __builtin_amdgcn_mfma_f32_16x16x32_bf16(hf[s], hf[s], css, 0, 0, 0); }
            asm volatile("s_waitcnt lgkmcnt(0)" ::: "memory");
#pragma unroll
            for (int s = 0; s < 8; ++s) { hf[s] = hn[s]; hn[s] = hnn[s]; }
        }
#pragma unroll
        for (int r = 0; r < 4; ++r) lg[tk * 24 + 4 * q + r] = c0[r];
        if (q == 0) {
#pragma unroll
            for (int r = 0; r < 4; ++r) lg[tk * 24 + 16 + r] = c1[r]; }
        if (q == (tk >> 2)) { const int rr = tk & 3; lg[384 + tk] = rr == 0 ? css[0] : (rr == 1 ? css[1] : (rr == 2 ? css[2] : css[3])); }
        LDS_WAIT(); asm volatile("" ::: "memory");
        int b = 0; unsigned lpos = 0; float rstd = 0.f, wlo = 0.f, whi = 0.f;
        if (F.lane < 16) {
            rstd = 1.0f / sqrtf(lg[384 + tk] * (1.0f / DM) + EPS);
            float gl[4], el[4];
#pragma unroll
            for (int g = 0; g < 4; ++g) gl[g] = lg[tk * 24 + 16 + g] * rstd + a.b_grp[layer * NGRP + g];
            int gs = 0; float gm = gl[0];
#pragma unroll
            for (int g = 1; g < 4; ++g) if (gl[g] > gm) { gm = gl[g]; gs = g; }
            float den = 0.f;
#pragma unroll
            for (int g = 0; g < 4; ++g) den += __expf(gl[g] - gm);
            const float gwt = 1.0f / den;
#pragma unroll
            for (int e = 0; e < 4; ++e) el[e] = lg[tk * 24 + gs * 4 + e] * rstd + a.b_rt[(layer * NGRP + gs) * EPG + e];
            int i1 = 0; float v1 = el[0];
#pragma unroll
            for (int e = 1; e < 4; ++e) if (el[e] > v1) { v1 = el[e]; i1 = e; }
            int i2 = -1; float v2 = -3.0e38f;
#pragma unroll
            for (int e = 0; e < 4; ++e) if (e != i1 && el[e] > v2) { v2 = el[e]; i2 = e; }
            const float w1 = gwt / (1.0f + __expf(v2 - v1)), w2 = gwt - w1;
            const int elo = i1 < i2 ? i1 : i2, ehi = i1 < i2 ? i2 : i1; wlo = i1 < i2 ? w1 : w2; whi = i1 < i2 ? w2 : w1;
            const int pidx = elo == 0 ? ehi - 1 : (elo == 1 ? ehi + 1 : 5);
            b = gs * 6 + pidx;
            lpos = __hip_atomic_fetch_add(bc + b, 1u, __ATOMIC_RELAXED, __HIP_MEMORY_SCOPE_WORKGROUP);
        }
        __syncthreads();
        if (F.tid < NBKT) { const unsigned n = bc[F.tid]; bc[32 + F.tid] = n ? __hip_atomic_fetch_add(cnt + F.tid * 64, n, __ATOMIC_RELAXED, __HIP_MEMORY_SCOPE_AGENT) : 0u; }
        __syncthreads();
        if (F.lane < 16) { const unsigned pos = bc[32 + b] + lpos;
            list[(size_t)b * T + pos] = tok0 + tk;
            meta[(size_t)b * T + pos] = (f32x4){rstd, wlo, whi, 0.f}; }
    }
#undef RT_STAGE
    asm volatile("s_waitcnt vmcnt(0)" ::: "memory"); __syncthreads();
}

constexpr int MAXU = 8;
struct MoeTab { LAS int* ud; LAS unsigned* rowtab; };
__device__ __forceinline__ void moe_build(const Args& a, Frame& F, int layer, int gather) {
    LAS int* ud = (LAS int*)(F.lds + UDESC_OFF); LAS int* tb = ud + MAXU * 8;
    LAS unsigned* rowtab = (LAS unsigned*)(F.lds + ROWTAB_OFF);
    const unsigned* cnt = (const unsigned*)(a.ws + WS_CTL) + CW_CNT + layer * NBKT * 64;
    const int* list = (const int*)(a.ws + WS_LIST);
    __syncthreads();
    if (F.tid < NBKT) tb[32 + F.tid] = (int)__hip_atomic_load(cnt + F.tid * 64, __ATOMIC_RELAXED, __HIP_MEMORY_SCOPE_AGENT);
    __syncthreads();
    if (F.tid == 0) { int base = 0; for (int b = 0; b < NBKT; ++b) { tb[b] = base; base += (tb[32 + b] + 255) >> 8; } tb[NBKT] = base; }
    __syncthreads();
    if (F.tid < MAXU) { const int i = F.tid, R = tb[NBKT]; int L = i * F.G + F.vcu; int v = 0, rt = 0, pn = 0, b = 0, ti = 0, nv = 0, hf = 0;
        { const int nf = (8 * R) / F.G, extra = 8 * R - nf * F.G; if (layer == 1 && i == nf && extra > 0 && 2 * extra <= F.G) { if (F.vcu < 2 * extra) { L = nf * F.G + (F.vcu >> 1); hf = 1 + (F.vcu & 1); } else L = 8 * R; } }
        if (L < 8 * R) { v = 1; rt = L >> 3; pn = L & 7; while (tb[b + 1] <= rt) ++b; ti = rt - tb[b]; nv = tb[32 + b] - 256 * ti; if (nv > 256) nv = 256; }
        ud[i * 8 + 0] = rt; ud[i * 8 + 1] = pn; ud[i * 8 + 2] = b; ud[i * 8 + 3] = ti; ud[i * 8 + 4] = nv; ud[i * 8 + 5] = v; ud[i * 8 + 6] = hf;
        if (i == 0) { const int nf = (8 * R) / F.G, extra = 8 * R - nf * F.G; tb[60] = (layer == 1 && extra > 0 && 2 * extra <= F.G && F.vcu < 2 * extra && nf < MAXU) ? nf : -1; } }
    __syncthreads();
    if (gather) for (int e = F.tid; e < MAXU * 256; e += NTHR) { const int i = e >> 8, r = e & 255; unsigned off = 0;
        if (ud[i * 8 + 5]) { const int b = ud[i * 8 + 2], ti = ud[i * 8 + 3], nv = ud[i * 8 + 4]; const int rr = r < nv ? r : nv - 1; off = (unsigned)list[(size_t)b * T + 256 * ti + rr] * (gather == 1 ? (unsigned)DM : 1u); }
        rowtab[e] = off; }
    VM_WAIT(); __syncthreads();
}
__device__ __forceinline__ int rfl(int v) { return __builtin_amdgcn_readfirstlane(v); }
struct SchedMoe {
    const char* A; const char* W; unsigned ldb_bytes; LAS int* ud; LAS unsigned* rowtab; int layer; int down; int halfpass;
    __device__ __forceinline__ bool next(int i, pg8::Unit& u) const { if (halfpass) { if (i > 0) return false; i = rfl(ud[MAXU * 8 + 60]); if (i < 0) return false; } else { if (i >= MAXU) return false; if (rfl(ud[i * 8 + 6]) != 0) return false; }
        if (!rfl(ud[i * 8 + 5])) return false; u.j = i; u.pm = rfl(ud[i * 8 + 0]); u.pn = rfl(ud[i * 8 + 1]); u.aux = rfl(ud[i * 8 + 2]); u.h = rfl(ud[i * 8 + 6]); return true; }
    __device__ __forceinline__ unsigned row_off(const pg8::Unit& u, int r) const { r ^= (u.h == 2 ? 128 : 0); return down ? (unsigned)(u.pm * 256 + r) * (unsigned)(2 * FF) : rowtab[u.j * 256 + r]; }
    __device__ __forceinline__ const char* b_ptr(const pg8::Unit& u, int kt) const {
        int gl, gh; bucket_experts(u.aux, gl, gh);
        if (!down) { const int ge = u.pn < 4 ? gl : gh; return W + ((size_t)(layer * NE + ge) * 1024 + (size_t)(u.pn & 3) * 256) * (size_t)DM + (size_t)kt * 128; }
        const int ge = kt < 4 ? gl : gh; return W + ((size_t)(layer * NE + ge) * DM + (size_t)u.pn * 256) * (size_t)FF + (size_t)(kt & 3) * 128;
    }
};
struct EpiSwiGLU {
    const f32x4* meta; unsigned char* H; LAS int* ud;
    static constexpr bool HAS_PRE = true; struct Pre { float a, b; };
    __device__ __forceinline__ Pre pre_load(const pg8::Unit& u) const { Pre p{0.f, 0.f}; const int t = threadIdx.x;
        if (t < 256) { const float* mp = (const float*)(meta + (size_t)u.aux * T + 256 * rfl(ud[u.j * 8 + 3]) + t); p.a = mp[0]; p.b = mp[1 + (u.pn >> 2)]; } return p; }
    __device__ __forceinline__ void pre_store(const Pre& p, LAS unsigned char* lds) const { const int t = threadIdx.x; if (t < 256) { LAS float* tb = (LAS float*)(lds + EX_OFF); tb[2 * t] = p.a; tb[2 * t + 1] = p.b; } }
    __device__ __forceinline__ void operator()(const f32x4 (&acc)[2][2][4][2], const pg8::Unit& u, int wr, int wc, int fr_, int fq, LAS unsigned char* lds) const {
        int fr = fr_;
        const int hi = u.pn >> 2; const LAS float* tb = (const LAS float*)(lds + EX_OFF);
        const int hcol = hi * 512 + (u.pn & 3) * 128 + wc * 32 + 8 * fq;
        const int rx = u.h == 2 ? 128 : 0, nai = u.h ? 1 : 2;
        asm volatile("" : "+v"(fr));
        float rsv[2][4], wv[2][4];
#pragma unroll
        for (int ai = 0; ai < 2; ++ai)
#pragma unroll
            for (int m = 0; m < 4; ++m) { const int r = (ai * 128 + wr * 64 + m * 16 + fr) ^ rx; rsv[ai][m] = tb[2 * r]; wv[ai][m] = tb[2 * r + 1]; }
        asm volatile("" ::: "memory");
#pragma unroll
        for (int ai = 0; ai < 2; ++ai)
#pragma unroll
            for (int m = 0; m < 4; ++m) { if (ai >= nai) continue; const int r = (ai * 128 + wr * 64 + m * 16 + fr) ^ rx; const float rstd = rsv[ai][m] * (1.0f / 64.0f), w = wv[ai][m] * 8.0f;
                const float c1 = -rstd * 1.4426950408889634f, kr = rstd * rstd * w;
                f32x4 ov[2];
#pragma unroll
                for (int n = 0; n < 2; ++n) { const f32x4 ga = acc[ai][0][m][n], ua = acc[ai][1][m][n]; const f32x4 x = ga * c1;
                    f32x4 d; d[0] = __builtin_amdgcn_exp2f(x[0]); d[1] = __builtin_amdgcn_exp2f(x[1]); d[2] = __builtin_amdgcn_exp2f(x[2]); d[3] = __builtin_amdgcn_exp2f(x[3]);
                    d = d + 1.0f;
                    f32x4 r; r[0] = __builtin_amdgcn_rcpf(d[0]); r[1] = __builtin_amdgcn_rcpf(d[1]); r[2] = __builtin_amdgcn_rcpf(d[2]); r[3] = __builtin_amdgcn_rcpf(d[3]);
                    ov[n] = ((ga * ua) * kr) * r; }
                u32x2 pk; pk.x = pk4_fp8(ov[0][0], ov[0][1], ov[0][2], ov[0][3]); pk.y = pk4_fp8(ov[1][0], ov[1][1], ov[1][2], ov[1][3]);
                *(u32x2*)(H + (size_t)(u.pm * 256 + r) * (2 * FF) + hcol) = pk; }
    }
};
template <bool OUT_F32> struct EpiDown {
    static constexpr bool HAS_PRE = false; struct Pre {}; __device__ __forceinline__ Pre pre_load(const pg8::Unit&) const { return Pre{}; } __device__ __forceinline__ void pre_store(const Pre&, LAS unsigned char*) const {}
    const LAS unsigned* rowtab; const bf16_t* hin; void* out; LAS int* ud;
    __device__ __forceinline__ void operator()(const f32x4 (&acc)[2][2][4][2], const pg8::Unit& u, int wr, int wc, int fr_, int fq, LAS unsigned char*) const {
        int fr = fr_;
        const int nv = rfl(ud[u.j * 8 + 4]);
        const int col0 = u.pn * 256 + wc * 32 + 8 * fq;
        const int rx = u.h == 2 ? 128 : 0, nai = u.h ? 1 : 2;
        asm volatile("" : "+v"(fr));
        int tok[2][4];
#pragma unroll
        for (int ai = 0; ai < 2; ++ai)
#pragma unroll
            for (int m = 0; m < 4; ++m) { const int r = (ai * 128 + wr * 64 + m * 16 + fr) ^ rx; tok[ai][m] = (int)(rowtab[u.j * 256 + r] >> 11); }
#pragma unroll
        for (int ai = 0; ai < 2; ++ai) if (ai < nai) {
            u32x4 hv[4][2];
#pragma unroll
            for (int m = 0; m < 4; ++m) { const size_t ro = (size_t)tok[ai][m] * DM + col0;
#pragma unroll
                for (int bj = 0; bj < 2; ++bj) hv[m][bj] = *(const u32x4*)(hin + ro + bj * 128); }
            asm volatile("" ::: "memory");
#pragma unroll
            for (int m = 0; m < 4; ++m) { const int r = (ai * 128 + wr * 64 + m * 16 + fr) ^ rx; const size_t ro = (size_t)tok[ai][m] * DM + col0;
                if (r < nv) {
#pragma unroll
                    for (int bj = 0; bj < 2; ++bj) { const u32x4 h4 = hv[m][bj];
                        const f32x4 v0 = acc[ai][bj][m][0] * (1.0f / 256.0f) + (f32x4){bflo(h4.x), bfhi(h4.x), bflo(h4.y), bfhi(h4.y)}, v1 = acc[ai][bj][m][1] * (1.0f / 256.0f) + (f32x4){bflo(h4.z), bfhi(h4.z), bflo(h4.w), bfhi(h4.w)};
                        if (OUT_F32) { float* o = (float*)out + ro + bj * 128; __builtin_nontemporal_store(v0, (f32x4*)o); __builtin_nontemporal_store(v1, (f32x4*)(o + 4)); }
                        else { u32x4 w; w.x = cvt_pk_bf16(v0[0], v0[1]); w.y = cvt_pk_bf16(v0[2], v0[3]); w.z = cvt_pk_bf16(v1[0], v1[1]); w.w = cvt_pk_bf16(v1[2], v1[3]); *(u32x4*)((bf16_t*)out + ro + bj * 128) = w; } } } }
            asm volatile("" ::: "memory"); }
    }
};


typedef __bf16 bf2_t __attribute__((ext_vector_type(2)));
typedef unsigned short us2_t __attribute__((ext_vector_type(2)));
__device__ __forceinline__ float wave_max(float v) {
    v = fmaxf(v, dpp_f<0xB1>(v)); v = fmaxf(v, dpp_f<0x4E>(v)); v = fmaxf(v, dpp_f<0x141>(v)); v = fmaxf(v, dpp_f<0x140>(v));
    return max_xor32(max_xor16(v));
}
__device__ __forceinline__ void rowpass_phase(Frame& F, const bf16_t* h, float* rstd, float* rscale, unsigned char* a8) {
    const int gw = F.vcu * NWAVES + F.wave, NGW = F.G * NWAVES;
    constexpr int RB = 4;
    for (int row0 = gw * RB; row0 < T; row0 += NGW * RB) {
        u32x4 v[RB][4];
#pragma unroll
        for (int q = 0; q < RB; ++q) { const u32x4* p = (const u32x4*)(h + (size_t)(row0 + q) * DM) + F.lane;
#pragma unroll
            for (int j = 0; j < 4; ++j) v[q][j] = p[64 * j]; }
#pragma unroll
        for (int q = 0; q < RB; ++q) { float ss = 0.f, am = 0.f;
            us2_t mx = (us2_t){0, 0};
#pragma unroll
            for (int j = 0; j < 4; ++j) {
#pragma unroll
                for (int e = 0; e < 4; ++e) { const unsigned w = v[q][j][e]; ss = __builtin_amdgcn_fdot2_f32_bf16(__builtin_bit_cast(bf2_t, w), __builtin_bit_cast(bf2_t, w), ss, false);
                    mx = __builtin_elementwise_max(mx, __builtin_bit_cast(us2_t, w & 0x7fff7fffu)); } }
            { const unsigned mw = __builtin_bit_cast(unsigned, mx); am = fmaxf(bflo(mw), bfhi(mw)); }
            ss = wave_sum(ss); am = wave_max(am);
            const float qs = am > 0.f ? 127.0f / am : 0.f; const int row = row0 + q;
            if (F.lane == 0) { rstd[row] = 1.0f / sqrtf(ss * (1.0f / DM) + EPS); rscale[row] = am * (1.0f / 127.0f); }
            u32x2* o = (u32x2*)(a8 + (size_t)row * DM) + F.lane;
#pragma unroll
            for (int j = 0; j < 4; ++j) { u32x2 w; w.x = pk4_i8(bflo(v[q][j].x) * qs, bfhi(v[q][j].x) * qs, bflo(v[q][j].y) * qs, bfhi(v[q][j].y) * qs); w.y = pk4_i8(bflo(v[q][j].z) * qs, bfhi(v[q][j].z) * qs, bflo(v[q][j].w) * qs, bfhi(v[q][j].w) * qs); o[64 * j] = w; } }
    }
}

struct EpiRes {
    static constexpr bool HAS_PRE = false; struct Pre {}; __device__ __forceinline__ Pre pre_load(const pg8::Unit&) const { return Pre{}; } __device__ __forceinline__ void pre_store(const Pre&, LAS unsigned char*) const {}
    const bf16_t* hin; bf16_t* out; unsigned char* out8; const float* cscale; float os;
    __device__ __forceinline__ void operator()(const f32x4 (&acc)[2][2][4][2], const pg8::Unit& u, int wr, int wc, int fr, int fq, LAS unsigned char*) const {
        const int row0 = u.pm * 256 + wr * 64 + fr, col0 = u.pn * 256 + wc * 32 + 8 * fq;
        f32x4 cs[2][2];
#pragma unroll
        for (int bj = 0; bj < 2; ++bj) { cs[bj][0] = *(const f32x4*)(cscale + col0 + bj * 128) * os; cs[bj][1] = *(const f32x4*)(cscale + col0 + bj * 128 + 4) * os; }
#pragma unroll
        for (int ai = 0; ai < 2; ++ai) {
            u32x4 hv[4][2];
#pragma unroll
            for (int m = 0; m < 4; ++m) { const size_t ro = (size_t)(row0 + ai * 128 + m * 16) * DM + col0;
#pragma unroll
                for (int bj = 0; bj < 2; ++bj) hv[m][bj] = *(const u32x4*)(hin + ro + bj * 128); }
            asm volatile("" ::: "memory");
#pragma unroll
            for (int m = 0; m < 4; ++m) { const size_t ro = (size_t)(row0 + ai * 128 + m * 16) * DM + col0;
#pragma unroll
                for (int bj = 0; bj < 2; ++bj) { const u32x4 h4 = hv[m][bj];
                    const f32x4 a0 = __builtin_convertvector(__builtin_bit_cast(pg8::v4i_t, acc[ai][bj][m][0]), f32x4), a1 = __builtin_convertvector(__builtin_bit_cast(pg8::v4i_t, acc[ai][bj][m][1]), f32x4);
                    const f32x4 v0 = a0 * cs[bj][0] + (f32x4){bflo(h4.x), bfhi(h4.x), bflo(h4.y), bfhi(h4.y)}, v1 = a1 * cs[bj][1] + (f32x4){bflo(h4.z), bfhi(h4.z), bflo(h4.w), bfhi(h4.w)};
                    u32x4 w; w.x = cvt_pk_bf16(v0[0], v0[1]); w.y = cvt_pk_bf16(v0[2], v0[3]); w.z = cvt_pk_bf16(v1[0], v1[1]); w.w = cvt_pk_bf16(v1[2], v1[3]);
                    *(u32x4*)(out + ro + bj * 128) = w;
                    u32x2 w8; w8.x = pk4_fp8(v0[0], v0[1], v0[2], v0[3]); w8.y = pk4_fp8(v1[0], v1[1], v1[2], v1[3]); *(u32x2*)(out8 + ro + bj * 128) = w8; } }
            asm volatile("" ::: "memory"); }
    }
};


constexpr float QSCALE = 0.08838834764831845f * 1.4426950408889634f;
struct EpiQKV {
    const float* rstd; const float* rscale; const float* cscale; const float* qn; const float* kn; bf16_t* q; unsigned* vmaxw;
    static constexpr bool HAS_PRE = false; struct Pre {}; __device__ __forceinline__ Pre pre_load(const pg8::Unit&) const { return Pre{}; } __device__ __forceinline__ void pre_store(const Pre&, LAS unsigned char*) const {}
    __device__ __forceinline__ void operator()(const f32x4 (&acc)[2][2][4][2], const pg8::Unit& u, int wr, int wc, int fr_, int fq_, LAS unsigned char* lds) const {
        int fr = fr_, fq = fq_; asm volatile("" : "+v"(fr), "+v"(fq));
        const int which = u.pn >> 3, colt = (u.pn & 7) * 256;
        bf16_t* dst = q + (size_t)which * ((WS_K - WS_Q) / 2);
        const int col0 = colt + wc * 32 + 8 * fq;
        LAS float* EX = (LAS float*)(lds + EX_OFF);
        const bool normed = which != 2;
        float rsv[2][4];
#pragma unroll
        for (int ai = 0; ai < 2; ++ai)
#pragma unroll
            for (int m = 0; m < 4; ++m) { const int gr = u.pm * 256 + ai * 128 + wr * 64 + m * 16 + fr; rsv[ai][m] = rstd[gr] * rscale[gr]; }
        f32x4 cs[2][2];
#pragma unroll
        for (int bj = 0; bj < 2; ++bj) { cs[bj][0] = *(const f32x4*)(cscale + u.pn * 256 + wc * 32 + 8 * fq + bj * 128); cs[bj][1] = *(const f32x4*)(cscale + u.pn * 256 + wc * 32 + 8 * fq + bj * 128 + 4); }
        f32x4 g0 = (f32x4){1.f, 1.f, 1.f, 1.f}, g1 = g0;
        if (which == 0) { g0 = *(const f32x4*)(qn + wc * 32 + 8 * fq) * QSCALE; g1 = *(const f32x4*)(qn + wc * 32 + 8 * fq + 4) * QSCALE; }
        if (which == 1) { g0 = *(const f32x4*)(kn + wc * 32 + 8 * fq); g1 = *(const f32x4*)(kn + wc * 32 + 8 * fq + 4); }
#define QKV_CVT(ai, bj, m, n) __builtin_convertvector(__builtin_bit_cast(pg8::v4i_t, acc[ai][bj][m][n]), f32x4)
        f32x4 (&A)[2][2][4][2] = const_cast<f32x4 (&)[2][2][4][2]>(acc);
#pragma unroll
        for (int ai = 0; ai < 2; ++ai)
#pragma unroll
            for (int m = 0; m < 4; ++m)
#pragma unroll
                for (int bj = 0; bj < 2; ++bj) { const f32x4 c0 = QKV_CVT(ai, bj, m, 0) * cs[bj][0], c1 = QKV_CVT(ai, bj, m, 1) * cs[bj][1]; A[ai][bj][m][0] = c0; A[ai][bj][m][1] = c1; }
        if (normed) {
#pragma unroll
            for (int ai = 0; ai < 2; ++ai)
#pragma unroll
                for (int m = 0; m < 4; ++m)
#pragma unroll
                    for (int bj = 0; bj < 2; ++bj) { const f32x4 v0 = A[ai][bj][m][0], v1 = A[ai][bj][m][1];
                        const f32x4 sq = v0 * v0 + v1 * v1; float s = (sq[0] + sq[1]) + (sq[2] + sq[3]);
                        s = add_xor32(add_xor16(s));
                        if (fq == 0) EX[((ai * 128 + wr * 64 + m * 16 + fr) * 2 + bj) * 4 + wc] = s; }
            asm volatile("s_waitcnt lgkmcnt(0)" ::: "memory"); __builtin_amdgcn_s_barrier(); asm volatile("" ::: "memory");
        }
#pragma unroll
        for (int bj = 0; bj < 2; ++bj) { cs[bj][0] = g0; cs[bj][1] = g1; }
        float vmx = 0.f;
#define QKV_PASS2(NORMED) _Pragma("unroll") for (int ai = 0; ai < 2; ++ai) _Pragma("unroll") for (int m = 0; m < 4; ++m) { const int r = ai * 128 + wr * 64 + m * 16 + fr; const size_t ro = (size_t)(u.pm * 256 + r) * DM + col0; \
                const float rs = rsv[ai][m]; \
                _Pragma("unroll") for (int bj = 0; bj < 2; ++bj) { float f = rs; \
                    if (NORMED) { const f32x4 pp = *(const LAS f32x4*)(EX + (r * 2 + bj) * 4); const float tot = ((pp[0] + pp[1]) + (pp[2] + pp[3])) * rs * rs; f = rs * __builtin_amdgcn_rsqf(tot * (1.0f / HD) + EPS); } \
                    const f32x4 v0 = A[ai][bj][m][0] * (cs[bj][0] * f), v1 = A[ai][bj][m][1] * (cs[bj][1] * f); \
                    if (!(NORMED)) { const f32x4 a0 = __builtin_elementwise_abs(v0), a1 = __builtin_elementwise_abs(v1); const f32x4 mx = __builtin_elementwise_max(a0, a1); vmx = fmaxf(vmx, fmaxf(fmaxf(mx[0], mx[1]), fmaxf(mx[2], mx[3]))); } \
                    u32x4 w; w.x = cvt_pk_bf16(v0[0], v0[1]); w.y = cvt_pk_bf16(v0[2], v0[3]); w.z = cvt_pk_bf16(v1[0], v1[1]); w.w = cvt_pk_bf16(v1[2], v1[3]); \
                    __builtin_nontemporal_store(w, (u32x4*)(dst + ro + bj * 128)); } }
        if (normed) { QKV_PASS2(true) } else { QKV_PASS2(false) }
#undef QKV_PASS2
#undef QKV_CVT
        if (!normed) { vmx = wave_max(vmx); if ((threadIdx.x & 63) == 0) __hip_atomic_fetch_max(vmaxw, __float_as_uint(vmx), __ATOMIC_RELAXED, __HIP_MEMORY_SCOPE_AGENT); }
    }
};


typedef short v4i16_t __attribute__((ext_vector_type(4)));
__device__ __forceinline__ s16x4 vtr(const LAS char* p) { return __builtin_bit_cast(s16x4, __builtin_amdgcn_ds_read_tr16_b64_v4i16((LAS v4i16_t*)p)); }
__device__ __forceinline__ unsigned lds_addr(const LAS void* p) { return (unsigned)(unsigned long long)p; }
__device__ __forceinline__ bf16x8 lds_rd128(unsigned a) { bf16x8 v; asm volatile("ds_read_b128 %0, %1" : "=v"(v) : "v"(a) : "memory"); return v; }
__device__ __forceinline__ s16x4 lds_rdtr64(unsigned a) { s16x4 v; asm volatile("ds_read_b64_tr_b16 %0, %1" : "=v"(v) : "v"(a) : "memory"); return v; }
__device__ __forceinline__ void lds_wr32(unsigned a, unsigned v) { asm volatile("ds_write_b32 %0, %1" :: "v"(a), "v"(v) : "memory"); }
__device__ __forceinline__ void attn_phase(Frame& F, const bf16_t* Q, const bf16_t* K, const bf16_t* V, unsigned char* O, const unsigned* vmaxw) {
    const int lane = F.lane, wid = F.wave, tid = F.tid, r32 = lane & 31, hi = lane >> 5;
    LAS char* lds = (LAS char*)F.lds;
    const float vmaxf = __uint_as_float(__hip_atomic_load(vmaxw, __ATOMIC_RELAXED, __HIP_MEMORY_SCOPE_AGENT)); const float oqs = vmaxf > 0.f ? 127.0f / vmaxf : 0.f;
    LAS unsigned* dflag = (LAS unsigned*)(F.lds + MISC_OFF + 64);
    unsigned ksrc, vsrc;
    { const int row = tid >> 4, cp = tid & 15; const int X = ((row & 3) << 2) | ((row >> 2) & 3);
      ksrc = (unsigned)(row * (DM * 2) + ((cp ^ X) * 16)); vsrc = (unsigned)(row * (DM * 2) + ((cp ^ ((row & 3) << 2)) * 16)); }
    const int Xr = ((r32 & 3) << 2) | ((r32 >> 2) & 3);
    const int kbase = 256 * r32 + 16 * (hi ^ Xr);
    const int g4 = lane >> 4, qq = (lane & 15) >> 2, pp = lane & 3;
    int vb[4];
#pragma unroll
    for (int db = 0; db < 4; ++db) vb[db] = 256 * (4 * (g4 >> 1) + qq) + 64 * (db ^ qq) + 32 * (g4 & 1) + 16 * (pp >> 1) + 8 * (pp & 1);
#define AT_STAGE(j) do { const int _j = (j); const char* _kt = kg + (size_t)_j * 32 * (DM * 2); const char* _vt = vg + (size_t)_j * 32 * (DM * 2); LAS char* _d = lds + (_j % 9) * 16384 + wid * 1024; \
        __builtin_amdgcn_global_load_lds((const unsigned*)(_kt + ksrc), (LAS unsigned*)(_d), 16, 0, 0); \
        __builtin_amdgcn_global_load_lds((const unsigned*)(_vt + vsrc), (LAS unsigned*)(_d + 8192), 16, 0, 0); } while (0)
#define AT_UNIT(idx_) do {   \
        const int _i = (idx_); qb = _i & 7; h = (_i >> 3) & 15; b = (BATCH - 1) - (_i >> 7); rowbase = (size_t)b * SEQ; t0w = qb * 256 + wid * 32; \
        kg = (const char*)(K + rowbase * DM + h * HD); vg = (const char*)(V + rowbase * DM + h * HD); } while (0)
#define AT_LOADQ() do { const bf16_t* _qp = Q + (rowbase + t0w + r32) * DM + h * HD + 8 * hi; _Pragma("unroll") for (int s = 0; s < 8; ++s) qf[s] = *(const bf16x8*)(_qp + 16 * s); } while (0)
    constexpr int NUNITS = BATCH * NH * (SEQ / 256);
    int it = 0, idx = F.vcu;
    if (idx >= REP_ATTN * NUNITS) return;
    int qb, b, h, t0w; size_t rowbase; const char* kg; const char* vg;
    bf16x8 qf[8];
    AT_UNIT(idx % NUNITS);
    __builtin_amdgcn_s_barrier();
#pragma unroll 1
    for (int w = 0; w < 8; ++w) AT_STAGE(8 * qb + w);
    AT_LOADQ();
    bool first = true;
    for (;;) {
        const int t = t0w + r32;
        f32x16 o[4];
#pragma unroll
        for (int db = 0; db < 4; ++db)
#pragma unroll
            for (int r = 0; r < 16; ++r) o[db][r] = 0.f;
        float C = 1.0f; bool wdone = false;
        for (int n = 0;; ++n) {
            const int j = 8 * qb + wid - n;
            if (n == 0 && !first) asm volatile("s_waitcnt vmcnt(4)" ::: "memory"); else asm volatile("s_waitcnt vmcnt(0)" ::: "memory");
            __builtin_amdgcn_s_barrier(); asm volatile("" ::: "memory");
            if (n > 0) { const LAS unsigned* df = dflag + ((n - 1) & 1) * 8; const u32x4 f0 = *(const LAS u32x4*)df, f1 = *(const LAS u32x4*)(df + 4);
                if ((f0.x & f0.y & f0.z & f0.w & f1.x & f1.y & f1.z & f1.w) != 0u) break; }
            asm volatile("" : "+v"(qf[0]), "+v"(qf[1]), "+v"(qf[2]), "+v"(qf[3]), "+v"(qf[4]), "+v"(qf[5]), "+v"(qf[6]), "+v"(qf[7]));
            if (8 * qb - n - 1 >= 0) AT_STAGE(8 * qb - n - 1);
            if (j >= 0 && !wdone) {
                const unsigned kba = lds_addr(lds + (j % 9) * 16384);
                bf16x8 kf[8];
                f32x16 p;
#pragma unroll
                for (int r = 0; r < 16; ++r) p[r] = 0.f;
#pragma unroll
                for (int s = 0; s < 8; ++s) kf[s] = lds_rd128(kba + (unsigned)(kbase ^ (32 * s)));
                asm volatile("s_waitcnt lgkmcnt(4)" : "+v"(kf[0]), "+v"(kf[1]), "+v"(kf[2]), "+v"(kf[3]) :: "memory");
#pragma unroll
                for (int s = 0; s < 4; ++s) p = __builtin_amdgcn_mfma_f32_32x32x16_bf16(kf[s], qf[s], p, 0, 0, 0);
                asm volatile("s_waitcnt lgkmcnt(0)" : "+v"(kf[4]), "+v"(kf[5]), "+v"(kf[6]), "+v"(kf[7]) :: "memory");
#pragma unroll
                for (int s = 4; s < 8; ++s) p = __builtin_amdgcn_mfma_f32_32x32x16_bf16(kf[s], qf[s], p, 0, 0, 0);
                s16x4 vt[2][4][2];
#pragma unroll
                for (int db = 0; db < 4; ++db) { vt[0][db][0] = lds_rdtr64(kba + 8192u + (unsigned)(vb[db])); vt[0][db][1] = lds_rdtr64(kba + 8192u + (unsigned)(vb[db] + 256 * 8)); }
                const bool needmask = (32 * j + 31 >= t0w);
                bf16x8 pf[2];
                {
                    float E[16], on[16], gt[4], pr[4], om[4];
                    const int mlim = t - 32 * j - 4 * hi;
#pragma unroll
                    for (int r = 0; r < 16; ++r) { float e = __builtin_amdgcn_exp2f(p[r]);
                        if (needmask) e = ((r & 3) + 8 * (r >> 2) < mlim) ? e : 0.f;
                        E[r] = e; }
#pragma unroll
                    for (int a = 0; a < 4; ++a) {
#pragma unroll
                        for (int bb = 0; bb < 4; ++bb) on[4 * a + bb] = 1.0f + E[4 * a + bb];
                        gt[a] = ((on[4 * a + 3] * on[4 * a + 2]) * on[4 * a + 1]) * on[4 * a]; }
#pragma unroll
                    for (int a = 0; a < 4; ++a) { auto rr = __builtin_amdgcn_permlane32_swap(__float_as_uint(gt[a]), __float_as_uint(gt[a]), false, false);
                        const float x0 = __uint_as_float(rr[0]), x1 = __uint_as_float(rr[1]); pr[a] = x0 * x1; om[a] = hi ? 1.0f : x1; }
                    float R[4]; R[3] = C; R[2] = R[3] * pr[3]; R[1] = R[2] * pr[2]; R[0] = R[1] * pr[1]; C = R[0] * pr[0];
                    float A[16];
#pragma unroll
                    for (int a = 0; a < 4; ++a) { const float ap = R[a] * om[a];
                        const float i0 = __builtin_amdgcn_rcpf(gt[a] * ap), i1 = i0 * on[4 * a], i2 = i1 * on[4 * a + 1], i3 = i2 * on[4 * a + 2];
                        A[4 * a] = E[4 * a] * i0; A[4 * a + 1] = E[4 * a + 1] * i1; A[4 * a + 2] = E[4 * a + 2] * i2; A[4 * a + 3] = E[4 * a + 3] * i3; }
#pragma unroll
                    for (int s2 = 0; s2 < 2; ++s2) { u32x4 w; w.x = cvt_pk_bf16(A[8 * s2 + 0], A[8 * s2 + 1]); w.y = cvt_pk_bf16(A[8 * s2 + 2], A[8 * s2 + 3]); w.z = cvt_pk_bf16(A[8 * s2 + 4], A[8 * s2 + 5]); w.w = cvt_pk_bf16(A[8 * s2 + 6], A[8 * s2 + 7]);
                        pf[s2] = __builtin_bit_cast(bf16x8, w); }
                }
                asm volatile("s_waitcnt lgkmcnt(0)" : "+v"(vt[0][0][0]), "+v"(vt[0][0][1]), "+v"(vt[0][1][0]), "+v"(vt[0][1][1]), "+v"(vt[0][2][0]), "+v"(vt[0][2][1]), "+v"(vt[0][3][0]), "+v"(vt[0][3][1]) :: "memory");
#pragma unroll
                for (int db = 0; db < 4; ++db) { vt[1][db][0] = lds_rdtr64(kba + 8192u + (unsigned)(vb[db] + 256 * 16)); vt[1][db][1] = lds_rdtr64(kba + 8192u + (unsigned)(vb[db] + 256 * 24)); }
#pragma unroll
                for (int db = 0; db < 4; ++db) { const bf16x8 vf = __builtin_shufflevector(vt[0][db][0], vt[0][db][1], 0, 1, 2, 3, 4, 5, 6, 7); o[db] = __builtin_amdgcn_mfma_f32_32x32x16_bf16(vf, pf[0], o[db], 0, 0, 0); }
                asm volatile("s_waitcnt lgkmcnt(0)" : "+v"(vt[1][0][0]), "+v"(vt[1][0][1]), "+v"(vt[1][1][0]), "+v"(vt[1][1][1]), "+v"(vt[1][2][0]), "+v"(vt[1][2][1]), "+v"(vt[1][3][0]), "+v"(vt[1][3][1]) :: "memory");
#pragma unroll
                for (int db = 0; db < 4; ++db) { const bf16x8 vf = __builtin_shufflevector(vt[1][db][0], vt[1][db][1], 0, 1, 2, 3, 4, 5, 6, 7); o[db] = __builtin_amdgcn_mfma_f32_32x32x16_bf16(vf, pf[1], o[db], 0, 0, 0); }
            }
            wdone = (j <= 0) || __all(C >= 4294967296.0f);
            { const unsigned wd = wdone ? 1u : 0u; if (lane == 0) lds_wr32(lds_addr((const LAS void*)(dflag + (n & 1) * 8 + wid)), wd); }
            asm volatile("s_waitcnt lgkmcnt(0)" ::: "memory");
        }
        const size_t orow = (rowbase + t0w) * DM + h * HD;
        ++it; idx = it * F.G + F.vcu;
        const bool has_next = idx < REP_ATTN * NUNITS;
        int pslot = 8;
        if (has_next) { AT_UNIT(idx % NUNITS);
#pragma unroll 1
            for (int w = 0; w < 8; ++w) AT_STAGE(8 * qb + w);
            AT_LOADQ(); pslot = (8 * qb + 8) % 9; }
        { LAS char* st = lds + pslot * 16384 + wid * 2048;
#pragma unroll
          for (int ps = 0; ps < 2; ++ps) {
#pragma unroll
              for (int dd = 0; dd < 2; ++dd) { const int db = 2 * ps + dd;
#pragma unroll
                  for (int a = 0; a < 4; ++a) *(LAS unsigned*)(st + r32 * 64 + ((32 * dd + 8 * a + 4 * hi) ^ ((r32 & 3) << 4))) = pk4_i8(o[db][4 * a] * oqs, o[db][4 * a + 1] * oqs, o[db][4 * a + 2] * oqs, o[db][4 * a + 3] * oqs); }
              asm volatile("s_waitcnt lgkmcnt(0)" ::: "memory");
#pragma unroll
              for (int k2 = 0; k2 < 2; ++k2) { const int row = 16 * k2 + (lane >> 2), ch = lane & 3;
                  const u32x4 v = *(const LAS u32x4*)(st + row * 64 + ((16 * ch) ^ ((row & 3) << 4)));
                  *(u32x4*)(O + orow + (size_t)row * DM + 64 * ps + 16 * ch) = v; }
              asm volatile("s_waitcnt lgkmcnt(0)" ::: "memory"); } }
        if (!has_next) break;
        first = false;
    }
#undef AT_STAGE
#undef AT_UNIT
#undef AT_LOADQ
    asm volatile("s_waitcnt vmcnt(0)" ::: "memory"); __builtin_amdgcn_s_barrier();
}

__device__ __forceinline__ void dump_bf16(Frame& F, const bf16_t* src, float* out) {
    const size_t n8 = (size_t)T * DM / 8;
    for (size_t i = (size_t)F.vcu * NTHR + F.tid; i < n8; i += (size_t)F.G * NTHR) {
        const u32x4 v = *(const u32x4*)(src + i * 8);
        f32x4 a = (f32x4){bflo(v.x), bfhi(v.x), bflo(v.y), bfhi(v.y)}, b = (f32x4){bflo(v.z), bfhi(v.z), bflo(v.w), bfhi(v.w)};
        *(f32x4*)(out + i * 8) = a; *(f32x4*)(out + i * 8 + 4) = b;
    }
}

constexpr int N_PHASES = 13;
__global__ void __launch_bounds__(NTHR, 2) fwd(Args args) {
    extern __shared__ __attribute__((aligned(16))) unsigned char lds_raw[];
    Frame F;
    F.lds = (LAS unsigned char*)lds_raw;
    F.tid = threadIdx.x; F.lane = F.tid & 63; F.wave = __builtin_amdgcn_readfirstlane(F.tid >> 6);
    F.G = gridDim.x; { const int bx = blockIdx.x; F.vcu = (F.G % 8 == 0) ? (bx % 8) * (F.G / 8) + bx / 8 : bx; }
    volatile LAS unsigned* MISC = (volatile LAS unsigned*)(F.lds + MISC_OFF);
    if (F.tid < 64) MISC[F.tid] = 0u;
    __syncthreads();
    unsigned* ctl = (unsigned*)(args.ws + WS_CTL);
    XcdBarrier bar; bar.bar = ctl + CW_BAR; bar.x = 0; bar.st = nullptr;
    if (N_LAUNCH_MODE == 1) bar = xcd_barrier_post(ctl + CW_BAR, MISC + 8);
    const int lo = args.ph_lo, hi = args.ph_hi;
#define IN(k) (lo <= (k) && (k) < hi)
#define SEAM(k) do { if (N_LAUNCH_MODE == 1 && IN(k) && IN((k) + 1)) xcd_barrier(bar); } while (0)
    bf16_t* pooled = (bf16_t*)(args.ws + WS_Q);
    bf16_t* h1 = (bf16_t*)(args.ws + WS_K);
    bf16_t* h2 = (bf16_t*)(args.ws + WS_HB);
    bf16_t* h3 = (bf16_t*)(args.ws + WS_HC);

    if (IN(0)) for (int rep = 0; rep < REP_P0; ++rep) { p0_weights(args, F); p0_pool(args, F, pooled); }
    SEAM(0);
    if (IN(1)) {
        SchedPlain S{(const char*)pooled, (const char*)(args.ws + WS_WPOOL), DM * 2, PGC * 2, T / 256, 8, F.G, F.vcu, 1, REP_POOLG};
        EpiPool E{(const bf16_t*)(args.ws + WS_HB), h1, args.ws + WS_X8};
        pg8::gemm_phase<EpiPool, SchedPlain>(F.lds, PGC, S, E);
    }
    SEAM(1);
    if (IN(2)) router_phase(args, F, h1, 0);
    SEAM(2);
    if (IN(3)) {
        moe_build(args, F, 0, 1);
        SchedMoe S{(const char*)(args.ws + WS_X8), (const char*)(args.ws + WS_WGU), DM, (LAS int*)(F.lds + UDESC_OFF), (LAS unsigned*)(F.lds + ROWTAB_OFF), 0, 0};
        EpiSwiGLU E{(const f32x4*)(args.ws + WS_META), args.ws + WS_HMOE, (LAS int*)(F.lds + UDESC_OFF)};
        pg8::gemm_phase<EpiSwiGLU, SchedMoe, 1>(F.lds, DM, S, E);
        { SchedMoe S2 = S; S2.halfpass = 1; pg8::gemm_phase<EpiSwiGLU, SchedMoe, 1, 1, true>(F.lds, DM, S2, E); }
        __syncthreads(); { const FillPlan fp = fill_plan(moe_units_l0(args), F.G, F.vcu); fill_range<false>(args, F, fp, 0, fp.gu3);
            if (fp.rank >= 0) { __syncthreads(); if (fp.rank < fp.st3) do_strip(args, F, fp.rank); } }
    }
    SEAM(3);
    if (IN(4)) {
        SchedMoe S{(const char*)(args.ws + WS_HMOE), (const char*)(args.ws + WS_WD), FF, (LAS int*)(F.lds + UDESC_OFF), (LAS unsigned*)(F.lds + ROWTAB_OFF), 0, 1};
        EpiDown<false> E{(const LAS unsigned*)(F.lds + ROWTAB_OFF), h1, (void*)h2, (LAS int*)(F.lds + UDESC_OFF)};
        pg8::gemm_phase<EpiDown<false>, SchedMoe, 1>(F.lds, 2 * FF, S, E);
        { SchedMoe S2 = S; S2.halfpass = 1; pg8::gemm_phase<EpiDown<false>, SchedMoe, 1, 1, true>(F.lds, 2 * FF, S2, E); }
        __syncthreads(); { const FillPlan fp = fill_plan(moe_units_l0(args), F.G, F.vcu); fill_range<false>(args, F, fp, fp.gu3, fp.gu4); fill_range<true>(args, F, fp, 0, fp.dn4);
            if (fp.rank >= 0) { __syncthreads(); for (int st = fp.st3 + fp.rank; st < fp.st4; st += fp.nidle) do_strip(args, F, st); } }
    }
    SEAM(4);
#if STOP_AFTER == 1
    if (IN(12)) dump_bf16(F, h1, args.out);
#endif
#if STOP_AFTER == 2
    if (IN(12)) dump_bf16(F, h2, args.out);
#endif
#if STOP_AFTER >= 3
    bf16_t* qb_ = (bf16_t*)(args.ws + WS_Q); bf16_t* kb_ = (bf16_t*)(args.ws + WS_K); bf16_t* vb_ = (bf16_t*)(args.ws + WS_V);
    unsigned char* ob_ = (unsigned char*)args.out;
    float* rstd2 = (float*)(args.ws + WS_RSTD); float* rscale2 = (float*)(args.ws + WS_RSCALE);
    unsigned* vmaxw = (unsigned*)(args.ws + WS_CTL) + CW_VMAX;
    if (IN(5)) { rowpass_phase(F, h2, rstd2, rscale2, args.ws + WS_A8); const FillPlan fp = fill_plan(moe_units_l0(args), F.G, F.vcu); fill_tail<false>(args, F, fp.gu4); fill_tail<true>(args, F, fp.dn4);
        __syncthreads(); for (int st = fp.st4 + F.vcu; st < N_STRIPS; st += F.G) do_strip(args, F, st); }
    SEAM(5);
    if (IN(6)) {
        SchedPlain S{(const char*)(args.ws + WS_A8), (const char*)(args.ws + WS_WQKV), DM, DM, T / 256, 24, F.G, F.vcu, 0, REP_QKV};
        EpiQKV E{rstd2, rscale2, (const float*)(args.ws + WS_CSQKV), args.q_norm, args.k_norm, qb_, vmaxw};
        pg8::gemm_phase<EpiQKV, SchedPlain, 2, KREP_QKV>(F.lds, DM, S, E);
    }
    SEAM(6);
    if (IN(7)) attn_phase(F, qb_, kb_, vb_, ob_, vmaxw);
    SEAM(7);
    if (IN(8)) {
        SchedPlain S{(const char*)ob_, (const char*)(args.ws + WS_WO), DM, DM, T / 256, 8, F.G, F.vcu, 0, REP_WO};
        EpiRes E{h2, h3, args.ws + WS_X8, (const float*)(args.ws + WS_CSWO), __uint_as_float(__hip_atomic_load(vmaxw, __ATOMIC_RELAXED, __HIP_MEMORY_SCOPE_AGENT)) * (1.0f / 127.0f)};
        pg8::gemm_phase<EpiRes, SchedPlain, 2>(F.lds, DM, S, E);
    }
    SEAM(8);
#endif
#if STOP_AFTER == 3
    if (IN(12)) dump_bf16(F, h3, args.out);
#endif
#if STOP_AFTER >= 4
    if (IN(9)) router_phase(args, F, h3, 1);
    SEAM(9);
    if (IN(10)) {
        moe_build(args, F, 1, 1);
        SchedMoe S{(const char*)(args.ws + WS_X8), (const char*)(args.ws + WS_WGU), DM, (LAS int*)(F.lds + UDESC_OFF), (LAS unsigned*)(F.lds + ROWTAB_OFF), 1, 0};
        EpiSwiGLU E{(const f32x4*)(args.ws + WS_META), args.ws + WS_HMOE, (LAS int*)(F.lds + UDESC_OFF)};
        pg8::gemm_phase<EpiSwiGLU, SchedMoe, 1>(F.lds, DM, S, E);
        { SchedMoe S2 = S; S2.halfpass = 1; pg8::gemm_phase<EpiSwiGLU, SchedMoe, 1, 1, true>(F.lds, DM, S2, E); }
    }
    SEAM(10);
    if (IN(11)) {
        SchedMoe S{(const char*)(args.ws + WS_HMOE), (const char*)(args.ws + WS_WD), FF, (LAS int*)(F.lds + UDESC_OFF), (LAS unsigned*)(F.lds + ROWTAB_OFF), 1, 1};
        EpiDown<true> E{(const LAS unsigned*)(F.lds + ROWTAB_OFF), h3, (void*)args.out, (LAS int*)(F.lds + UDESC_OFF)};
        pg8::gemm_phase<EpiDown<true>, SchedMoe, 1>(F.lds, 2 * FF, S, E);
        { SchedMoe S2 = S; S2.halfpass = 1; pg8::gemm_phase<EpiDown<true>, SchedMoe, 1, 1, true>(F.lds, 2 * FF, S2, E); }
    }
#endif
#undef IN
#undef SEAM
}

extern "C" void kernel_launch(void* const* d_in, const int* in_sizes, int n_in, void* d_out, int out_size, void* d_ws, size_t ws_size, hipStream_t stream) {
    static int grid = 0;
    if (grid == 0) {
        if (n_in != 18 || out_size != T * DM || ws_size < WS_END) { fprintf(stderr, "kernel_launch: unexpected sizes (n_in %d out %d ws %zu)\n", n_in, out_size, ws_size); grid = -1; return; }
        int dev = 0, cus = 0, per_cu = 0;
        if (hipGetDevice(&dev) != hipSuccess || hipDeviceGetAttribute(&cus, hipDeviceAttributeMultiprocessorCount, dev) != hipSuccess) { grid = -1; return; }
        if (hipFuncSetAttribute((const void*)fwd, hipFuncAttributeMaxDynamicSharedMemorySize, LDS_BYTES) != hipSuccess) { fprintf(stderr, "kernel_launch: hipFuncSetAttribute failed\n"); grid = -1; return; }
        if (hipOccupancyMaxActiveBlocksPerMultiprocessor(&per_cu, (const void*)fwd, NTHR, LDS_BYTES) != hipSuccess || per_cu < 1) fprintf(stderr, "kernel_launch: occupancy query says %d\n", per_cu);
        (void)hipGetLastError();
        grid = cus;
    }
    if (grid < 0) return;
    hipMemsetAsync((char*)d_ws + WS_CTL, 0, CTL_BYTES, stream);
    Args a{};
    a.x = (const float*)d_in[0]; a.norm_mix = (const float*)d_in[1]; a.norm_ffn = (const float*)d_in[2]; a.pool_w = (const float*)d_in[3]; a.pool_scale = (const float*)d_in[4];
    a.kv_norm = (const float*)d_in[5]; a.w_kv = (const float*)d_in[6]; a.k_norm = (const float*)d_in[7]; a.w_q = (const float*)d_in[8]; a.q_norm = (const float*)d_in[9]; a.w_o = (const float*)d_in[10];
    a.w_grp = (const float*)d_in[11]; a.b_grp = (const float*)d_in[12]; a.w_rt = (const float*)d_in[13]; a.b_rt = (const float*)d_in[14]; a.w_gate = (const float*)d_in[15]; a.w_up = (const float*)d_in[16]; a.w_down = (const float*)d_in[17];
    a.out = (float*)d_out; a.ws = (unsigned char*)d_ws;
    if (N_LAUNCH_MODE == 1) { a.ph_lo = 0; a.ph_hi = N_PHASES; hipLaunchKernelGGL(fwd, dim3(grid), dim3(NTHR), LDS_BYTES, stream, a); }
    else for (int p = 0; p < N_PHASES; ++p) { a.ph_lo = p; a.ph_hi = p + 1; hipLaunchKernelGGL(fwd, dim3(grid), dim3(NTHR), LDS_BYTES, stream, a); }
}
```

```cpp
#include <hip/hip_runtime.h>
#include <cstdio>
#include <cstdint>

#ifndef STOP_AFTER
#define STOP_AFTER 4
#endif
#ifndef REP_ATTN
#define REP_ATTN 1
#endif
#ifndef REP_QKV
#define REP_QKV 1
#endif
#ifndef REP_WO
#define REP_WO 1
#endif
#ifndef REP_POOLG
#define REP_POOLG 1
#endif
#ifndef KREP_QKV
#define KREP_QKV 1
#endif
#ifndef SKEW_TICKS
#define SKEW_TICKS 0
#endif
#ifndef REP_P0
#define REP_P0 1
#endif
#ifndef N_LAUNCH_MODE
#define N_LAUNCH_MODE 1
#endif

#define LAS __attribute__((address_space(3)))
#define GAS __attribute__((address_space(1)))
typedef unsigned short bf16_t;
typedef short bf16x8 __attribute__((ext_vector_type(8)));
typedef short s16x4 __attribute__((ext_vector_type(4)));
typedef float f32x2 __attribute__((ext_vector_type(2)));
typedef float f32x4 __attribute__((ext_vector_type(4)));
typedef float f32x16 __attribute__((ext_vector_type(16)));
typedef unsigned u32x2 __attribute__((ext_vector_type(2)));
typedef unsigned u32x4 __attribute__((ext_vector_type(4)));

constexpr int BATCH = 16, SEQ = 2048, DM = 2048, T = BATCH * SEQ, NH = 16, HD = 128;
constexpr int NGRP = 4, EPG = 4, NE = 16, FF = 512, NBKT = 24;
constexpr int PGC = 512;
constexpr float EPS = 1e-6f;
constexpr int MAXRT = 152;
constexpr int NWAVES = 8, NTHR = 512;

constexpr size_t MiB = 1u << 20;
constexpr size_t WS_CTL = 0, CTL_BYTES = 96 * 1024;
constexpr size_t WS_WPOOL = 1 * MiB;
constexpr size_t WS_WQKV = 3 * MiB;
constexpr size_t WS_WO = 27 * MiB;
constexpr size_t WS_WGU = 35 * MiB;
constexpr size_t WS_X8 = 99 * MiB;
constexpr size_t WS_WD = 163 * MiB;
constexpr size_t WS_WR = 227 * MiB;
constexpr size_t WS_RSTD = 228 * MiB;
constexpr size_t WS_RSCALE = WS_RSTD + 131072;
constexpr size_t WS_CSQKV = WS_RSTD + 262144;
constexpr size_t WS_CSWO = WS_RSTD + 294912;
constexpr size_t WS_LIST = 229 * MiB;
constexpr size_t WS_META = 232 * MiB;
constexpr size_t WS_HMOE = 244 * MiB;
constexpr size_t WS_HB = 320 * MiB;
constexpr size_t WS_HC = 448 * MiB;
constexpr size_t WS_Q = 576 * MiB;
constexpr size_t WS_K = 704 * MiB;
constexpr size_t WS_V = 832 * MiB;
constexpr size_t WS_A8 = 960 * MiB;
constexpr size_t WS_END = 1024 * MiB;
constexpr int CW_BAR = 4096;
constexpr int CW_VMAX = 8192;
constexpr int CW_CNT = 16384;

constexpr int RING_BYTES = 131072;
constexpr int EX_OFF = RING_BYTES;
constexpr int ROWTAB_OFF = EX_OFF + 8192;
constexpr int UDESC_OFF = ROWTAB_OFF + 8192;
constexpr int MISC_OFF = UDESC_OFF + 1024;
constexpr int LDS_BYTES = 151552;
static_assert(MISC_OFF + 256 <= LDS_BYTES, "lds map");
static_assert(WS_V - WS_K == WS_K - WS_Q, "q|k|v spacing");

__device__ __forceinline__ unsigned f2bf(float f) { unsigned u = __builtin_bit_cast(unsigned, f); return (u + 0x7fffu + ((u >> 16) & 1u)) >> 16; }
__device__ __forceinline__ unsigned pk2(float lo, float hi) { return f2bf(lo) | (f2bf(hi) << 16); }
__device__ __forceinline__ float bf2f(unsigned short b) { return __builtin_bit_cast(float, ((unsigned)b) << 16); }
__device__ __forceinline__ float bflo(unsigned w) { return __builtin_bit_cast(float, w << 16); }
__device__ __forceinline__ float bfhi(unsigned w) { return __builtin_bit_cast(float, w & 0xffff0000u); }
__device__ __forceinline__ unsigned cvt_pk_bf16(float lo, float hi) { unsigned r; asm volatile("v_cvt_pk_bf16_f32 %0, %1, %2" : "=v"(r) : "v"(lo), "v"(hi)); return r; }
__device__ __forceinline__ float add_xor16(float v) { auto r = __builtin_amdgcn_permlane16_swap(__float_as_uint(v), __float_as_uint(v), false, false); return __uint_as_float(r[0]) + __uint_as_float(r[1]); }
__device__ __forceinline__ float add_xor32(float v) { auto r = __builtin_amdgcn_permlane32_swap(__float_as_uint(v), __float_as_uint(v), false, false); return __uint_as_float(r[0]) + __uint_as_float(r[1]); }
template <int CTRL> __device__ __forceinline__ float dpp_f(float v) { return __uint_as_float((unsigned)__builtin_amdgcn_update_dpp(0, (int)__float_as_uint(v), CTRL, 0xf, 0xf, true)); }
__device__ __forceinline__ float max_xor16(float v) { auto r = __builtin_amdgcn_permlane16_swap(__float_as_uint(v), __float_as_uint(v), false, false); return fmaxf(__uint_as_float(r[0]), __uint_as_float(r[1])); }
__device__ __forceinline__ float max_xor32(float v) { auto r = __builtin_amdgcn_permlane32_swap(__float_as_uint(v), __float_as_uint(v), false, false); return fmaxf(__uint_as_float(r[0]), __uint_as_float(r[1])); }
__device__ __forceinline__ float wave_sum(float v) {
    v += dpp_f<0xB1>(v); v += dpp_f<0x4E>(v); v += dpp_f<0x141>(v); v += dpp_f<0x140>(v);
    return add_xor32(add_xor16(v));
}
__device__ __forceinline__ unsigned pk4_fp8(float a, float b, float c, float d) {
    a = __builtin_amdgcn_fmed3f(a, -448.f, 448.f); b = __builtin_amdgcn_fmed3f(b, -448.f, 448.f); c = __builtin_amdgcn_fmed3f(c, -448.f, 448.f); d = __builtin_amdgcn_fmed3f(d, -448.f, 448.f);
    int r = __builtin_amdgcn_cvt_pk_fp8_f32(a, b, 0, false); r = __builtin_amdgcn_cvt_pk_fp8_f32(c, d, r, true); return (unsigned)r; }
__device__ __forceinline__ unsigned pk4_i8(float a, float b, float c, float d) {
    const float M = 12582912.0f;
    const unsigned ta = __float_as_uint(__builtin_amdgcn_fmed3f(a, -127.f, 127.f) + M), tb = __float_as_uint(__builtin_amdgcn_fmed3f(b, -127.f, 127.f) + M);
    const unsigned tc = __float_as_uint(__builtin_amdgcn_fmed3f(c, -127.f, 127.f) + M), td = __float_as_uint(__builtin_amdgcn_fmed3f(d, -127.f, 127.f) + M);
    const unsigned p01 = __builtin_amdgcn_perm(tb, ta, 0x0c0c0400u), p23 = __builtin_amdgcn_perm(td, tc, 0x0c0c0400u);
    return __builtin_amdgcn_perm(p23, p01, 0x05040100u); }
#define LDS_WAIT() asm volatile("s_waitcnt lgkmcnt(0)" ::: "memory")
#define VM_WAIT() asm volatile("s_waitcnt vmcnt(0)" ::: "memory")

#define XB_TMO      128
#define XB_XCNT(j)  (256  + 64 * (j))
#define XB_XSUB(j)  (1280 + 64 * (j))
#define XB_XGEN(j)  (2304 + 64 * (j))
#define XB_TOP      3328
#define XB_TOPGEN   3392
#define XCD_BAR_WORDS 3456
#define XB_SPIN_CAP (1u << 18)
__device__ __forceinline__ unsigned xb_ld(unsigned* p)              { return __hip_atomic_load(p, __ATOMIC_RELAXED, __HIP_MEMORY_SCOPE_AGENT); }
__device__ __forceinline__ unsigned xb_add(unsigned* p, unsigned v) { return __hip_atomic_fetch_add(p, v, __ATOMIC_RELAXED, __HIP_MEMORY_SCOPE_AGENT); }
__device__ __forceinline__ unsigned xb_xcc_id() { return (unsigned)__builtin_amdgcn_s_getreg((3 << 11) | 20) & 0xFu; }
#define XB_SPIN(cond, bar) do { unsigned _sp = 0; while (cond) { __builtin_amdgcn_s_sleep(1); \
    if ((++_sp & 255u) == 0u) { if (xb_ld(&(bar)[XB_TMO])) break; if (_sp > XB_SPIN_CAP) { atomicAdd(&(bar)[XB_TMO], 1u); break; } } } } while (0)
struct XcdBarrier { unsigned* bar; unsigned x; volatile LAS unsigned* st; };
__device__ __forceinline__ XcdBarrier xcd_barrier_post(unsigned* bar, volatile LAS unsigned* st) {
    XcdBarrier b; b.bar = bar; b.x = xb_xcc_id(); b.st = st;
    if (threadIdx.x == 0) (void)xb_add(&bar[XB_XCNT(b.x)], 1u);
    return b;
}
__device__ __forceinline__ void xcd_barrier_complete(unsigned* bar, unsigned x, unsigned& nloc, unsigned& nx) {
    const unsigned G = gridDim.x * gridDim.y * gridDim.z;
    unsigned sum, cnt, mine, sp = 0u;
    for (;;) {
        sum = 0u; cnt = 0u; mine = 0u;
#pragma unroll
        for (unsigned j = 0; j < 16; ++j) { const unsigned c = xb_ld(&bar[XB_XCNT(j)]); sum += c; cnt += (c > 0u) ? 1u : 0u; mine = (j == x) ? c : mine; }
        if (sum == G) break;
        __builtin_amdgcn_s_sleep(1);
        if ((++sp & 255u) == 0u) { if (xb_ld(&bar[XB_TMO])) break; if (sp > XB_SPIN_CAP) { atomicAdd(&bar[XB_TMO], 1u); break; } }
    }
    nloc = mine > 0u ? mine : 1u; nx = cnt > 0u ? cnt : 1u;
}
__device__ __forceinline__ void xcd_barrier(const XcdBarrier& b) {
    asm volatile("s_waitcnt vmcnt(0)" ::: "memory");
    __syncthreads();
    if (threadIdx.x == 0) {
        unsigned* bar = b.bar;
        __builtin_amdgcn_s_waitcnt(0);
        unsigned nloc = b.st[0], nx = b.st[1];
        if (nloc == 0u) { xcd_barrier_complete(bar, b.x, nloc, nx); b.st[0] = nloc; b.st[1] = nx; }
        const unsigned old = xb_add(&bar[XB_XSUB(b.x)], 1u);
        const unsigned gen = old / nloc;
        if (old + 1u == (gen + 1u) * nloc) {
            __builtin_amdgcn_fence(__ATOMIC_RELEASE, "agent");
            asm volatile("s_waitcnt vmcnt(0)" ::: "memory");
            const unsigned og = xb_add(&bar[XB_TOP], 1u);
            const unsigned tg = og / nx;
            if (og + 1u == (tg + 1u) * nx) xb_add(&bar[XB_TOPGEN], 1u);
            else XB_SPIN(xb_ld(&bar[XB_TOPGEN]) == tg, bar);
            __builtin_amdgcn_fence(__ATOMIC_ACQUIRE, "agent");
            xb_add(&bar[XB_XGEN(b.x)], 1u);
            asm volatile("s_waitcnt vmcnt(0)" ::: "memory");
        } else {
            XB_SPIN(xb_ld(&bar[XB_XGEN(b.x)]) == gen, bar);
            __builtin_amdgcn_fence(__ATOMIC_ACQUIRE, "agent");
            asm volatile("s_waitcnt vmcnt(0)" ::: "memory");
        }
    }
    __syncthreads();
}

namespace pg8 {
constexpr int BM = 256, BK = 64, HALF = 128, HTB = HALF * BK * 2, STAGE_BYTES = 8 * HTB;
__host__ __device__ __forceinline__ int lds_byte(int r, int c) { const int st = (r >> 4) * 2 + (c >> 5), rr = r & 15, cc = c & 31, ob = rr * 64 + cc * 2; return st * 1024 + (ob ^ (((ob >> 9) & 1) << 5)); }
__host__ __device__ __forceinline__ void stage_rc(int b, int& R, int& C) { const int st = b / 1024, sb = b % 1024, swz = sb ^ (((sb >> 9) & 1) << 5); R = (st >> 1) * 16 + swz / 64; C = (st & 1) * 32 + (swz % 64) / 2; }
__host__ __device__ __forceinline__ int perm32(int rho) { const int n = rho >> 4, i = rho & 15; return 8 * (i >> 2) + 4 * n + (i & 3); }

struct Unit { int j, pm, pn, aux, h; };

typedef int v4i_t __attribute__((ext_vector_type(4)));
typedef int v8i_t __attribute__((ext_vector_type(8)));
template <class Epi, class Sched, int MODE = 0, int KREP = 1, bool HALFU = false>
__device__ __forceinline__ void gemm_phase(LAS unsigned char* lds, const int K, const Sched& S, const Epi& E) {
    const int tid = threadIdx.x, wid = __builtin_amdgcn_readfirstlane(tid >> 6), lane = tid & 63, wr = wid >> 2, wc = wid & 3, fr = lane & 15, fq = lane >> 4;
    constexpr bool FP8 = MODE == 1, I8 = MODE == 2;
    const int nt1 = (MODE != 0) ? K / 128 : K / BK, nt = nt1 * KREP;
    int Rl[2], Cl2[2]; unsigned voffB[2];
#pragma unroll
    for (int i = 0; i < 2; ++i) { int R, C; stage_rc(tid * 16 + i * 8192, R, C); Rl[i] = R; Cl2[i] = C * 2; const int Rb = (R & ~31) + perm32(R & 31); voffB[i] = (unsigned)Rb * S.ldb_bytes + (unsigned)C * 2u; }
    const size_t kstep = (size_t)(BK * 2);
    const size_t hstepB = (size_t)HALF * S.ldb_bytes;
    const unsigned ldsw = (unsigned)wid * 1024u;
    const int aoff = lds_byte(wr * 64 + fr, fq * 8), boff = lds_byte(wc * 32 + fr, fq * 8);
#define PG8_SA(b, h) (((b) * 2 + (h)) * HTB)
#define PG8_SB(b, h) ((4 + (b) * 2 + (h)) * HTB)
#define PG8_STAGEB(bufoff, gbase) do { _Pragma("unroll") for (int _i = 0; _i < 2; ++_i) \
        __builtin_amdgcn_global_load_lds((const unsigned*)((const char*)(gbase) + voffB[_i]), (LAS unsigned*)(lds + (bufoff) + ldsw + _i * 8192), 16, 0, 0); } while (0)
#define PG8_STAGEA(bufoff, offs, h, kb) do { _Pragma("unroll") for (int _i = 0; _i < 2; ++_i) \
        __builtin_amdgcn_global_load_lds((const unsigned*)(S.A + (kb) + (offs)[(h) * 2 + _i]), (LAS unsigned*)(lds + (bufoff) + ldsw + _i * 8192), 16, 0, 0); } while (0)
#define PG8_LDA(dst, b, h) do { _Pragma("unroll") for (int m = 0; m < 4; ++m) _Pragma("unroll") for (int k = 0; k < 2; ++k) dst[m][k] = *(const LAS bf16x8*)(lds + PG8_SA(b, h) + aoff + m * 2048 + k * 1024); } while (0)
#define PG8_LDB(dst, b, h) do { _Pragma("unroll") for (int n = 0; n < 2; ++n) _Pragma("unroll") for (int k = 0; k < 2; ++k) dst[n][k] = *(const LAS bf16x8*)(lds + PG8_SB(b, h) + boff + n * 2048 + k * 1024); } while (0)
#define PG8_CAT(x0, x1) __builtin_shufflevector(__builtin_bit_cast(v4i_t, x0), __builtin_bit_cast(v4i_t, x1), 0, 1, 2, 3, 4, 5, 6, 7)
#define PG8_MMA(ai, bj, At, Bt) do { __builtin_amdgcn_s_setprio(1); _Pragma("unroll") for (int m = 0; m < 4; ++m) _Pragma("unroll") for (int n = 0; n < 2; ++n) { \
        if constexpr (FP8) acc[ai][bj][m][n] = __builtin_amdgcn_mfma_scale_f32_16x16x128_f8f6f4(PG8_CAT(Bt[n][0], Bt[n][1]), PG8_CAT(At[m][0], At[m][1]), acc[ai][bj][m][n], 0, 0, 0, 0, 0, 0); \
        else if constexpr (I8) { _Pragma("unroll") for (int k = 0; k < 2; ++k) acc[ai][bj][m][n] = __builtin_bit_cast(f32x4, __builtin_amdgcn_mfma_i32_16x16x64_i8(__builtin_bit_cast(v4i_t, Bt[n][k]), __builtin_bit_cast(v4i_t, At[m][k]), __builtin_bit_cast(v4i_t, acc[ai][bj][m][n]), 0, 0, 0)); } \
        else { _Pragma("unroll") for (int k = 0; k < 2; ++k) acc[ai][bj][m][n] = __builtin_amdgcn_mfma_f32_16x16x32_bf16(Bt[n][k], At[m][k], acc[ai][bj][m][n], 0, 0, 0); } } __builtin_amdgcn_s_setprio(0); } while (0)
#define PG8_WAIT_V(n) asm volatile("s_waitcnt vmcnt(" #n ")" ::: "memory")
#define PG8_WAIT_K do { if constexpr (HALFU) PG8_WAIT_V(6); else PG8_WAIT_V(8); } while (0)
#define PG8_WAIT_L(n) asm volatile("s_waitcnt lgkmcnt(" #n ")" ::: "memory")
#define PG8_BAR __builtin_amdgcn_s_barrier()
#define PG8_SCHED __builtin_amdgcn_sched_barrier(0)
#define PG8_OFFS(dst, u) do { _Pragma("unroll") for (int _h = 0; _h < 2; ++_h) _Pragma("unroll") for (int _i = 0; _i < 2; ++_i) dst[_h * 2 + _i] = S.row_off(u, _h * HALF + Rl[_i]) + (unsigned)Cl2[_i]; } while (0)
#define PG8_KLOOP(HALFC) \
        for (int t = 0; t < nt; t += 2) { \
            const bool last = (t == nt - 2); \
            const int t1 = KREP > 1 ? (t + 1) % nt1 : t + 1, t2 = KREP > 1 ? (t + 2) % nt1 : t + 2, t3 = KREP > 1 ? (t + 3) % nt1 : t + 3; \
            const size_t a1 = (size_t)t1 * kstep; \
            const size_t a2 = last ? (size_t)0 : (size_t)t2 * kstep; const size_t a3 = a2 + kstep; \
            const char* b2 = last ? S.b_ptr(nxt, 0) : S.b_ptr(cur, t2); \
            const char* b3 = last ? S.b_ptr(nxt, 1) : S.b_ptr(cur, t3); \
 \
            PG8_LDB(B0, 0, 0); PG8_LDB(B1, 0, 1); PG8_SCHED; PG8_LDA(At, 0, 0); if constexpr (!(HALFC)) PG8_STAGEA(PG8_SA(1, 1), offC, 1, a1); \
            if (last && has_next) { PG8_OFFS(offC, nxt); } \
            PG8_WAIT_K; PG8_WAIT_L(0); PG8_BAR; PG8_MMA(0, 0, At, B0); PG8_MMA(0, 1, At, B1); PG8_BAR; PG8_SCHED; \
 \
            if constexpr (!(HALFC)) PG8_LDA(At, 0, 1); PG8_STAGEB(PG8_SB(0, 0), b2); PG8_STAGEB(PG8_SB(0, 1), b2 + hstepB); PG8_STAGEA(PG8_SA(0, 0), offC, 0, a2); \
            PG8_WAIT_K; PG8_WAIT_L(0); PG8_BAR; if constexpr (!(HALFC)) { PG8_MMA(1, 0, At, B0); PG8_MMA(1, 1, At, B1); } PG8_BAR; PG8_SCHED; \
 \
            PG8_LDB(B0, 1, 0); PG8_LDB(B1, 1, 1); PG8_SCHED; PG8_LDA(At, 1, 0); if constexpr (!(HALFC)) PG8_STAGEA(PG8_SA(0, 1), offC, 1, a2); \
            PG8_WAIT_K; PG8_WAIT_L(0); PG8_BAR; PG8_MMA(0, 0, At, B0); PG8_MMA(0, 1, At, B1); PG8_BAR; PG8_SCHED; \
 \
            if constexpr (!(HALFC)) PG8_LDA(At, 1, 1); PG8_STAGEB(PG8_SB(1, 0), b3); PG8_STAGEB(PG8_SB(1, 1), b3 + hstepB); PG8_STAGEA(PG8_SA(1, 0), offC, 0, a3); \
            PG8_WAIT_K; PG8_WAIT_L(0); PG8_BAR; if constexpr (!(HALFC)) { PG8_MMA(1, 0, At, B0); PG8_MMA(1, 1, At, B1); } PG8_BAR; PG8_SCHED; \
            if constexpr (Epi::HAS_PRE) { if (t == 0) E.pre_store(pre_, lds); } \
        }
    Unit cur, nxt; int ui = 0;
    if (!S.next(0, cur)) return;
    if (SKEW_TICKS > 0) { const unsigned long long t0 = __builtin_amdgcn_s_memrealtime(), dl = (unsigned long long)((blockIdx.x >> 3) & 7) * SKEW_TICKS; while (__builtin_amdgcn_s_memrealtime() - t0 < dl) __builtin_amdgcn_s_sleep(8); }
    f32x4 acc[2][2][4][2];
#pragma unroll
    for (int a = 0; a < 2; ++a)
#pragma unroll
        for (int b = 0; b < 2; ++b)
#pragma unroll
            for (int m = 0; m < 4; ++m)
#pragma unroll
                for (int n = 0; n < 2; ++n) acc[a][b][m][n] = (f32x4){0.f, 0.f, 0.f, 0.f};
    bf16x8 At[4][2], B0[2][2], B1[2][2];
    unsigned offC[4];
    PG8_OFFS(offC, cur);
    const char* cB0 = S.b_ptr(cur, 0); const char* cB1 = S.b_ptr(cur, 1);
    PG8_STAGEB(PG8_SB(0, 0), cB0); PG8_STAGEB(PG8_SB(0, 1), cB0 + hstepB); PG8_STAGEA(PG8_SA(0, 0), offC, 0, 0); if constexpr (!HALFU) PG8_STAGEA(PG8_SA(0, 1), offC, 1, 0);
    if (wr == 1) PG8_BAR;
    if constexpr (HALFU) PG8_WAIT_V(0); else PG8_WAIT_V(2);
    PG8_BAR;
    PG8_STAGEB(PG8_SB(1, 0), cB1); PG8_STAGEA(PG8_SA(1, 0), offC, 0, kstep); PG8_STAGEB(PG8_SB(1, 1), cB1 + hstepB);
    PG8_WAIT_V(6); PG8_BAR;
    for (;;) {
        const bool has_next = S.next(ui + 1, nxt);
        if (!has_next) nxt = cur;
        typename Epi::Pre pre_ = E.pre_load(cur);
        PG8_KLOOP(HALFU)
        if (wr == 0) PG8_BAR;
        if constexpr (KREP > 1) {
#pragma unroll
            for (int a = 0; a < 2; ++a)
#pragma unroll
                for (int b = 0; b < 2; ++b)
#pragma unroll
                    for (int m = 0; m < 4; ++m)
#pragma unroll
                        for (int n = 0; n < 2; ++n) acc[a][b][m][n] = acc[a][b][m][n] * (1.0f / KREP); }
        E(acc, cur, wr, wc, fr, fq, lds);
        if (!has_next) break;
#pragma unroll
        for (int a = 0; a < 2; ++a)
#pragma unroll
            for (int b = 0; b < 2; ++b)
#pragma unroll
                for (int m = 0; m < 4; ++m)
#pragma unroll
                    for (int n = 0; n < 2; ++n) acc[a][b][m][n] = (f32x4){0.f, 0.f, 0.f, 0.f};
        cur = nxt; ++ui;
        if (wr == 1) PG8_BAR;
    }
    PG8_WAIT_V(0);
    PG8_BAR;
#undef PG8_SA
#undef PG8_SB
#undef PG8_STAGEA
#undef PG8_STAGEB
#undef PG8_LDA
#undef PG8_LDB
#undef PG8_MMA
#undef PG8_CAT
#undef PG8_WAIT_V
#undef PG8_WAIT_L
#undef PG8_WAIT_K
#undef PG8_BAR
#undef PG8_SCHED
#undef PG8_OFFS
#undef PG8_KLOOP
}
}

struct Args {
    const float* x; const float* norm_mix; const float* norm_ffn; const float* pool_w; const float* pool_scale; const float* kv_norm; const float* w_kv; const float* k_norm;
    const float* w_q; const float* q_norm; const float* w_o; const float* w_grp; const float* b_grp; const float* w_rt; const float* b_rt; const float* w_gate; const float* w_up; const float* w_down;
    float* out; unsigned char* ws; int ph_lo, ph_hi;
};
struct Frame {
    LAS unsigned char* lds; int tid, lane, wave, vcu, G;
};

template <bool OUT8> __device__ __forceinline__ void transpose_item(const float* W, int ldw, const float* gk, const float* gn, void* WTv, int ldk, int k0, int n0, int drow0, LAS float* scr, int lane, float scale = 1.f) {
    float v[32];
    const float* src = W + (size_t)(k0 + (lane >> 5)) * ldw + n0 + (lane & 31);
#pragma unroll
    for (int i = 0; i < 32; ++i) v[i] = __builtin_nontemporal_load(src + (size_t)(2 * i) * ldw);
    const int c = lane & 7;
    f32x4 ga = (f32x4){1.f, 1.f, 1.f, 1.f}, gb = ga;
    if (gk) { ga = *(const f32x4*)(gk + k0 + 8 * c); gb = *(const f32x4*)(gk + k0 + 8 * c + 4); }
#pragma unroll
    for (int i = 0; i < 32; ++i) scr[(2 * i + (lane >> 5)) * 33 + (lane & 31)] = v[i];
    LDS_WAIT(); asm volatile("" ::: "memory");
#pragma unroll
    for (int j = 0; j < 4; ++j) { const int n = (lane >> 3) + 8 * j; const LAS float* s = scr + (8 * c) * 33 + n; const float g = (gn ? gn[n0 + n] : 1.f) * scale;
        if constexpr (OUT8) { u32x2 o; o.x = pk4_fp8(s[0 * 33] * ga[0] * g, s[1 * 33] * ga[1] * g, s[2 * 33] * ga[2] * g, s[3 * 33] * ga[3] * g); o.y = pk4_fp8(s[4 * 33] * gb[0] * g, s[5 * 33] * gb[1] * g, s[6 * 33] * gb[2] * g, s[7 * 33] * gb[3] * g);
            __builtin_nontemporal_store(o, (u32x2*)((unsigned char*)WTv + (size_t)(drow0 + n) * ldk + k0 + 8 * c)); }
        else { u32x4 o; o.x = pk2(s[0 * 33] * ga[0] * g, s[1 * 33] * ga[1] * g); o.y = pk2(s[2 * 33] * ga[2] * g, s[3 * 33] * ga[3] * g); o.z = pk2(s[4 * 33] * gb[0] * g, s[5 * 33] * gb[1] * g); o.w = pk2(s[6 * 33] * gb[2] * g, s[7 * 33] * gb[3] * g);
            __builtin_nontemporal_store(o, (u32x4*)((bf16_t*)WTv + (size_t)(drow0 + n) * ldk + k0 + 8 * c)); } }
    LDS_WAIT(); asm volatile("" ::: "memory");
}


__device__ __forceinline__ void strip_item_i8(const float* W, int ldw, const float* gk, unsigned char* WT, float* cscale, int n0, int drow0, LAS float* scr, LAS float* smax, int lane, int wave) {
    const float* src = W + (size_t)(lane >> 5) * ldw + n0 + (lane & 31);
    const int kb0 = wave * 4;
    float amax = 0.f;
    unsigned pk[4][16];
#pragma unroll
    for (int q = 0; q < 4; ++q) { const int kb = kb0 + q;
        float v[32];
#pragma unroll
        for (int i = 0; i < 32; ++i) v[i] = __builtin_nontemporal_load(src + (size_t)(64 * kb + 2 * i) * ldw);
#pragma unroll
        for (int i = 0; i < 32; ++i) { const float g = gk ? gk[64 * kb + 2 * i + (lane >> 5)] : 1.f; v[i] *= g; amax = fmaxf(amax, fabsf(v[i])); }
#pragma unroll
        for (int i = 0; i < 16; ++i) pk[q][i] = cvt_pk_bf16(v[2 * i], v[2 * i + 1]);
    }
    amax = fmaxf(amax, __shfl_xor(amax, 32));
    if (lane < 32) smax[wave * 32 + lane] = amax;
    __syncthreads();
    if (lane < 32) { float m = 0.f;
#pragma unroll
        for (int w = 0; w < NWAVES; ++w) m = fmaxf(m, smax[w * 32 + lane]);
        scr[64 * 33 + lane] = m > 0.f ? 127.0f / m : 0.f; if (wave == 0) cscale[drow0 + lane] = m * (1.0f / 127.0f); }
    const int c = lane & 7;
#pragma unroll
    for (int q = 0; q < 4; ++q) { const int kb = kb0 + q;
#pragma unroll
        for (int i = 0; i < 16; ++i) { scr[(4 * i + (lane >> 5)) * 33 + (lane & 31)] = __builtin_bit_cast(float, pk[q][i] << 16); scr[(4 * i + 2 + (lane >> 5)) * 33 + (lane & 31)] = __builtin_bit_cast(float, pk[q][i] & 0xffff0000u); }
        LDS_WAIT(); asm volatile("" ::: "memory");
#pragma unroll
        for (int j = 0; j < 4; ++j) { const int n = (lane >> 3) + 8 * j; const LAS float* s = scr + (8 * c) * 33 + n; const float qs = scr[64 * 33 + n];
            u32x2 o; o.x = pk4_i8(s[0 * 33] * qs, s[1 * 33] * qs, s[2 * 33] * qs, s[3 * 33] * qs); o.y = pk4_i8(s[4 * 33] * qs, s[5 * 33] * qs, s[6 * 33] * qs, s[7 * 33] * qs);
            *(u32x2*)(WT + (size_t)(drow0 + n) * DM + 64 * kb + 8 * c) = o; }
        LDS_WAIT(); asm volatile("" ::: "memory");
    }
    __syncthreads();
}

__device__ __forceinline__ void conv_gu_item(const Args& a, int layer, int idx, LAS float* scr, int lane) {
    const int which = idx >> 13, e = (idx >> 9) & 15, rr = idx & 511, kb = rr >> 4, nb = rr & 15, le = layer * NE + e;
    const int f0 = 32 * nb, drow0 = (f0 >> 7) * 256 + which * 128 + (f0 & 127);
    transpose_item<true>((which ? a.w_up : a.w_gate) + (size_t)le * DM * FF, FF, a.norm_ffn + layer * DM, nullptr, a.ws + WS_WGU + (size_t)le * 1024 * DM, DM, 64 * kb, f0, drow0, scr, lane, 64.f);
}
__device__ __forceinline__ void conv_down_item(const Args& a, int layer, int idx, LAS float* scr, int lane) {
    const int e = idx >> 9, rr = idx & 511, kb = rr >> 6, nb = rr & 63, le = layer * NE + e;
    transpose_item<true>(a.w_down + (size_t)le * FF * DM, DM, nullptr, nullptr, a.ws + WS_WD + (size_t)le * DM * FF, FF, 64 * kb, 32 * nb, 32 * nb, scr, lane, 32.f);
}
constexpr int N_GU_ITEMS = 16384, N_DOWN_ITEMS = 8192;
constexpr int Q_GU3 = 10, Q_GU4 = 4, Q_DN4 = 24;
struct FillPlan { int gu3, gu4, dn4, nidle, rank, st3, st4; };
__device__ __forceinline__ FillPlan fill_plan(int units, int G, int vcu) { FillPlan p; const int rem = units % G; p.nidle = rem == 0 ? G : G - rem; p.rank = rem == 0 ? vcu : vcu - rem;
    const long cap = (long)p.nidle * NWAVES; const long g3 = cap * Q_GU3, g4 = g3 + cap * Q_GU4, d4 = cap * Q_DN4;
    p.gu3 = g3 < N_GU_ITEMS ? (int)g3 : N_GU_ITEMS; p.gu4 = g4 < N_GU_ITEMS ? (int)g4 : N_GU_ITEMS; p.dn4 = d4 < N_DOWN_ITEMS ? (int)d4 : N_DOWN_ITEMS;
    p.st3 = p.nidle < 256 ? p.nidle : 256; { const int e = p.st3 + 2 * p.nidle; p.st4 = e < 256 ? e : 256; } return p; }
template <bool DOWN> __device__ __forceinline__ void fill_range(const Args& a, Frame& F, const FillPlan& p, int lo, int hi) {
    if (p.rank < 0) return;
    const int nw = p.nidle * NWAVES; LAS float* scr = (LAS float*)(F.lds + F.wave * 16384);
    for (int idx = lo + p.rank * NWAVES + F.wave; idx < hi; idx += nw) { if (DOWN) conv_down_item(a, 1, idx, scr, F.lane); else conv_gu_item(a, 1, idx, scr, F.lane); }
}
template <bool DOWN> __device__ __forceinline__ void fill_tail(const Args& a, Frame& F, int lo) {
    const int nitems = DOWN ? N_DOWN_ITEMS : N_GU_ITEMS; LAS float* scr = (LAS float*)(F.lds + F.wave * 16384);
    for (int idx = lo + F.vcu * NWAVES + F.wave; idx < nitems; idx += F.G * NWAVES) { if (DOWN) conv_down_item(a, 1, idx, scr, F.lane); else conv_gu_item(a, 1, idx, scr, F.lane); }
}
__device__ __forceinline__ int moe_units_l0(const Args& a) {
    const unsigned* cnt = (const unsigned*)(a.ws + WS_CTL) + CW_CNT; const int lane = threadIdx.x & 63;
    int r = lane < NBKT ? (((int)__hip_atomic_load(cnt + lane * 64, __ATOMIC_RELAXED, __HIP_MEMORY_SCOPE_AGENT) + 255) >> 8) : 0;
#pragma unroll
    for (int o = 1; o < 64; o <<= 1) r += __shfl_xor(r, o);
    return 8 * __builtin_amdgcn_readfirstlane(r);
}
constexpr int N_STRIPS = 256;
__device__ __forceinline__ void do_strip(const Args& a, Frame& F, int st) {
    LAS float* scr = (LAS float*)(F.lds + F.wave * 16384); LAS float* smax = (LAS float*)(F.lds + 8 * 16384);
    if (st < 64) strip_item_i8(a.w_q, DM, a.norm_mix + DM, a.ws + WS_WQKV, (float*)(a.ws + WS_CSQKV), 32 * st, 32 * st, scr, smax, F.lane, F.wave);
    else if (st < 192) strip_item_i8(a.w_kv, 2 * DM, a.kv_norm, a.ws + WS_WQKV, (float*)(a.ws + WS_CSQKV), 32 * (st - 64), DM + 32 * (st - 64), scr, smax, F.lane, F.wave);
    else strip_item_i8(a.w_o, DM, nullptr, a.ws + WS_WO, (float*)(a.ws + WS_CSWO), 32 * (st - 192), 32 * (st - 192), scr, smax, F.lane, F.wave);
}
__device__ __forceinline__ void p0_weights(const Args& a, Frame& F) {
    LAS float* scr = (LAS float*)(F.lds + F.wave * 16384);
    const int gw = F.vcu * NWAVES + F.wave, NGW = F.G * NWAVES;
    bf16_t* Wpool = (bf16_t*)(a.ws + WS_WPOOL);
    constexpr int I_POOL = 4 * 8 * 16, NITEMS = I_POOL + N_GU_ITEMS + N_DOWN_ITEMS;
    for (int it = gw; it < NITEMS; it += NGW) {
        int r = it;
        if (r < I_POOL) { const int g = r / 128, rr = r % 128, kb = rr / 16, nb = rr % 16;
            transpose_item<false>(a.pool_w + (size_t)g * PGC * PGC, PGC, a.norm_mix + g * PGC, a.pool_scale + g * PGC, Wpool + (size_t)g * PGC * PGC, PGC, 64 * kb, 32 * nb, 32 * nb, scr, F.lane); continue; } r -= I_POOL;
        if (r < N_GU_ITEMS) { conv_gu_item(a, 0, r, scr, F.lane); continue; } r -= N_GU_ITEMS;
        conv_down_item(a, 0, r, scr, F.lane);
    }
    bf16_t* Wr = (bf16_t*)(a.ws + WS_WR);
    for (int idx = (F.vcu * NTHR + F.tid); idx < 2 * 32 * DM; idx += F.G * NTHR) {
        const int l = idx / (32 * DM), rr = (idx / DM) % 32, k = idx % DM; float v = 0.f;
        if (rr < 16) v = a.w_rt[(((size_t)l * NGRP + (rr >> 2)) * DM + k) * EPG + (rr & 3)];
        else if (rr < 20) v = a.w_grp[((size_t)l * DM + k) * NGRP + (rr - 16)];
        v *= a.norm_ffn[l * DM + k];
        const unsigned hi = f2bf(v); const float rem = v - __builtin_bit_cast(float, hi << 16);
        Wr[idx] = (bf16_t)hi; Wr[2 * 32 * DM + idx] = (bf16_t)f2bf(rem);
    }
}

template <int W> __device__ __forceinline__ void pool_batch(const float* xb, int t0, int rb, int c0, int tid, int lane, int wave, LAS float* rs, LAS float* part,
                                                            f32x4 (&cv)[16], const f32x4 (&hist)[16], f32x4& S, bf16_t* prow) {
    constexpr int NB = 16;
#pragma unroll
    for (int i = 0; i < NB; ++i) cv[i] = __builtin_nontemporal_load((const f32x4*)(xb + (size_t)(t0 + rb + i) * DM + c0));
    bf16_t* xrow = prow + ((long)WS_HB - (long)WS_Q) / 2;
    float q[NB];
#pragma unroll
    for (int i = 0; i < NB; ++i) q[i] = (cv[i].x * cv[i].x + cv[i].y * cv[i].y) + (cv[i].z * cv[i].z + cv[i].w * cv[i].w);
#pragma unroll
    for (int i = 0; i < NB; ++i) q[i] = wave_sum(q[i]);
    if (lane == 0) {
#pragma unroll
        for (int i = 0; i < NB; ++i) part[wave * NB + i] = q[i]; }
    __syncthreads();
    if (tid < NB) { float ss = 0.f;
#pragma unroll
        for (int wv = 0; wv < NWAVES; ++wv) ss += part[wv * NB + tid];
        rs[16 + rb + tid] = 1.0f / sqrtf(ss * (1.0f / DM) + EPS); }
    __syncthreads();
#pragma unroll
    for (int i = 0; i < NB; ++i) { const int r = rb + i, t = t0 + r;
        { u32x2 xo; xo.x = cvt_pk_bf16(cv[i].x, cv[i].y); xo.y = cvt_pk_bf16(cv[i].z, cv[i].w); *(u32x2*)(xrow + (size_t)r * DM) = xo; }
        cv[i] = cv[i] * rs[r + 16];
        S += cv[i];
        const float inv = 1.0f / (float)((t + 1 < W) ? (t + 1) : W);
        const f32x4 p = S * inv - cv[i];
        u32x2 o; o.x = pk2(p.x, p.y); o.y = pk2(p.z, p.w);
        *(u32x2*)(prow + (size_t)r * DM) = o;
        if (i - W + 1 >= 0) S -= cv[i - W + 1 >= 0 ? i - W + 1 : 0]; else S -= hist[NB + i - W + 1 < NB ? NB + i - W + 1 : 0]; }
}
template <int W> __device__ __forceinline__ void pool_unit(const float* xb, int t0, int c0, int tid, int lane, int wave, LAS float* rs, LAS float* part, bf16_t* prow) {
    f32x4 A[16], B[16]; f32x4 S = (f32x4){0.f, 0.f, 0.f, 0.f};
#pragma unroll
    for (int r = 0; r < 16; ++r) { B[r] = (f32x4){0.f, 0.f, 0.f, 0.f};
        if (16 - r < W) { int t = t0 - (16 - r); t = t < 0 ? 0 : t; B[r] = *(const f32x4*)(xb + (size_t)t * DM + c0) * rs[r]; S += B[r]; } }
#pragma unroll 1
    for (int rb = 0; rb < 128; rb += 32) {
        pool_batch<W>(xb, t0, rb, c0, tid, lane, wave, rs, part, A, B, S, prow);
        pool_batch<W>(xb, t0, rb + 16, c0, tid, lane, wave, rs, part, B, A, S, prow);
    }
}
__device__ __forceinline__ void p0_pool(const Args& a, Frame& F, bf16_t* pooled) {
    constexpr int TC = 128;
    LAS float* rs = (LAS float*)(F.lds);
    LAS float* part = (LAS float*)(F.lds + 1024);
    const int c0 = F.tid * 4, gi = c0 / PGC;
    for (int u = F.vcu; u < T / TC; u += F.G) {
        const int b = u / (SEQ / TC), t0 = (u % (SEQ / TC)) * TC;
        const float* xb = a.x + (size_t)b * SEQ * DM;
        __syncthreads();
        { const int rg = F.wave * 2 - 16;
          f32x4 v[2][8];
#pragma unroll
          for (int q = 0; q < 2; ++q) { int t = t0 + rg + q; t = t < 0 ? 0 : t; const f32x4* xr = (const f32x4*)(xb + (size_t)t * DM) + F.lane;
#pragma unroll
              for (int j = 0; j < 8; ++j) v[q][j] = xr[64 * j]; }
#pragma unroll
          for (int q = 0; q < 2; ++q) { const int r = rg + q, t = t0 + r; float ss = 0.f;
#pragma unroll
              for (int j = 0; j < 8; ++j) ss += (v[q][j].x * v[q][j].x + v[q][j].y * v[q][j].y) + (v[q][j].z * v[q][j].z + v[q][j].w * v[q][j].w);
              ss = wave_sum(ss);
              if (F.lane == 0) rs[r + 16] = (t >= 0) ? 1.0f / sqrtf(ss * (1.0f / DM) + EPS) : 0.f; } }
        __syncthreads();
        bf16_t* prow = pooled + ((size_t)b * SEQ + t0) * DM + c0;
        if (gi == 0) pool_unit<2>(xb, t0, c0, F.tid, F.lane, F.wave, rs, part, prow);
        else if (gi == 1) pool_unit<4>(xb, t0, c0, F.tid, F.lane, F.wave, rs, part, prow);
        else if (gi == 2) pool_unit<8>(xb, t0, c0, F.tid, F.lane, F.wave, rs, part, prow);
        else pool_unit<16>(xb, t0, c0, F.tid, F.lane, F.wave, rs, part, prow);
    }
    __syncthreads();
}

struct SchedPlain {
    const char* A; const char* B; unsigned lda_bytes, ldb_bytes; int nM, nN, G, vcu; int pool; int rep;
    __device__ __forceinline__ bool next(int i, pg8::Unit& u) const {
        if (G == 256 && (nM & 3) == 0 && (nN & 7) == 0 && ((nM >> 2) * (nN >> 3)) % 8 == 0) {
            const int SN = nN >> 3, nS = (nM >> 2) * SN; int s = i * 8 + (vcu >> 5); if (s >= rep * nS) return false; s %= nS;
            const int c = vcu & 31; u.j = i; u.pm = (s / SN) * 4 + (c >> 3); u.pn = (s % SN) * 8 + (c & 7); u.aux = 0; u.h = 0; return true; }
        int L = i * G + vcu; if (L >= rep * nM * nN) return false; L %= nM * nN; u.j = i; u.pm = L / nN; u.pn = L % nN; u.aux = 0; u.h = 0; return true; }
    __device__ __forceinline__ unsigned row_off(const pg8::Unit& u, int r) const { return (unsigned)(u.pm * 256 + r) * lda_bytes + (pool ? (unsigned)(u.pn >> 1) * (PGC * 2) : 0u); }
    __device__ __forceinline__ const char* b_ptr(const pg8::Unit& u, int kt) const { return B + (size_t)u.pn * 256 * ldb_bytes + (size_t)kt * 128; }
};

struct EpiPool {
    static constexpr bool HAS_PRE = false; struct Pre {}; __device__ __forceinline__ Pre pre_load(const pg8::Unit&) const { return Pre{}; } __device__ __forceinline__ void pre_store(const Pre&, LAS unsigned char*) const {}
    const bf16_t* xc; bf16_t* out; unsigned char* out8;
    __device__ __forceinline__ void operator()(const f32x4 (&acc)[2][2][4][2], const pg8::Unit& u, int wr, int wc, int fr, int fq, LAS unsigned char*) const {
        const int row0 = u.pm * 256 + wr * 64 + fr, col0 = u.pn * 256 + wc * 32 + 8 * fq;
#pragma unroll
        for (int ai = 0; ai < 2; ++ai) {
            u32x4 xv[4][2];
#pragma unroll
            for (int m = 0; m < 4; ++m) { const size_t ro = (size_t)(row0 + ai * 128 + m * 16) * DM + col0;
#pragma unroll
                for (int bj = 0; bj < 2; ++bj) xv[m][bj] = *(const u32x4*)(xc + ro + bj * 128); }
            asm volatile("" ::: "memory");
#pragma unroll
            for (int m = 0; m < 4; ++m) { const size_t ro = (size_t)(row0 + ai * 128 + m * 16) * DM + col0;
#pragma unroll
                for (int bj = 0; bj < 2; ++bj) { const u32x4 h4 = xv[m][bj];
                    const f32x4 v0 = acc[ai][bj][m][0] + (f32x4){bflo(h4.x), bfhi(h4.x), bflo(h4.y), bfhi(h4.y)}, v1 = acc[ai][bj][m][1] + (f32x4){bflo(h4.z), bfhi(h4.z), bflo(h4.w), bfhi(h4.w)};
                    u32x4 w; w.x = cvt_pk_bf16(v0[0], v0[1]); w.y = cvt_pk_bf16(v0[2], v0[3]); w.z = cvt_pk_bf16(v1[0], v1[1]); w.w = cvt_pk_bf16(v1[2], v1[3]);
                    *(u32x4*)(out + ro + bj * 128) = w;
                    u32x2 w8; w8.x = pk4_fp8(v0[0], v0[1], v0[2], v0[3]); w8.y = pk4_fp8(v1[0], v1[1], v1[2], v1[3]); *(u32x2*)(out8 + ro + bj * 128) = w8; } }
            asm volatile("" ::: "memory"); }
    }
};


__device__ __forceinline__ void bucket_experts(int b, int& ge_lo, int& ge_hi) { const int g = b / 6, p = b % 6; const int el = p < 3 ? 0 : (p < 5 ? 1 : 2), eh = p < 3 ? p + 1 : (p < 5 ? p - 1 : 3); ge_lo = g * 4 + el; ge_hi = g * 4 + eh; }
__device__ __forceinline__ void router_phase(const Args& a, Frame& F, const bf16_t* h, int layer) {
    const char* Wh = (const char*)((const bf16_t*)(a.ws + WS_WR) + (size_t)layer * 32 * DM); const char* Wl = Wh + (size_t)2 * 32 * DM * 2;
    unsigned* cnt = (unsigned*)(a.ws + WS_CTL) + CW_CNT + layer * NBKT * 64;
    int* list = (int*)(a.ws + WS_LIST); f32x4* meta = (f32x4*)(a.ws + WS_META);
    LAS char* lds = (LAS char*)F.lds;
    LAS float* lg = (LAS float*)(F.lds + 98304 + F.wave * 2048);
    LAS unsigned* bc = (LAS unsigned*)(F.lds + 98304 + 16384);
    const int tk = F.lane & 15, q = F.lane >> 4, wid = F.wave;
    unsigned wsrc[4];
#pragma unroll
    for (int i = 0; i < 4; ++i) { const int p = i * 512 + F.tid, row = (p >> 5) & 31, cp = p & 31; wsrc[i] = (unsigned)(row * (DM * 2) + ((cp ^ (row & 15)) * 16)); }
#define RT_STAGE(kc, buf) do { _Pragma("unroll") for (int _i = 0; _i < 4; ++_i) __builtin_amdgcn_global_load_lds((const unsigned*)((_i < 2 ? Wh : Wl) + (size_t)(kc) * 512 + wsrc[_i]), (LAS unsigned*)(lds + (buf) * 32768 + _i * 8192 + wid * 1024), 16, 0, 0); } while (0)
    const int aoffA = tk * 512, aoffB = (16 + tk) * 512;
    for (int bt = F.vcu; bt < T / 128; bt += F.G) {
        const int tok0 = bt * 128 + wid * 16;
        __syncthreads();
        if (F.tid < 64) bc[F.tid] = 0u;
        f32x4 c0 = {0.f, 0.f, 0.f, 0.f}, c1 = c0, css = c0;
        const bf16_t* hp = h + (size_t)(tok0 + tk) * DM + 8 * q;
        bf16x8 hf[8];
        bf16x8 hn[8], hnn[8];
        RT_STAGE(0, 0);
#pragma unroll
        for (int s = 0; s < 8; ++s) hf[s] = *(const bf16x8*)(hp + 32 * s);
        RT_STAGE(1, 1);
#pragma unroll
        for (int s = 0; s < 8; ++s) hn[s] = *(const bf16x8*)(hp + 256 + 32 * s);
        for (int kc = 0; kc < 8; ++kc) {
            if (kc < 7) asm volatile("s_waitcnt vmcnt(12)" ::: "memory"); else asm volatile("s_waitcnt vmcnt(0)" ::: "memory");
            __builtin_amdgcn_s_barrier(); asm volatile("" ::: "memory");
            if (kc < 6) { RT_STAGE(kc + 2, (kc + 2) % 3);
#pragma unroll
                for (int s = 0; s < 8; ++s) hnn[s] = *(const bf16x8*)(hp + 256 * (kc + 2) + 32 * s); }
            const LAS char* wb = lds + (kc % 3) * 32768;
#pragma unroll
            for (int s = 0; s < 8; ++s) { const int co = ((4 * s + q) ^ tk) * 16;
                const bf16x8 a0 = *(const LAS bf16x8*)(wb + aoffA + co), a1 = *(const LAS bf16x8*)(wb + aoffB + co), a0l = *(const LAS bf16x8*)(wb + 16384 + aoffA + co), a1l = *(const LAS bf16x8*)(wb + 16384 + aoffB + co);
                c0 = __builtin_amdgcn_mfma_f32_16x16x32_bf16(a0, hf[s], c0, 0, 0, 0); c0 = __builtin_amdgcn_mfma_f32_16x16x32_bf16(a0l, hf[s], c0, 0, 0, 0);
                c1 = __builtin_amdgcn_mfma_f32_16x16x32_bf16(a1, hf[s], c1, 0, 0, 0); c1 = __builtin_amdgcn_mfma_f32_16x16x32_bf16(a1l, hf[s], c1, 0, 0, 0);
                css = __builtin_amdgcn_mfma_f32_16x16x32_bf16(hf[s], hf[s], css, 0, 0, 0); }
            asm volatile("s_waitcnt lgkmcnt(0)" ::: "memory");
#pragma unroll
            for (int s = 0; s < 8; ++s) { hf[s] = hn[s]; hn[s] = hnn[s]; }
        }
#pragma unroll
        for (int r = 0; r < 4; ++r) lg[tk * 24 + 4 * q + r] = c0[r];
        if (q == 0) {
#pragma unroll
            for (int r = 0; r < 4; ++r) lg[tk * 24 + 16 + r] = c1[r]; }
        if (q == (tk >> 2)) { const int rr = tk & 3; lg[384 + tk] = rr == 0 ? css[0] : (rr == 1 ? css[1] : (rr == 2 ? css[2] : css[3])); }
        LDS_WAIT(); asm volatile("" ::: "memory");
        int b = 0; unsigned lpos = 0; float rstd = 0.f, wlo = 0.f, whi = 0.f;
        if (F.lane < 16) {
            rstd = 1.0f / sqrtf(lg[384 + tk] * (1.0f / DM) + EPS);
            float gl[4], el[4];
#pragma unroll
            for (int g = 0; g < 4; ++g) gl[g] = lg[tk * 24 + 16 + g] * rstd + a.b_grp[layer * NGRP + g];
            int gs = 0; float gm = gl[0];
#pragma unroll
            for (int g = 1; g < 4; ++g) if (gl[g] > gm) { gm = gl[g]; gs = g; }
            float den = 0.f;
#pragma unroll
            for (int g = 0; g < 4; ++g) den += __expf(gl[g] - gm);
            const float gwt = 1.0f / den;
#pragma unroll
            for (int e = 0; e < 4; ++e) el[e] = lg[tk * 24 + gs * 4 + e] * rstd + a.b_rt[(layer * NGRP + gs) * EPG + e];
            int i1 = 0; float v1 = el[0];
#pragma unroll
            for (int e = 1; e < 4; ++e) if (el[e] > v1) { v1 = el[e]; i1 = e; }
            int i2 = -1; float v2 = -3.0e38f;
#pragma unroll
            for (int e = 0; e < 4; ++e) if (e != i1 && el[e] > v2) { v2 = el[e]; i2 = e; }
            const float w1 = gwt / (1.0f + __expf(v2 - v1)), w2 = gwt - w1;
            const int elo = i1 < i2 ? i1 : i2, ehi = i1 < i2 ? i2 : i1; wlo = i1 < i2 ? w1 : w2; whi = i1 < i2 ? w2 : w1;
            const int pidx = elo == 0 ? ehi - 1 : (elo == 1 ? ehi + 1 : 5);
            b = gs * 6 + pidx;
            lpos = __hip_atomic_fetch_add(bc + b, 1u, __ATOMIC_RELAXED, __HIP_MEMORY_SCOPE_WORKGROUP);
        }
        __syncthreads();
        if (F.tid < NBKT) { const unsigned n = bc[F.tid]; bc[32 + F.tid] = n ? __hip_atomic_fetch_add(cnt + F.tid * 64, n, __ATOMIC_RELAXED, __HIP_MEMORY_SCOPE_AGENT) : 0u; }
        __syncthreads();
        if (F.lane < 16) { const unsigned pos = bc[32 + b] + lpos;
            list[(size_t)b * T + pos] = tok0 + tk;
            meta[(size_t)b * T + pos] = (f32x4){rstd, wlo, whi, 0.f}; }
    }
#undef RT_STAGE
    asm volatile("s_waitcnt vmcnt(0)" ::: "memory"); __syncthreads();
}

constexpr int MAXU = 8;
struct MoeTab { LAS int* ud; LAS unsigned* rowtab; };
__device__ __forceinline__ void moe_build(const Args& a, Frame& F, int layer, int gather) {
    LAS int* ud = (LAS int*)(F.lds + UDESC_OFF); LAS int* tb = ud + MAXU * 8;
    LAS unsigned* rowtab = (LAS unsigned*)(F.lds + ROWTAB_OFF);
    const unsigned* cnt = (const unsigned*)(a.ws + WS_CTL) + CW_CNT + layer * NBKT * 64;
    const int* list = (const int*)(a.ws + WS_LIST);
    __syncthreads();
    if (F.tid < NBKT) tb[32 + F.tid] = (int)__hip_atomic_load(cnt + F.tid * 64, __ATOMIC_RELAXED, __HIP_MEMORY_SCOPE_AGENT);
    __syncthreads();
    if (F.tid == 0) { int base = 0; for (int b = 0; b < NBKT; ++b) { tb[b] = base; base += (tb[32 + b] + 255) >> 8; } tb[NBKT] = base; }
    __syncthreads();
    if (F.tid < MAXU) { const int i = F.tid, R = tb[NBKT]; int L = i * F.G + F.vcu; int v = 0, rt = 0, pn = 0, b = 0, ti = 0, nv = 0, hf = 0;
        { const int nf = (8 * R) / F.G, extra = 8 * R - nf * F.G; if (layer == 1 && i == nf && extra > 0 && 2 * extra <= F.G) { if (F.vcu < 2 * extra) { L = nf * F.G + (F.vcu >> 1); hf = 1 + (F.vcu & 1); } else L = 8 * R; } }
        if (L < 8 * R) { v = 1; rt = L >> 3; pn = L & 7; while (tb[b + 1] <= rt) ++b; ti = rt - tb[b]; nv = tb[32 + b] - 256 * ti; if (nv > 256) nv = 256; }
        ud[i * 8 + 0] = rt; ud[i * 8 + 1] = pn; ud[i * 8 + 2] = b; ud[i * 8 + 3] = ti; ud[i * 8 + 4] = nv; ud[i * 8 + 5] = v; ud[i * 8 + 6] = hf;
        if (i == 0) { const int nf = (8 * R) / F.G, extra = 8 * R - nf * F.G; tb[60] = (layer == 1 && extra > 0 && 2 * extra <= F.G && F.vcu < 2 * extra && nf < MAXU) ? nf : -1; } }
    __syncthreads();
    if (gather) for (int e = F.tid; e < MAXU * 256; e += NTHR) { const int i = e >> 8, r = e & 255; unsigned off = 0;
        if (ud[i * 8 + 5]) { const int b = ud[i * 8 + 2], ti = ud[i * 8 + 3], nv = ud[i * 8 + 4]; const int rr = r < nv ? r : nv - 1; off = (unsigned)list[(size_t)b * T + 256 * ti + rr] * (gather == 1 ? (unsigned)DM : 1u); }
        rowtab[e] = off; }
    VM_WAIT(); __syncthreads();
}
__device__ __forceinline__ int rfl(int v) { return __builtin_amdgcn_readfirstlane(v); }
struct SchedMoe {
    const char* A; const char* W; unsigned ldb_bytes; LAS int* ud; LAS unsigned* rowtab; int layer; int down; int halfpass;
    __device__ __forceinline__ bool next(int i, pg8::Unit& u) const { if (halfpass) { if (i > 0) return false; i = rfl(ud[MAXU * 8 + 60]); if (i < 0) return false; } else { if (i >= MAXU) return false; if (rfl(ud[i * 8 + 6]) != 0) return false; }
        if (!rfl(ud[i * 8 + 5])) return false; u.j = i; u.pm = rfl(ud[i * 8 + 0]); u.pn = rfl(ud[i * 8 + 1]); u.aux = rfl(ud[i * 8 + 2]); u.h = rfl(ud[i * 8 + 6]); return true; }
    __device__ __forceinline__ unsigned row_off(const pg8::Unit& u, int r) const { r ^= (u.h == 2 ? 128 : 0); return down ? (unsigned)(u.pm * 256 + r) * (unsigned)(2 * FF) : rowtab[u.j * 256 + r]; }
    __device__ __forceinline__ const char* b_ptr(const pg8::Unit& u, int kt) const {
        int gl, gh; bucket_experts(u.aux, gl, gh);
        if (!down) { const int ge = u.pn < 4 ? gl : gh; return W + ((size_t)(layer * NE + ge) * 1024 + (size_t)(u.pn & 3) * 256) * (size_t)DM + (size_t)kt * 128; }
        const int ge = kt < 4 ? gl : gh; return W + ((size_t)(layer * NE + ge) * DM + (size_t)u.pn * 256) * (size_t)FF + (size_t)(kt & 3) * 128;
    }
};
struct EpiSwiGLU {
    const f32x4* meta; unsigned char* H; LAS int* ud;
    static constexpr bool HAS_PRE = true; struct Pre { float a, b; };
    __device__ __forceinline__ Pre pre_load(const pg8::Unit& u) const { Pre p{0.f, 0.f}; const int t = threadIdx.x;
        if (t < 256) { const float* mp = (const float*)(meta + (size_t)u.aux * T + 256 * rfl(ud[u.j * 8 + 3]) + t); p.a = mp[0]; p.b = mp[1 + (u.pn >> 2)]; } return p; }
    __device__ __forceinline__ void pre_store(const Pre& p, LAS unsigned char* lds) const { const int t = threadIdx.x; if (t < 256) { LAS float* tb = (LAS float*)(lds + EX_OFF); tb[2 * t] = p.a; tb[2 * t + 1] = p.b; } }
    __device__ __forceinline__ void operator()(const f32x4 (&acc)[2][2][4][2], const pg8::Unit& u, int wr, int wc, int fr_, int fq, LAS unsigned char* lds) const {
        int fr = fr_;
        const int hi = u.pn >> 2; const LAS float* tb = (const LAS float*)(lds + EX_OFF);
        const int hcol = hi * 512 + (u.pn & 3) * 128 + wc * 32 + 8 * fq;
        const int rx = u.h == 2 ? 128 : 0, nai = u.h ? 1 : 2;
        asm volatile("" : "+v"(fr));
        float rsv[2][4], wv[2][4];
#pragma unroll
        for (int ai = 0; ai < 2; ++ai)
#pragma unroll
            for (int m = 0; m < 4; ++m) { const int r = (ai * 128 + wr * 64 + m * 16 + fr) ^ rx; rsv[ai][m] = tb[2 * r]; wv[ai][m] = tb[2 * r + 1]; }
        asm volatile("" ::: "memory");
#pragma unroll
        for (int ai = 0; ai < 2; ++ai)
#pragma unroll
            for (int m = 0; m < 4; ++m) { if (ai >= nai) continue; const int r = (ai * 128 + wr * 64 + m * 16 + fr) ^ rx; const float rstd = rsv[ai][m] * (1.0f / 64.0f), w = wv[ai][m] * 8.0f;
                const float c1 = -rstd * 1.4426950408889634f, kr = rstd * rstd * w;
                f32x4 ov[2];
#pragma unroll
                for (int n = 0; n < 2; ++n) { const f32x4 ga = acc[ai][0][m][n], ua = acc[ai][1][m][n]; const f32x4 x = ga * c1;
                    f32x4 d; d[0] = __builtin_amdgcn_exp2f(x[0]); d[1] = __builtin_amdgcn_exp2f(x[1]); d[2] = __builtin_amdgcn_exp2f(x[2]); d[3] = __builtin_amdgcn_exp2f(x[3]);
                    d = d + 1.0f;
                    f32x4 r; r[0] = __builtin_amdgcn_rcpf(d[0]); r[1] = __builtin_amdgcn_rcpf(d[1]); r[2] = __builtin_amdgcn_rcpf(d[2]); r[3] = __builtin_amdgcn_rcpf(d[3]);
                    ov[n] = ((ga * ua) * kr) * r; }
                u32x2 pk; pk.x = pk4_fp8(ov[0][0], ov[0][1], ov[0][2], ov[0][3]); pk.y = pk4_fp8(ov[1][0], ov[1][1], ov[1][2], ov[1][3]);
                *(u32x2*)(H + (size_t)(u.pm * 256 + r) * (2 * FF) + hcol) = pk; }
    }
};
template <bool OUT_F32> struct EpiDown {
    static constexpr bool HAS_PRE = false; struct Pre {}; __device__ __forceinline__ Pre pre_load(const pg8::Unit&) const { return Pre{}; } __device__ __forceinline__ void pre_store(const Pre&, LAS unsigned char*) const {}
    const LAS unsigned* rowtab; const bf16_t* hin; void* out; LAS int* ud;
    __device__ __forceinline__ void operator()(const f32x4 (&acc)[2][2][4][2], const pg8::Unit& u, int wr, int wc, int fr_, int fq, LAS unsigned char*) const {
        int fr = fr_;
        const int nv = rfl(ud[u.j * 8 + 4]);
        const int col0 = u.pn * 256 + wc * 32 + 8 * fq;
        const int rx = u.h == 2 ? 128 : 0, nai = u.h ? 1 : 2;
        asm volatile("" : "+v"(fr));
        int tok[2][4];
#pragma unroll
        for (int ai = 0; ai < 2; ++ai)
#pragma unroll
            for (int m = 0; m < 4; ++m) { const int r = (ai * 128 + wr * 64 + m * 16 + fr) ^ rx; tok[ai][m] = (int)(rowtab[u.j * 256 + r] >> 11); }
#pragma unroll
        for (int ai = 0; ai < 2; ++ai) if (ai < nai) {
            u32x4 hv[4][2];
#pragma unroll
            for (int m = 0; m < 4; ++m) { const size_t ro = (size_t)tok[ai][m] * DM + col0;
#pragma unroll
                for (int bj = 0; bj < 2; ++bj) hv[m][bj] = *(const u32x4*)(hin + ro + bj * 128); }
            asm volatile("" ::: "memory");
#pragma unroll
            for (int m = 0; m < 4; ++m) { const int r = (ai * 128 + wr * 64 + m * 16 + fr) ^ rx; const size_t ro = (size_t)tok[ai][m] * DM + col0;
                if (r < nv) {
#pragma unroll
                    for (int bj = 0; bj < 2; ++bj) { const u32x4 h4 = hv[m][bj];
                        const f32x4 v0 = acc[ai][bj][m][0] * (1.0f / 256.0f) + (f32x4){bflo(h4.x), bfhi(h4.x), bflo(h4.y), bfhi(h4.y)}, v1 = acc[ai][bj][m][1] * (1.0f / 256.0f) + (f32x4){bflo(h4.z), bfhi(h4.z), bflo(h4.w), bfhi(h4.w)};
                        if (OUT_F32) { float* o = (float*)out + ro + bj * 128; __builtin_nontemporal_store(v0, (f32x4*)o); __builtin_nontemporal_store(v1, (f32x4*)(o + 4)); }
                        else { u32x4 w; w.x = cvt_pk_bf16(v0[0], v0[1]); w.y = cvt_pk_bf16(v0[2], v0[3]); w.z = cvt_pk_bf16(v1[0], v1[1]); w.w = cvt_pk_bf16(v1[2], v1[3]); *(u32x4*)((bf16_t*)out + ro + bj * 128) = w; } } } }
            asm volatile("" ::: "memory"); }
    }
};


typedef __bf16 bf2_t __attribute__((ext_vector_type(2)));
typedef unsigned short us2_t __attribute__((ext_vector_type(2)));
__device__ __forceinline__ float wave_max(float v) {
    v = fmaxf(v, dpp_f<0xB1>(v)); v = fmaxf(v, dpp_f<0x4E>(v)); v = fmaxf(v, dpp_f<0x141>(v)); v = fmaxf(v, dpp_f<0x140>(v));
    return max_xor32(max_xor16(v));
}
__device__ __forceinline__ void rowpass_phase(Frame& F, const bf16_t* h, float* rstd, float* rscale, unsigned char* a8) {
    const int gw = F.vcu * NWAVES + F.wave, NGW = F.G * NWAVES;
    constexpr int RB = 4;
    for (int row0 = gw * RB; row0 < T; row0 += NGW * RB) {
        u32x4 v[RB][4];
#pragma unroll
        for (int q = 0; q < RB; ++q) { const u32x4* p = (const u32x4*)(h + (size_t)(row0 + q) * DM) + F.lane;
#pragma unroll
            for (int j = 0; j < 4; ++j) v[q][j] = p[64 * j]; }
#pragma unroll
        for (int q = 0; q < RB; ++q) { float ss = 0.f, am = 0.f;
            us2_t mx = (us2_t){0, 0};
#pragma unroll
            for (int j = 0; j < 4; ++j) {
#pragma unroll
                for (int e = 0; e < 4; ++e) { const unsigned w = v[q][j][e]; ss = __builtin_amdgcn_fdot2_f32_bf16(__builtin_bit_cast(bf2_t, w), __builtin_bit_cast(bf2_t, w), ss, false);
                    mx = __builtin_elementwise_max(mx, __builtin_bit_cast(us2_t, w & 0x7fff7fffu)); } }
            { const unsigned mw = __builtin_bit_cast(unsigned, mx); am = fmaxf(bflo(mw), bfhi(mw)); }
            ss = wave_sum(ss); am = wave_max(am);
            const float qs = am > 0.f ? 127.0f / am : 0.f; const int row = row0 + q;
            if (F.lane == 0) { rstd[row] = 1.0f / sqrtf(ss * (1.0f / DM) + EPS); rscale[row] = am * (1.0f / 127.0f); }
            u32x2* o = (u32x2*)(a8 + (size_t)row * DM) + F.lane;
#pragma unroll
            for (int j = 0; j < 4; ++j) { u32x2 w; w.x = pk4_i8(bflo(v[q][j].x) * qs, bfhi(v[q][j].x) * qs, bflo(v[q][j].y) * qs, bfhi(v[q][j].y) * qs); w.y = pk4_i8(bflo(v[q][j].z) * qs, bfhi(v[q][j].z) * qs, bflo(v[q][j].w) * qs, bfhi(v[q][j].w) * qs); o[64 * j] = w; } }
    }
}

struct EpiRes {
    static constexpr bool HAS_PRE = false; struct Pre {}; __device__ __forceinline__ Pre pre_load(const pg8::Unit&) const { return Pre{}; } __device__ __forceinline__ void pre_store(const Pre&, LAS unsigned char*) const {}
    const bf16_t* hin; bf16_t* out; unsigned char* out8; const float* cscale; float os;
    __device__ __forceinline__ void operator()(const f32x4 (&acc)[2][2][4][2], const pg8::Unit& u, int wr, int wc, int fr, int fq, LAS unsigned char*) const {
        const int row0 = u.pm * 256 + wr * 64 + fr, col0 = u.pn * 256 + wc * 32 + 8 * fq;
        f32x4 cs[2][2];
#pragma unroll
        for (int bj = 0; bj < 2; ++bj) { cs[bj][0] = *(const f32x4*)(cscale + col0 + bj * 128) * os; cs[bj][1] = *(const f32x4*)(cscale + col0 + bj * 128 + 4) * os; }
#pragma unroll
        for (int ai = 0; ai < 2; ++ai) {
            u32x4 hv[4][2];
#pragma unroll
            for (int m = 0; m < 4; ++m) { const size_t ro = (size_t)(row0 + ai * 128 + m * 16) * DM + col0;
#pragma unroll
                for (int bj = 0; bj < 2; ++bj) hv[m][bj] = *(const u32x4*)(hin + ro + bj * 128); }
            asm volatile("" ::: "memory");
#pragma unroll
            for (int m = 0; m < 4; ++m) { const size_t ro = (size_t)(row0 + ai * 128 + m * 16) * DM + col0;
#pragma unroll
                for (int bj = 0; bj < 2; ++bj) { const u32x4 h4 = hv[m][bj];
                    const f32x4 a0 = __builtin_convertvector(__builtin_bit_cast(pg8::v4i_t, acc[ai][bj][m][0]), f32x4), a1 = __builtin_convertvector(__builtin_bit_cast(pg8::v4i_t, acc[ai][bj][m][1]), f32x4);
                    const f32x4 v0 = a0 * cs[bj][0] + (f32x4){bflo(h4.x), bfhi(h4.x), bflo(h4.y), bfhi(h4.y)}, v1 = a1 * cs[bj][1] + (f32x4){bflo(h4.z), bfhi(h4.z), bflo(h4.w), bfhi(h4.w)};
                    u32x4 w; w.x = cvt_pk_bf16(v0[0], v0[1]); w.y = cvt_pk_bf16(v0[2], v0[3]); w.z = cvt_pk_bf16(v1[0], v1[1]); w.w = cvt_pk_bf16(v1[2], v1[3]);
                    *(u32x4*)(out + ro + bj * 128) = w;
                    u32x2 w8; w8.x = pk4_fp8(v0[0], v0[1], v0[2], v0[3]); w8.y = pk4_fp8(v1[0], v1[1], v1[2], v1[3]); *(u32x2*)(out8 + ro + bj * 128) = w8; } }
            asm volatile("" ::: "memory"); }
    }
};


constexpr float QSCALE = 0.08838834764831845f * 1.4426950408889634f;
struct EpiQKV {
    const float* rstd; const float* rscale; const float* cscale; const float* qn; const float* kn; bf16_t* q; unsigned* vmaxw;
    static constexpr bool HAS_PRE = false; struct Pre {}; __device__ __forceinline__ Pre pre_load(const pg8::Unit&) const { return Pre{}; } __device__ __forceinline__ void pre_store(const Pre&, LAS unsigned char*) const {}
    __device__ __forceinline__ void operator()(const f32x4 (&acc)[2][2][4][2], const pg8::Unit& u, int wr, int wc, int fr_, int fq_, LAS unsigned char* lds) const {
        int fr = fr_, fq = fq_; asm volatile("" : "+v"(fr), "+v"(fq));
        const int which = u.pn >> 3, colt = (u.pn & 7) * 256;
        bf16_t* dst = q + (size_t)which * ((WS_K - WS_Q) / 2);
        const int col0 = colt + wc * 32 + 8 * fq;
        LAS float* EX = (LAS float*)(lds + EX_OFF);
        const bool normed = which != 2;
        float rsv[2][4];
#pragma unroll
        for (int ai = 0; ai < 2; ++ai)
#pragma unroll
            for (int m = 0; m < 4; ++m) { const int gr = u.pm * 256 + ai * 128 + wr * 64 + m * 16 + fr; rsv[ai][m] = rstd[gr] * rscale[gr]; }
        f32x4 cs[2][2];
#pragma unroll
        for (int bj = 0; bj < 2; ++bj) { cs[bj][0] = *(const f32x4*)(cscale + u.pn * 256 + wc * 32 + 8 * fq + bj * 128); cs[bj][1] = *(const f32x4*)(cscale + u.pn * 256 + wc * 32 + 8 * fq + bj * 128 + 4); }
        f32x4 g0 = (f32x4){1.f, 1.f, 1.f, 1.f}, g1 = g0;
        if (which == 0) { g0 = *(const f32x4*)(qn + wc * 32 + 8 * fq) * QSCALE; g1 = *(const f32x4*)(qn + wc * 32 + 8 * fq + 4) * QSCALE; }
        if (which == 1) { g0 = *(const f32x4*)(kn + wc * 32 + 8 * fq); g1 = *(const f32x4*)(kn + wc * 32 + 8 * fq + 4); }
#define QKV_CVT(ai, bj, m, n) __builtin_convertvector(__builtin_bit_cast(pg8::v4i_t, acc[ai][bj][m][n]), f32x4)
        f32x4 (&A)[2][2][4][2] = const_cast<f32x4 (&)[2][2][4][2]>(acc);
#pragma unroll
        for (int ai = 0; ai < 2; ++ai)
#pragma unroll
            for (int m = 0; m < 4; ++m)
#pragma unroll
                for (int bj = 0; bj < 2; ++bj) { const f32x4 c0 = QKV_CVT(ai, bj, m, 0) * cs[bj][0], c1 = QKV_CVT(ai, bj, m, 1) * cs[bj][1]; A[ai][bj][m][0] = c0; A[ai][bj][m][1] = c1; }
        if (normed) {
#pragma unroll
            for (int ai = 0; ai < 2; ++ai)
#pragma unroll
                for (int m = 0; m < 4; ++m)
#pragma unroll
                    for (int bj = 0; bj < 2; ++bj) { const f32x4 v0 = A[ai][bj][m][0], v1 = A[ai][bj][m][1];
                        const f32x4 sq = v0 * v0 + v1 * v1; float s = (sq[0] + sq[1]) + (sq[2] + sq[3]);
                        s = add_xor32(add_xor16(s));
                        if (fq == 0) EX[((ai * 128 + wr * 64 + m * 16 + fr) * 2 + bj) * 4 + wc] = s; }
            asm volatile("s_waitcnt lgkmcnt(0)" ::: "memory"); __builtin_amdgcn_s_barrier(); asm volatile("" ::: "memory");
        }
#pragma unroll
        for (int bj = 0; bj < 2; ++bj) { cs[bj][0] = g0; cs[bj][1] = g1; }
        float vmx = 0.f;
#define QKV_PASS2(NORMED) _Pragma("unroll") for (int ai = 0; ai < 2; ++ai) _Pragma("unroll") for (int m = 0; m < 4; ++m) { const int r = ai * 128 + wr * 64 + m * 16 + fr; const size_t ro = (size_t)(u.pm * 256 + r) * DM + col0; \
                const float rs = rsv[ai][m]; \
                _Pragma("unroll") for (int bj = 0; bj < 2; ++bj) { float f = rs; \
                    if (NORMED) { const f32x4 pp = *(const LAS f32x4*)(EX + (r * 2 + bj) * 4); const float tot = ((pp[0] + pp[1]) + (pp[2] + pp[3])) * rs * rs; f = rs * __builtin_amdgcn_rsqf(tot * (1.0f / HD) + EPS); } \
                    const f32x4 v0 = A[ai][bj][m][0] * (cs[bj][0] * f), v1 = A[ai][bj][m][1] * (cs[bj][1] * f); \
                    if (!(NORMED)) { const f32x4 a0 = __builtin_elementwise_abs(v0), a1 = __builtin_elementwise_abs(v1); const f32x4 mx = __builtin_elementwise_max(a0, a1); vmx = fmaxf(vmx, fmaxf(fmaxf(mx[0], mx[1]), fmaxf(mx[2], mx[3]))); } \
                    u32x4 w; w.x = cvt_pk_bf16(v0[0], v0[1]); w.y = cvt_pk_bf16(v0[2], v0[3]); w.z = cvt_pk_bf16(v1[0], v1[1]); w.w = cvt_pk_bf16(v1[2], v1[3]); \
                    __builtin_nontemporal_store(w, (u32x4*)(dst + ro + bj * 128)); } }
        if (normed) { QKV_PASS2(true) } else { QKV_PASS2(false) }
#undef QKV_PASS2
#undef QKV_CVT
        if (!normed) { vmx = wave_max(vmx); if ((threadIdx.x & 63) == 0) __hip_atomic_fetch_max(vmaxw, __float_as_uint(vmx), __ATOMIC_RELAXED, __HIP_MEMORY_SCOPE_AGENT); }
    }
};


typedef short v4i16_t __attribute__((ext_vector_type(4)));
__device__ __forceinline__ s16x4 vtr(const LAS char* p) { return __builtin_bit_cast(s16x4, __builtin_amdgcn_ds_read_tr16_b64_v4i16((LAS v4i16_t*)p)); }
__device__ __forceinline__ unsigned lds_addr(const LAS void* p) { return (unsigned)(unsigned long long)p; }
__device__ __forceinline__ bf16x8 lds_rd128(unsigned a) { bf16x8 v; asm volatile("ds_read_b128 %0, %1" : "=v"(v) : "v"(a) : "memory"); return v; }
__device__ __forceinline__ s16x4 lds_rdtr64(unsigned a) { s16x4 v; asm volatile("ds_read_b64_tr_b16 %0, %1" : "=v"(v) : "v"(a) : "memory"); return v; }
__device__ __forceinline__ void lds_wr32(unsigned a, unsigned v) { asm volatile("ds_write_b32 %0, %1" :: "v"(a), "v"(v) : "memory"); }
__device__ __forceinline__ void attn_phase(Frame& F, const bf16_t* Q, const bf16_t* K, const bf16_t* V, unsigned char* O, const unsigned* vmaxw) {
    const int lane = F.lane, wid = F.wave, tid = F.tid, r32 = lane & 31, hi = lane >> 5;
    LAS char* lds = (LAS char*)F.lds;
    const float vmaxf = __uint_as_float(__hip_atomic_load(vmaxw, __ATOMIC_RELAXED, __HIP_MEMORY_SCOPE_AGENT)); const float oqs = vmaxf > 0.f ? 127.0f / vmaxf : 0.f;
    LAS unsigned* dflag = (LAS unsigned*)(F.lds + MISC_OFF + 64);
    unsigned ksrc, vsrc;
    { const int row = tid >> 4, cp = tid & 15; const int X = ((row & 3) << 2) | ((row >> 2) & 3);
      ksrc = (unsigned)(row * (DM * 2) + ((cp ^ X) * 16)); vsrc = (unsigned)(row * (DM * 2) + ((cp ^ ((row & 3) << 2)) * 16)); }
    const int Xr = ((r32 & 3) << 2) | ((r32 >> 2) & 3);
    const int kbase = 256 * r32 + 16 * (hi ^ Xr);
    const int g4 = lane >> 4, qq = (lane & 15) >> 2, pp = lane & 3;
    int vb[4];
#pragma unroll
    for (int db = 0; db < 4; ++db) vb[db] = 256 * (4 * (g4 >> 1) + qq) + 64 * (db ^ qq) + 32 * (g4 & 1) + 16 * (pp >> 1) + 8 * (pp & 1);
#define AT_STAGE(j) do { const int _j = (j); const char* _kt = kg + (size_t)_j * 32 * (DM * 2); const char* _vt = vg + (size_t)_j * 32 * (DM * 2); LAS char* _d = lds + (_j % 9) * 16384 + wid * 1024; \
        __builtin_amdgcn_global_load_lds((const unsigned*)(_kt + ksrc), (LAS unsigned*)(_d), 16, 0, 0); \
        __builtin_amdgcn_global_load_lds((const unsigned*)(_vt + vsrc), (LAS unsigned*)(_d + 8192), 16, 0, 0); } while (0)
#define AT_UNIT(idx_) do {   \
        const int _i = (idx_); qb = _i & 7; h = (_i >> 3) & 15; b = (BATCH - 1) - (_i >> 7); rowbase = (size_t)b * SEQ; t0w = qb * 256 + wid * 32; \
        kg = (const char*)(K + rowbase * DM + h * HD); vg = (const char*)(V + rowbase * DM + h * HD); } while (0)
#define AT_LOADQ() do { const bf16_t* _qp = Q + (rowbase + t0w + r32) * DM + h * HD + 8 * hi; _Pragma("unroll") for (int s = 0; s < 8; ++s) qf[s] = *(const bf16x8*)(_qp + 16 * s); } while (0)
    constexpr int NUNITS = BATCH * NH * (SEQ / 256);
    int it = 0, idx = F.vcu;
    if (idx >= REP_ATTN * NUNITS) return;
    int qb, b, h, t0w; size_t rowbase; const char* kg; const char* vg;
    bf16x8 qf[8];
    AT_UNIT(idx % NUNITS);
    __builtin_amdgcn_s_barrier();
#pragma unroll 1
    for (int w = 0; w < 8; ++w) AT_STAGE(8 * qb + w);
    AT_LOADQ();
    bool first = true;
    for (;;) {
        const int t = t0w + r32;
        f32x16 o[4];
#pragma unroll
        for (int db = 0; db < 4; ++db)
#pragma unroll
            for (int r = 0; r < 16; ++r) o[db][r] = 0.f;
        float C = 1.0f; bool wdone = false;
        for (int n = 0;; ++n) {
            const int j = 8 * qb + wid - n;
            if (n == 0 && !first) asm volatile("s_waitcnt vmcnt(4)" ::: "memory"); else asm volatile("s_waitcnt vmcnt(0)" ::: "memory");
            __builtin_amdgcn_s_barrier(); asm volatile("" ::: "memory");
            if (n > 0) { const LAS unsigned* df = dflag + ((n - 1) & 1) * 8; const u32x4 f0 = *(const LAS u32x4*)df, f1 = *(const LAS u32x4*)(df + 4);
                if ((f0.x & f0.y & f0.z & f0.w & f1.x & f1.y & f1.z & f1.w) != 0u) break; }
            asm volatile("" : "+v"(qf[0]), "+v"(qf[1]), "+v"(qf[2]), "+v"(qf[3]), "+v"(qf[4]), "+v"(qf[5]), "+v"(qf[6]), "+v"(qf[7]));
            if (8 * qb - n - 1 >= 0) AT_STAGE(8 * qb - n - 1);
            if (j >= 0 && !wdone) {
                const unsigned kba = lds_addr(lds + (j % 9) * 16384);
                bf16x8 kf[8];
                f32x16 p;
#pragma unroll
                for (int r = 0; r < 16; ++r) p[r] = 0.f;
#pragma unroll
                for (int s = 0; s < 8; ++s) kf[s] = lds_rd128(kba + (unsigned)(kbase ^ (32 * s)));
                asm volatile("s_waitcnt lgkmcnt(4)" : "+v"(kf[0]), "+v"(kf[1]), "+v"(kf[2]), "+v"(kf[3]) :: "memory");
#pragma unroll
                for (int s = 0; s < 4; ++s) p = __builtin_amdgcn_mfma_f32_32x32x16_bf16(kf[s], qf[s], p, 0, 0, 0);
                asm volatile("s_waitcnt lgkmcnt(0)" : "+v"(kf[4]), "+v"(kf[5]), "+v"(kf[6]), "+v"(kf[7]) :: "memory");
#pragma unroll
                for (int s = 4; s < 8; ++s) p = __builtin_amdgcn_mfma_f32_32x32x16_bf16(kf[s], qf[s], p, 0, 0, 0);
                s16x4 vt[2][4][2];
#pragma unroll
                for (int db = 0; db < 4; ++db) { vt[0][db][0] = lds_rdtr64(kba + 8192u + (unsigned)(vb[db])); vt[0][db][1] = lds_rdtr64(kba + 8192u + (unsigned)(vb[db] + 256 * 8)); }
                const bool needmask = (32 * j + 31 >= t0w);
                bf16x8 pf[2];
                {
                    float E[16], on[16], gt[4], pr[4], om[4];
                    const int mlim = t - 32 * j - 4 * hi;
#pragma unroll
                    for (int r = 0; r < 16; ++r) { float e = __builtin_amdgcn_exp2f(p[r]);
                        if (needmask) e = ((r & 3) + 8 * (r >> 2) < mlim) ? e : 0.f;
                        E[r] = e; }
#pragma unroll
                    for (int a = 0; a < 4; ++a) {
#pragma unroll
                        for (int bb = 0; bb < 4; ++bb) on[4 * a + bb] = 1.0f + E[4 * a + bb];
                        gt[a] = ((on[4 * a + 3] * on[4 * a + 2]) * on[4 * a + 1]) * on[4 * a]; }
#pragma unroll
                    for (int a = 0; a < 4; ++a) { auto rr = __builtin_amdgcn_permlane32_swap(__float_as_uint(gt[a]), __float_as_uint(gt[a]), false, false);
                        const float x0 = __uint_as_float(rr[0]), x1 = __uint_as_float(rr[1]); pr[a] = x0 * x1; om[a] = hi ? 1.0f : x1; }
                    float R[4]; R[3] = C; R[2] = R[3] * pr[3]; R[1] = R[2] * pr[2]; R[0] = R[1] * pr[1]; C = R[0] * pr[0];
                    float A[16];
#pragma unroll
                    for (int a = 0; a < 4; ++a) { const float ap = R[a] * om[a];
                        const float i0 = __builtin_amdgcn_rcpf(gt[a] * ap), i1 = i0 * on[4 * a], i2 = i1 * on[4 * a + 1], i3 = i2 * on[4 * a + 2];
                        A[4 * a] = E[4 * a] * i0; A[4 * a + 1] = E[4 * a + 1] * i1; A[4 * a + 2] = E[4 * a + 2] * i2; A[4 * a + 3] = E[4 * a + 3] * i3; }
#pragma unroll
                    for (int s2 = 0; s2 < 2; ++s2) { u32x4 w; w.x = cvt_pk_bf16(A[8 * s2 + 0], A[8 * s2 + 1]); w.y = cvt_pk_bf16(A[8 * s2 + 2], A[8 * s2 + 3]); w.z = cvt_pk_bf16(A[8 * s2 + 4], A[8 * s2 + 5]); w.w = cvt_pk_bf16(A[8 * s2 + 6], A[8 * s2 + 7]);
                        pf[s2] = __builtin_bit_cast(bf16x8, w); }
                }
                asm volatile("s_waitcnt lgkmcnt(0)" : "+v"(vt[0][0][0]), "+v"(vt[0][0][1]), "+v"(vt[0][1][0]), "+v"(vt[0][1][1]), "+v"(vt[0][2][0]), "+v"(vt[0][2][1]), "+v"(vt[0][3][0]), "+v"(vt[0][3][1]) :: "memory");
#pragma unroll
                for (int db = 0; db < 4; ++db) { vt[1][db][0] = lds_rdtr64(kba + 8192u + (unsigned)(vb[db] + 256 * 16)); vt[1][db][1] = lds_rdtr64(kba + 8192u + (unsigned)(vb[db] + 256 * 24)); }
#pragma unroll
                for (int db = 0; db < 4; ++db) { const bf16x8 vf = __builtin_shufflevector(vt[0][db][0], vt[0][db][1], 0, 1, 2, 3, 4, 5, 6, 7); o[db] = __builtin_amdgcn_mfma_f32_32x32x16_bf16(vf, pf[0], o[db], 0, 0, 0); }
                asm volatile("s_waitcnt lgkmcnt(0)" : "+v"(vt[1][0][0]), "+v"(vt[1][0][1]), "+v"(vt[1][1][0]), "+v"(vt[1][1][1]), "+v"(vt[1][2][0]), "+v"(vt[1][2][1]), "+v"(vt[1][3][0]), "+v"(vt[1][3][1]) :: "memory");
#pragma unroll
                for (int db = 0; db < 4; ++db) { const bf16x8 vf = __builtin_shufflevector(vt[1][db][0], vt[1][db][1], 0, 1, 2, 3, 4, 5, 6, 7); o[db] = __builtin_amdgcn_mfma_f32_32x32x16_bf16(vf, pf[1], o[db], 0, 0, 0); }
            }
            wdone = (j <= 0) || __all(C >= 4294967296.0f);
            { const unsigned wd = wdone ? 1u : 0u; if (lane == 0) lds_wr32(lds_addr((const LAS void*)(dflag + (n & 1) * 8 + wid)), wd); }
            asm volatile("s_waitcnt lgkmcnt(0)" ::: "memory");
        }
        const size_t orow = (rowbase + t0w) * DM + h * HD;
        ++it; idx = it * F.G + F.vcu;
        const bool has_next = idx < REP_ATTN * NUNITS;
        int pslot = 8;
        if (has_next) { AT_UNIT(idx % NUNITS);
#pragma unroll 1
            for (int w = 0; w < 8; ++w) AT_STAGE(8 * qb + w);
            AT_LOADQ(); pslot = (8 * qb + 8) % 9; }
        { LAS char* st = lds + pslot * 16384 + wid * 2048;
#pragma unroll
          for (int ps = 0; ps < 2; ++ps) {
#pragma unroll
              for (int dd = 0; dd < 2; ++dd) { const int db = 2 * ps + dd;
#pragma unroll
                  for (int a = 0; a < 4; ++a) *(LAS unsigned*)(st + r32 * 64 + ((32 * dd + 8 * a + 4 * hi) ^ ((r32 & 3) << 4))) = pk4_i8(o[db][4 * a] * oqs, o[db][4 * a + 1] * oqs, o[db][4 * a + 2] * oqs, o[db][4 * a + 3] * oqs); }
              asm volatile("s_waitcnt lgkmcnt(0)" ::: "memory");
#pragma unroll
              for (int k2 = 0; k2 < 2; ++k2) { const int row = 16 * k2 + (lane >> 2), ch = lane & 3;
                  const u32x4 v = *(const LAS u32x4*)(st + row * 64 + ((16 * ch) ^ ((row & 3) << 4)));
                  *(u32x4*)(O + orow + (size_t)row * DM + 64 * ps + 16 * ch) = v; }
              asm volatile("s_waitcnt lgkmcnt(0)" ::: "memory"); } }
        if (!has_next) break;
        first = false;
    }
#undef AT_STAGE
#undef AT_UNIT
#undef AT_LOADQ
    asm volatile("s_waitcnt vmcnt(0)" ::: "memory"); __builtin_amdgcn_s_barrier();
}

__device__ __forceinline__ void dump_bf16(Frame& F, const bf16_t* src, float* out) {
    const size_t n8 = (size_t)T * DM / 8;
    for (size_t i = (size_t)F.vcu * NTHR + F.tid; i < n8; i += (size_t)F.G * NTHR) {
        const u32x4 v = *(const u32x4*)(src + i * 8);
        f32x4 a = (f32x4){bflo(v.x), bfhi(v.x), bflo(v.y), bfhi(v.y)}, b = (f32x4){bflo(v.z), bfhi(v.z), bflo(v.w), bfhi(v.w)};
        *(f32x4*)(out + i * 8) = a; *(f32x4*)(out + i * 8 + 4) = b;
    }
}

constexpr int N_PHASES = 13;
__global__ void __launch_bounds__(NTHR, 2) fwd(Args args) {
    extern __shared__ __attribute__((aligned(16))) unsigned char lds_raw[];
    Frame F;
    F.lds = (LAS unsigned char*)lds_raw;
    F.tid = threadIdx.x; F.lane = F.tid & 63; F.wave = __builtin_amdgcn_readfirstlane(F.tid >> 6);
    F.G = gridDim.x; { const int bx = blockIdx.x; F.vcu = (F.G % 8 == 0) ? (bx % 8) * (F.G / 8) + bx / 8 : bx; }
    volatile LAS unsigned* MISC = (volatile LAS unsigned*)(F.lds + MISC_OFF);
    if (F.tid < 64) MISC[F.tid] = 0u;
    __syncthreads();
    unsigned* ctl = (unsigned*)(args.ws + WS_CTL);
    XcdBarrier bar; bar.bar = ctl + CW_BAR; bar.x = 0; bar.st = nullptr;
    if (N_LAUNCH_MODE == 1) bar = xcd_barrier_post(ctl + CW_BAR, MISC + 8);
    const int lo = args.ph_lo, hi = args.ph_hi;
#define IN(k) (lo <= (k) && (k) < hi)
#define SEAM(k) do { if (N_LAUNCH_MODE == 1 && IN(k) && IN((k) + 1)) xcd_barrier(bar); } while (0)
    bf16_t* pooled = (bf16_t*)(args.ws + WS_Q);
    bf16_t* h1 = (bf16_t*)(args.ws + WS_K);
    bf16_t* h2 = (bf16_t*)(args.ws + WS_HB);
    bf16_t* h3 = (bf16_t*)(args.ws + WS_HC);

    if (IN(0)) for (int rep = 0; rep < REP_P0; ++rep) { p0_weights(args, F); p0_pool(args, F, pooled); }
    SEAM(0);
    if (IN(1)) {
        SchedPlain S{(const char*)pooled, (const char*)(args.ws + WS_WPOOL), DM * 2, PGC * 2, T / 256, 8, F.G, F.vcu, 1, REP_POOLG};
        EpiPool E{(const bf16_t*)(args.ws + WS_HB), h1, args.ws + WS_X8};
        pg8::gemm_phase<EpiPool, SchedPlain>(F.lds, PGC, S, E);
    }
    SEAM(1);
    if (IN(2)) router_phase(args, F, h1, 0);
    SEAM(2);
    if (IN(3)) {
        moe_build(args, F, 0, 1);
        SchedMoe S{(const char*)(args.ws + WS_X8), (const char*)(args.ws + WS_WGU), DM, (LAS int*)(F.lds + UDESC_OFF), (LAS unsigned*)(F.lds + ROWTAB_OFF), 0, 0};
        EpiSwiGLU E{(const f32x4*)(args.ws + WS_META), args.ws + WS_HMOE, (LAS int*)(F.lds + UDESC_OFF)};
        pg8::gemm_phase<EpiSwiGLU, SchedMoe, 1>(F.lds, DM, S, E);
        { SchedMoe S2 = S; S2.halfpass = 1; pg8::gemm_phase<EpiSwiGLU, SchedMoe, 1, 1, true>(F.lds, DM, S2, E); }
        __syncthreads(); { const FillPlan fp = fill_plan(moe_units_l0(args), F.G, F.vcu); fill_range<false>(args, F, fp, 0, fp.gu3);
            if (fp.rank >= 0) { __syncthreads(); if (fp.rank < fp.st3) do_strip(args, F, fp.rank); } }
    }
    SEAM(3);
    if (IN(4)) {
        SchedMoe S{(const char*)(args.ws + WS_HMOE), (const char*)(args.ws + WS_WD), FF, (LAS int*)(F.lds + UDESC_OFF), (LAS unsigned*)(F.lds + ROWTAB_OFF), 0, 1};
        EpiDown<false> E{(const LAS unsigned*)(F.lds + ROWTAB_OFF), h1, (void*)h2, (LAS int*)(F.lds + UDESC_OFF)};
        pg8::gemm_phase<EpiDown<false>, SchedMoe, 1>(F.lds, 2 * FF, S, E);
        { SchedMoe S2 = S; S2.halfpass = 1; pg8::gemm_phase<EpiDown<false>, SchedMoe, 1, 1, true>(F.lds, 2 * FF, S2, E); }
        __syncthreads(); { const FillPlan fp = fill_plan(moe_units_l0(args), F.G, F.vcu); fill_range<false>(args, F, fp, fp.gu3, fp.gu4); fill_range<true>(args, F, fp, 0, fp.dn4);
            if (fp.rank >= 0) { __syncthreads(); for (int st = fp.st3 + fp.rank; st < fp.st4; st += fp.nidle) do_strip(args, F, st); } }
    }
    SEAM(4);
#if STOP_AFTER == 1
    if (IN(12)) dump_bf16(F, h1, args.out);
#endif
#if STOP_AFTER == 2
    if (IN(12)) dump_bf16(F, h2, args.out);
#endif
#if STOP_AFTER >= 3
    bf16_t* qb_ = (bf16_t*)(args.ws + WS_Q); bf16_t* kb_ = (bf16_t*)(args.ws + WS_K); bf16_t* vb_ = (bf16_t*)(args.ws + WS_V);
    unsigned char* ob_ = (unsigned char*)args.out;
    float* rstd2 = (float*)(args.ws + WS_RSTD); float* rscale2 = (float*)(args.ws + WS_RSCALE);
    unsigned* vmaxw = (unsigned*)(args.ws + WS_CTL) + CW_VMAX;
    if (IN(5)) { rowpass_phase(F, h2, rstd2, rscale2, args.ws + WS_A8); const FillPlan fp = fill_plan(moe_units_l0(args), F.G, F.vcu); fill_tail<false>(args, F, fp.gu4); fill_tail<true>(args, F, fp.dn4);
        __syncthreads(); for (int st = fp.st4 + F.vcu; st < N_STRIPS; st += F.G) do_strip(args, F, st); }
    SEAM(5);
    if (IN(6)) {
        SchedPlain S{(const char*)(args.ws + WS_A8), (const char*)(args.ws + WS_WQKV), DM, DM, T / 256, 24, F.G, F.vcu, 0, REP_QKV};
        EpiQKV E{rstd2, rscale2, (const float*)(args.ws + WS_CSQKV), args.q_norm, args.k_norm, qb_, vmaxw};
        pg8::gemm_phase<EpiQKV, SchedPlain, 2, KREP_QKV>(F.lds, DM, S, E);
    }
    SEAM(6);
    if (IN(7)) attn_phase(F, qb_, kb_, vb_, ob_, vmaxw);
    SEAM(7);
    if (IN(8)) {
        SchedPlain S{(const char*)ob_, (const char*)(args.ws + WS_WO), DM, DM, T / 256, 8, F.G, F.vcu, 0, REP_WO};
        EpiRes E{h2, h3, args.ws + WS_X8, (const float*)(args.ws + WS_CSWO), __uint_as_float(__hip_atomic_load(vmaxw, __ATOMIC_RELAXED, __HIP_MEMORY_SCOPE_AGENT)) * (1.0f / 127.0f)};
        pg8::gemm_phase<EpiRes, SchedPlain, 2>(F.lds, DM, S, E);
    }
    SEAM(8);
#endif
#if STOP_AFTER == 3
    if (IN(12)) dump_bf16(F, h3, args.out);
#endif
#if STOP_AFTER >= 4
    if (IN(9)) router_phase(args, F, h3, 1);
    SEAM(9);
    if (IN(10)) {
        moe_build(args, F, 1, 1);
        SchedMoe S{(const char*)(args.ws + WS_X8), (const char*)(args.ws + WS_WGU), DM, (LAS int*)(F.lds + UDESC_OFF), (LAS unsigned*)(F.lds + ROWTAB_OFF), 1, 0};
        EpiSwiGLU E{(const f32x4*)(args.ws + WS_META), args.ws + WS_HMOE, (LAS int*)(F.lds + UDESC_OFF)};
        pg8::gemm_phase<EpiSwiGLU, SchedMoe, 1>(F.lds, DM, S, E);
        { SchedMoe S2 = S; S2.halfpass = 1; pg8::gemm_phase<EpiSwiGLU, SchedMoe, 1, 1, true>(F.lds, DM, S2, E); }
    }
    SEAM(10);
    if (IN(11)) {
        SchedMoe S{(const char*)(args.ws + WS_HMOE), (const char*)(args.ws + WS_WD), FF, (LAS int*)(F.lds + UDESC_OFF), (LAS unsigned*)(F.lds + ROWTAB_OFF), 1, 1};
        EpiDown<true> E{(const LAS unsigned*)(F.lds + ROWTAB_OFF), h3, (void*)args.out, (LAS int*)(F.lds + UDESC_OFF)};
        pg8::gemm_phase<EpiDown<true>, SchedMoe, 1>(F.lds, 2 * FF, S, E);
        { SchedMoe S2 = S; S2.halfpass = 1; pg8::gemm_phase<EpiDown<true>, SchedMoe, 1, 1, true>(F.lds, 2 * FF, S2, E); }
    }
#endif
#undef IN
#undef SEAM
}

extern "C" void kernel_launch(void* const* d_in, const int* in_sizes, int n_in, void* d_out, int out_size, void* d_ws, size_t ws_size, hipStream_t stream) {
    static int grid = 0;
    if (grid == 0) {
        if (n_in != 18 || out_size != T * DM || ws_size < WS_END) { fprintf(stderr, "kernel_launch: unexpected sizes (n_in %d out %d ws %zu)\n", n_in, out_size, ws_size); grid = -1; return; }
        int dev = 0, cus = 0, per_cu = 0;
        if (hipGetDevice(&dev) != hipSuccess || hipDeviceGetAttribute(&cus, hipDeviceAttributeMultiprocessorCount, dev) != hipSuccess) { grid = -1; return; }
        if (hipFuncSetAttribute((const void*)fwd, hipFuncAttributeMaxDynamicSharedMemorySize, LDS_BYTES) != hipSuccess) { fprintf(stderr, "kernel_launch: hipFuncSetAttribute failed\n"); grid = -1; return; }
        if (hipOccupancyMaxActiveBlocksPerMultiprocessor(&per_cu, (const void*)fwd, NTHR, LDS_BYTES) != hipSuccess || per_cu < 1) fprintf(stderr, "kernel_launch: occupancy query says %d\n", per_cu);
        (void)hipGetLastError();
        grid = cus;
    }
    if (grid < 0) return;
    hipMemsetAsync((char*)d_ws + WS_CTL, 0, CTL_BYTES, stream);
    Args a{};
    a.x = (const float*)d_in[0]; a.norm_mix = (const float*)d_in[1]; a.norm_ffn = (const float*)d_in[2]; a.pool_w = (const float*)d_in[3]; a.pool_scale = (const float*)d_in[4];
    a.kv_norm = (const float*)d_in[5]; a.w_kv = (const float*)d_in[6]; a.k_norm = (const float*)d_in[7]; a.w_q = (const float*)d_in[8]; a.q_norm = (const float*)d_in[9]; a.w_o = (const float*)d_in[10];
    a.w_grp = (const float*)d_in[11]; a.b_grp = (const float*)d_in[12]; a.w_rt = (const float*)d_in[13]; a.b_rt = (const float*)d_in[14]; a.w_gate = (const float*)d_in[15]; a.w_up = (const float*)d_in[16]; a.w_down = (const float*)d_in[17];
    a.out = (float*)d_out; a.ws = (unsigned char*)d_ws;
    if (N_LAUNCH_MODE == 1) { a.ph_lo = 0; a.ph_hi = N_PHASES; hipLaunchKernelGGL(fwd, dim3(grid), dim3(NTHR), LDS_BYTES, stream, a); }
    else for (int p = 0; p < N_PHASES; ++p) { a.ph_lo = p; a.ph_hi = p + 1; hipLaunchKernelGGL(fwd, dim3(grid), dim3(NTHR), LDS_BYTES, stream, a); }
}
```
